# Optimizing an MI355X kernel written in HIP

```python
import math
import jax, jax.numpy as jnp
from jax import lax
import numpy as np

D_MODEL = 1024
BATCH = 8
SEQ = 2048
DEPTH = 4

SSM_WIDTH = D_MODEL // 4
MLSTM_WIDTH = D_MODEL // 4
NSA_WIDTH = D_MODEL // 2
D_MIX = SSM_WIDTH + MLSTM_WIDTH + NSA_WIDTH
SSM_GROUP = 16
SSM_GROUPS = SSM_WIDTH // SSM_GROUP
SSM_STATE = 64
DT_MIN = 1e-3
DT_MAX = 1e-1
MLSTM_HEADS = 4
MLSTM_HEAD_DIM = MLSTM_WIDTH // MLSTM_HEADS
MLSTM_CHUNK = 128
MLSTM_CONV = 4
NSA_HEAD_DIM = 64
NSA_HEADS = NSA_WIDTH // NSA_HEAD_DIM
NSA_KV_GROUPS = 2
NSA_KV_WIDTH = NSA_KV_GROUPS * NSA_HEAD_DIM
CMP_BLOCK = 32
CMP_STRIDE = 16
CMP_HIDDEN = 256
SEL_BLOCK = 64
SEL_TOPN = 8
WINDOW = 256
Q_BLOCK = 128
FORCE_SCORE = 1e4
NEG_INF = -1e30
ROPE_THETA = 500000.0
ROPE_DIMS = NSA_HEAD_DIM // 4
D_FF = 4 * D_MODEL
EPS = 1e-6

IN_SPLITS = (SSM_WIDTH,
             MLSTM_WIDTH, MLSTM_WIDTH, MLSTM_WIDTH, MLSTM_WIDTH, MLSTM_HEADS, MLSTM_HEADS,
             NSA_WIDTH, NSA_KV_WIDTH, NSA_KV_WIDTH, NSA_KV_WIDTH, NSA_KV_WIDTH, NSA_KV_WIDTH, NSA_KV_WIDTH,
             3 * NSA_HEADS)
D_IN = SSM_WIDTH + 4 * MLSTM_WIDTH + 2 * MLSTM_HEADS + NSA_WIDTH + 6 * NSA_KV_WIDTH + 3 * NSA_HEADS

kernel_name = 'hybrid_s5_mlstm_nsa_sandwich'

F32 = jnp.float32


def _rmsnorm(x, g):
    xf = x.astype(F32)
    y = xf * lax.rsqrt(jnp.mean(xf * xf, axis=-1, keepdims=True) + EPS)
    return (y * g).astype(x.dtype)


def _group_rmsnorm(y, g, n_groups):
    shp = y.shape
    yf = y.astype(F32).reshape(*shp[:-1], n_groups, shp[-1] // n_groups)
    yf = yf * lax.rsqrt(jnp.mean(yf * yf, axis=-1, keepdims=True) + EPS)
    return yf.reshape(shp) * g


def _rope_tables(positions):
    inv = ROPE_THETA ** (-jnp.arange(0, ROPE_DIMS, 2, dtype=F32) / ROPE_DIMS)
    ang = positions.astype(F32)[..., None] * inv
    return jnp.cos(ang)[:, :, None, :], jnp.sin(ang)[:, :, None, :]


def _rope(x, cos, sin):
    half = ROPE_DIMS // 2
    x1 = x[..., :half]
    x2 = x[..., half:ROPE_DIMS]
    rot = jnp.concatenate([x1 * cos - x2 * sin, x2 * cos + x1 * sin], axis=-1)
    return jnp.concatenate([rot.astype(x.dtype), x[..., ROPE_DIMS:]], axis=-1)


def _masked_softmax(s, mask):
    s = jnp.where(mask, s.astype(F32), NEG_INF)
    p = jax.nn.softmax(s, axis=-1)
    return jnp.where(mask, p, 0.0)


def _causal_dwconv(x, w):
    K = w.shape[0]
    S = x.shape[1]
    xp = jnp.pad(x, ((0, 0), (K - 1, 0), (0, 0)))
    out = xp[:, 0:S] * w[0]
    for j in range(1, K):
        out = out + xp[:, j:j + S] * w[j]
    return out


def _s5_mixer(u, lam_re, lam_im, b_re, b_im, c_re, c_im, d_skip, log_dt, w_glu):
    Bsz, S, _ = u.shape
    uf = u.astype(F32).reshape(Bsz, S, SSM_GROUPS, SSM_GROUP)
    dt = jnp.exp(log_dt.astype(F32))[:, None]
    lr = lam_re.astype(F32)
    li = lam_im.astype(F32)
    mag = jnp.exp(lr * dt)
    ang = li * dt
    ab_re = mag * jnp.cos(ang)
    ab_im = mag * jnp.sin(ang)
    den = lr * lr + li * li
    g_re = ((ab_re - 1.0) * lr + ab_im * li) / den
    g_im = (ab_im * lr - (ab_re - 1.0) * li) / den
    br = b_re.astype(F32)
    bi = b_im.astype(F32)
    bb_re = g_re[..., None] * br - g_im[..., None] * bi
    bb_im = g_re[..., None] * bi + g_im[..., None] * br
    bu_re = jnp.einsum('bsgh,gph->bsgp', uf, bb_re)
    bu_im = jnp.einsum('bsgh,gph->bsgp', uf, bb_im)
    a_re = jnp.broadcast_to(ab_re, bu_re.shape)
    a_im = jnp.broadcast_to(ab_im, bu_im.shape)

    def combine(e1, e2):
        a1r, a1i, b1r, b1i = e1
        a2r, a2i, b2r, b2i = e2
        return (a2r * a1r - a2i * a1i,
                a2r * a1i + a2i * a1r,
                a2r * b1r - a2i * b1i + b2r,
                a2r * b1i + a2i * b1r + b2i)

    _, _, xr, xi = lax.associative_scan(combine, (a_re, a_im, bu_re, bu_im), axis=1)
    y = (jnp.einsum('bsgp,ghp->bsgh', xr, c_re.astype(F32))
         - jnp.einsum('bsgp,ghp->bsgh', xi, c_im.astype(F32))
         + d_skip.astype(F32).reshape(SSM_GROUPS, SSM_GROUP) * uf)
    y = jax.nn.gelu(y.reshape(Bsz, S, SSM_WIDTH))
    return y * jax.nn.sigmoid(y @ w_glu.astype(F32))


def _mlstm_mixer(q, k, v, o_pre, i_pre, f_pre, conv_w, b_i, b_f):
    Bsz, S, _ = q.shape
    H, Dh, L = MLSTM_HEADS, MLSTM_HEAD_DIM, MLSTM_CHUNK
    nc = S // L
    qk = jax.nn.silu(_causal_dwconv(jnp.concatenate([q, k], axis=-1), conv_w))
    q, k = jnp.split(qk, 2, axis=-1)

    def heads(t):
        return t.astype(F32).reshape(Bsz, nc, L, H, Dh).transpose(1, 0, 3, 2, 4)

    def gates(t):
        return t.reshape(Bsz, nc, L, H).transpose(1, 0, 3, 2)

    qh = heads(q)
    kh = heads(k) * (Dh ** -0.5)
    vh = heads(v)
    ig = gates(i_pre.astype(F32) + b_i.astype(F32))
    lf = gates(jax.nn.log_sigmoid(f_pre.astype(F32) + b_f.astype(F32)))
    causal = jnp.tril(jnp.ones((L, L), dtype=bool))

    def step(carry, xs):
        C, n, m = carry
        qc, kc, vc, ic, fc = xs
        b = jnp.cumsum(fc, axis=-1)
        dmat = b[..., :, None] - b[..., None, :] + ic[..., None, :]
        dmat = jnp.where(causal, dmat, -jnp.inf)
        inter = b + m[..., None]
        m_t = jnp.maximum(inter, jnp.max(dmat, axis=-1))
        w_intra = jnp.exp(dmat - m_t[..., None])
        w_inter = jnp.exp(inter - m_t)
        s = jnp.einsum('bhtd,bhsd->bhts', qc, kc) * w_intra
        num = (w_inter[..., None] * jnp.einsum('bhtd,bhde->bhte', qc, C)
               + jnp.einsum('bhts,bhse->bhte', s, vc))
        den = w_inter * jnp.einsum('bhtd,bhd->bht', qc, n) + jnp.sum(s, axis=-1)
        h = num / jnp.maximum(jnp.abs(den), jnp.exp(-m_t))[..., None]
        bL = b[..., -1]
        logw = bL[..., None] - b + ic
        m_new = jnp.maximum(bL + m, jnp.max(logw, axis=-1))
        wk = jnp.exp(logw - m_new[..., None])
        decay = jnp.exp(bL + m - m_new)
        C_new = decay[..., None, None] * C + jnp.einsum('bhs,bhsd,bhse->bhde', wk, kc, vc)
        n_new = decay[..., None] * n + jnp.einsum('bhs,bhsd->bhd', wk, kc)
        return (C_new, n_new, m_new), h

    init = (jnp.zeros((Bsz, H, Dh, Dh), F32), jnp.zeros((Bsz, H, Dh), F32), jnp.zeros((Bsz, H), F32))
    _, hs = lax.scan(step, init, (qh, kh, vh, ig, lf))
    h = hs.transpose(1, 0, 3, 2, 4).reshape(Bsz, S, MLSTM_WIDTH)
    return jax.nn.sigmoid(o_pre.astype(F32)) * h


def _compress(t, pe, w1, w2):
    Bsz, S, G, Dh = t.shape
    r = CMP_BLOCK // CMP_STRIDE
    ch = t.reshape(Bsz, S // CMP_STRIDE, CMP_STRIDE, G, Dh)
    n = S // CMP_STRIDE - (r - 1)
    blocks = jnp.concatenate([ch[:, j:j + n] for j in range(r)], axis=2)
    blocks = blocks + pe[None, None, :, None, :]
    flat = blocks.transpose(0, 1, 3, 2, 4).reshape(Bsz, n, G, CMP_BLOCK * Dh)
    return jax.nn.gelu(flat @ w1) @ w2


def _cmp_to_sel_overlap(n_cmp, n_sel):
    i = np.arange(n_cmp)[:, None]
    j = np.arange(n_sel)[None, :]
    lo = np.maximum(i * CMP_STRIDE, j * SEL_BLOCK)
    hi = np.minimum(i * CMP_STRIDE + CMP_BLOCK, (j + 1) * SEL_BLOCK)
    return jnp.asarray(np.maximum(hi - lo, 0) / CMP_STRIDE, dtype=F32)


def _nsa_mixer(q, k_c, v_c, k_s, v_s, k_w, v_w, g_pre, cos, sin,
               pe_k, w1_k, w2_k, pe_v, w1_v, w2_v):
    Bsz, S, _ = q.shape
    H, G, Dh = NSA_HEADS, NSA_KV_GROUPS, NSA_HEAD_DIM
    R = H // G
    scale = Dh ** -0.5
    t_idx = jnp.arange(S)
    qh = _rope(q.reshape(Bsz, S, H, Dh), cos, sin)
    qg = qh.reshape(Bsz, S, G, R, Dh)

    def kv(t):
        return t.reshape(Bsz, S, G, Dh)

    k_c = _rope(kv(k_c), cos, sin)
    k_s = _rope(kv(k_s), cos, sin)
    k_w = _rope(kv(k_w), cos, sin)
    v_c, v_s, v_w = kv(v_c), kv(v_s), kv(v_w)

    kcmp = _compress(k_c, pe_k, w1_k, w2_k)
    vcmp = _compress(v_c, pe_v, w1_v, w2_v)
    n_cmp = kcmp.shape[1]
    cmp_end = jnp.arange(n_cmp) * CMP_STRIDE + CMP_BLOCK - 1
    cmask = cmp_end[None, :] <= t_idx[:, None]
    sc = jnp.einsum('bsgrd,bngd->bgrsn', qg, kcmp) * scale
    p_c = _masked_softmax(sc, cmask)
    o_c = jnp.einsum('bgrsn,bngd->bsgrd', p_c, vcmp).reshape(Bsz, S, H, Dh)

    n_sel = S // SEL_BLOCK
    n_top = min(SEL_TOPN, n_sel)
    imp = jnp.einsum('bgrsn,nj->bgsj', p_c, _cmp_to_sel_overlap(n_cmp, n_sel))
    blk = jnp.arange(n_sel)
    valid = blk[None, :] * SEL_BLOCK <= t_idx[:, None]
    forced = (blk[None, :] == 0) | (blk[None, :] == (t_idx // SEL_BLOCK)[:, None])
    imp = jnp.where(forced, FORCE_SCORE, jnp.where(valid, imp, -FORCE_SCORE))
    _, sel_idx = lax.top_k(imp, n_top)

    nq = S // Q_BLOCK
    ks_blocks = k_s.reshape(Bsz, n_sel, SEL_BLOCK, G, Dh).transpose(0, 3, 1, 2, 4)
    vs_blocks = v_s.reshape(Bsz, n_sel, SEL_BLOCK, G, Dh).transpose(0, 3, 1, 2, 4)
    q_blk = qg.reshape(Bsz, nq, Q_BLOCK, G, R, Dh).transpose(1, 0, 3, 2, 4, 5)
    idx_blk = sel_idx.reshape(Bsz, G, nq, Q_BLOCK, n_top).transpose(2, 0, 1, 3, 4)
    t_blk = t_idx.reshape(nq, Q_BLOCK)
    b_ix = jnp.arange(Bsz)[:, None, None]
    g_ix = jnp.arange(G)[None, :, None]
    kk = n_top * SEL_BLOCK

    def sel_block(args):
        qb, ib, tb = args
        flat = ib.reshape(Bsz, G, Q_BLOCK * n_top)
        kg = ks_blocks[b_ix, g_ix, flat].reshape(Bsz, G, Q_BLOCK, kk, Dh)
        vg = vs_blocks[b_ix, g_ix, flat].reshape(Bsz, G, Q_BLOCK, kk, Dh)
        kpos = (ib[..., None] * SEL_BLOCK + jnp.arange(SEL_BLOCK)).reshape(Bsz, G, Q_BLOCK, kk)
        mask = kpos <= tb[None, None, :, None]
        s = jnp.einsum('bgtrd,bgtkd->bgrtk', qb, kg) * scale
        p = _masked_softmax(s, mask[:, :, None])
        return jnp.einsum('bgrtk,bgtkd->btgrd', p, vg)

    o_s = lax.map(sel_block, (q_blk, idx_blk, t_blk))
    o_s = o_s.transpose(1, 0, 2, 3, 4, 5).reshape(Bsz, S, H, Dh)

    nb = S // Q_BLOCK
    nprev = WINDOW // Q_BLOCK

    def band(t):
        tb = t.reshape(Bsz, nb, Q_BLOCK, G, Dh)
        tp = jnp.pad(tb, ((0, 0), (nprev, 0), (0, 0), (0, 0), (0, 0)))
        return jnp.concatenate([tp[:, j:j + nb] for j in range(nprev + 1)], axis=2)

    kwb = band(k_w)
    vwb = band(v_w)
    qpos = t_idx.reshape(nb, Q_BLOCK)
    kpos = (jnp.arange(nb)[:, None] - nprev) * Q_BLOCK + jnp.arange((nprev + 1) * Q_BLOCK)[None, :]
    wmask = ((kpos[:, None, :] >= 0) & (kpos[:, None, :] <= qpos[:, :, None])
             & (qpos[:, :, None] - kpos[:, None, :] < WINDOW))
    qw = qg.reshape(Bsz, nb, Q_BLOCK, G, R, Dh)
    sw = jnp.einsum('bitgrd,bikgd->bigrtk', qw, kwb) * scale
    p_w = _masked_softmax(sw, wmask[None, :, None, None])
    o_w = jnp.einsum('bigrtk,bikgd->bitgrd', p_w, vwb).reshape(Bsz, S, H, Dh)

    g = jax.nn.sigmoid(g_pre.astype(F32)).reshape(Bsz, S, H, 3)
    o = g[..., 0:1] * o_c + g[..., 1:2] * o_s + g[..., 2:3] * o_w
    return o.reshape(Bsz, S, NSA_WIDTH)


def _split_points():
    return [int(v) for v in np.cumsum(IN_SPLITS)[:-1]]


def setup_inputs(seed: int = 0) -> dict:
    key = jax.random.key(seed)
    ks = jax.random.split(key, 40)
    L, D, G, P, Hc = DEPTH, D_MODEL, SSM_GROUPS, SSM_STATE, SSM_GROUP

    def nrm(k, shape, scale):
        return scale * jax.random.normal(k, shape, F32)

    def gain(k, shape):
        return 1.0 + 0.05 * jax.random.normal(k, shape, F32)

    x = jax.random.normal(ks[0], (BATCH, SEQ, D), F32)
    offs = jax.random.randint(ks[1], (BATCH, 1), 0, SEQ, dtype=jnp.int32)
    positions = offs + jnp.arange(SEQ, dtype=jnp.int32)[None, :]
    return {
        'x': x,
        'positions': positions,
        'ln_mix_pre': gain(ks[2], (L, D)),
        'ln_mix_post': gain(ks[3], (L, D)),
        'ln_mlp_pre': gain(ks[4], (L, D)),
        'ln_mlp_post': gain(ks[5], (L, D)),
        'w_in': nrm(ks[6], (L, D, D_IN), D ** -0.5),
        'w_out': nrm(ks[7], (L, D_MIX, D), D_MIX ** -0.5),
        'ssm_lambda_re': -0.5 + 0.01 * jax.random.normal(ks[8], (L, G, P), F32),
        'ssm_lambda_im': math.pi * jnp.arange(P, dtype=F32) + 0.01 * jax.random.normal(ks[9], (L, G, P), F32),
        'ssm_b_re': nrm(ks[10], (L, G, P, Hc), (2 * Hc) ** -0.5),
        'ssm_b_im': nrm(ks[11], (L, G, P, Hc), (2 * Hc) ** -0.5),
        'ssm_c_re': nrm(ks[12], (L, G, Hc, P), P ** -0.5),
        'ssm_c_im': nrm(ks[13], (L, G, Hc, P), P ** -0.5),
        'ssm_d': nrm(ks[14], (L, SSM_WIDTH), 1.0),
        'ssm_log_dt': jax.random.uniform(ks[15], (L, G), F32, math.log(DT_MIN), math.log(DT_MAX)),
        'ssm_w_glu': nrm(ks[16], (L, SSM_WIDTH, SSM_WIDTH), SSM_WIDTH ** -0.5),
        'mlstm_conv': nrm(ks[17], (L, MLSTM_CONV, 2 * MLSTM_WIDTH), MLSTM_CONV ** -0.5),
        'mlstm_b_i': nrm(ks[18], (L, MLSTM_HEADS), 0.1),
        'mlstm_b_f': jax.random.uniform(ks[19], (L, MLSTM_HEADS), F32, 3.0, 6.0),
        'cmp_pe_k': nrm(ks[20], (L, CMP_BLOCK, NSA_HEAD_DIM), 0.1),
        'cmp_w1_k': nrm(ks[21], (L, CMP_BLOCK * NSA_HEAD_DIM, CMP_HIDDEN), (CMP_BLOCK * NSA_HEAD_DIM) ** -0.5),
        'cmp_w2_k': nrm(ks[22], (L, CMP_HIDDEN, NSA_HEAD_DIM), CMP_HIDDEN ** -0.5),
        'cmp_pe_v': nrm(ks[23], (L, CMP_BLOCK, NSA_HEAD_DIM), 0.1),
        'cmp_w1_v': nrm(ks[24], (L, CMP_BLOCK * NSA_HEAD_DIM, CMP_HIDDEN), (CMP_BLOCK * NSA_HEAD_DIM) ** -0.5),
        'cmp_w2_v': nrm(ks[25], (L, CMP_HIDDEN, NSA_HEAD_DIM), CMP_HIDDEN ** -0.5),
        'gn_ssm': gain(ks[26], (L, SSM_WIDTH)),
        'gn_mlstm': gain(ks[27], (L, MLSTM_WIDTH)),
        'gn_nsa': gain(ks[28], (L, NSA_WIDTH)),
        'mlp_w1': nrm(ks[29], (L, D, D_FF), D ** -0.5),
        'mlp_w2': nrm(ks[30], (L, D_FF, D), D_FF ** -0.5),
    }


def reference(x, positions, ln_mix_pre, ln_mix_post, ln_mlp_pre, ln_mlp_post, w_in, w_out,
              ssm_lambda_re, ssm_lambda_im, ssm_b_re, ssm_b_im, ssm_c_re, ssm_c_im, ssm_d,
              ssm_log_dt, ssm_w_glu, mlstm_conv, mlstm_b_i, mlstm_b_f,
              cmp_pe_k, cmp_w1_k, cmp_w2_k, cmp_pe_v, cmp_w1_v, cmp_w2_v,
              gn_ssm, gn_mlstm, gn_nsa, mlp_w1, mlp_w2):
    cos, sin = _rope_tables(positions)
    h = x
    for l in range(DEPTH):
        u = _rmsnorm(h, ln_mix_pre[l])
        z = u @ w_in[l]
        (s_u, m_q, m_k, m_v, m_o, m_i, m_f,
         a_q, c_k, c_v, s_k, s_v, w_k, w_v, a_g) = jnp.split(z, _split_points(), axis=-1)
        y_ssm = _s5_mixer(s_u, ssm_lambda_re[l], ssm_lambda_im[l], ssm_b_re[l], ssm_b_im[l],
                          ssm_c_re[l], ssm_c_im[l], ssm_d[l], ssm_log_dt[l], ssm_w_glu[l])
        y_mls = _mlstm_mixer(m_q, m_k, m_v, m_o, m_i, m_f, mlstm_conv[l], mlstm_b_i[l], mlstm_b_f[l])
        y_nsa = _nsa_mixer(a_q, c_k, c_v, s_k, s_v, w_k, w_v, a_g, cos, sin,
                           cmp_pe_k[l], cmp_w1_k[l], cmp_w2_k[l], cmp_pe_v[l], cmp_w1_v[l], cmp_w2_v[l])
        y = jnp.concatenate([_group_rmsnorm(y_ssm, gn_ssm[l], SSM_GROUPS),
                             _group_rmsnorm(y_mls, gn_mlstm[l], MLSTM_HEADS),
                             _group_rmsnorm(y_nsa, gn_nsa[l], NSA_HEADS)], axis=-1).astype(h.dtype)
        h = h + _rmsnorm(y @ w_out[l], ln_mix_post[l])
        u = _rmsnorm(h, ln_mlp_pre[l])
        f = jnp.square(jax.nn.relu(u @ mlp_w1[l])) @ mlp_w2[l]
        h = h + _rmsnorm(f, ln_mlp_post[l])
    return h
```

```cpp
#include <hip/hip_runtime.h>
#include <hip/hip_cooperative_groups.h>
#include <cstdio>
#include <cstdint>
namespace cg = cooperative_groups;

#define LAS __attribute__((address_space(3)))
typedef unsigned short bf16_t;
typedef short bf16x8 __attribute__((ext_vector_type(8)));
typedef short bf16x4 __attribute__((ext_vector_type(4)));
typedef float f32x4 __attribute__((ext_vector_type(4)));
typedef float f32x2 __attribute__((ext_vector_type(2)));
typedef unsigned u32x4 __attribute__((ext_vector_type(4)));
typedef unsigned u32x2 __attribute__((ext_vector_type(2)));
typedef LAS unsigned char* ldsp;

constexpr int NB = 8, SEQ = 2048, MTOK = NB * SEQ, DM = 1024, DEPTH = 4, DIN = 2592, ZLD = 2816, DFF = 4096;
constexpr int ZC_SU = 0, ZC_MQ = 256, ZC_MK = 512, ZC_MV = 768, ZC_MO = 1024, ZC_AQ = 1280, ZC_CK = 1792, ZC_CV = 1920,
              ZC_SK = 2048, ZC_SV = 2176, ZC_WK = 2304, ZC_WV = 2432, ZC_G = 2560;
constexpr float EPS = 1e-6f;
constexpr float NEGF = -1e30f;

constexpr size_t MiB = 1u << 20;
constexpr size_t WS_CTL = 0;
constexpr size_t WS_WIN = 1 * MiB;
constexpr size_t WS_WOUT = 7 * MiB;
constexpr size_t WS_W1 = 9 * MiB;
constexpr size_t WS_W2 = 17 * MiB;
constexpr size_t WS_WGLU = 25 * MiB;
constexpr size_t WS_CW1K = 25 * MiB + 256 * 1024;
constexpr size_t WS_CW1V = 26 * MiB + 256 * 1024;
constexpr size_t WS_CW2K = 27 * MiB + 256 * 1024;
constexpr size_t WS_CW2V = 27 * MiB + 320 * 1024;
constexpr size_t WS_CB1 = 27 * MiB + 384 * 1024;
constexpr size_t WS_ROPE = 28 * MiB;
constexpr size_t WS_GATE = 29 * MiB;
constexpr size_t WS_S5E = 31 * MiB;
constexpr size_t WS_MLC = 33 * MiB;
constexpr size_t WS_KCMP = 42 * MiB;
constexpr size_t WS_VCMP = 42 * MiB + 512 * 1024;
constexpr size_t WS_U = 44 * MiB;
constexpr size_t WS_Y = 76 * MiB;
constexpr size_t WS_Z = 108 * MiB;
constexpr size_t WS_END = 236 * MiB;
constexpr int MLC_STRIDE = 4224;

__device__ __forceinline__ float bf2f(unsigned short v) { return __uint_as_float(((unsigned)v) << 16); }
__device__ __forceinline__ unsigned cvt_pk_bf16(float lo, float hi) { unsigned r; asm volatile("v_cvt_pk_bf16_f32 %0, %1, %2" : "=v"(r) : "v"(lo), "v"(hi)); return r; }
__device__ __forceinline__ unsigned short f2bf(float f) { return (unsigned short)(cvt_pk_bf16(f, 0.f) & 0xffffu); }
__device__ __forceinline__ float wave_sum(float v) {
#pragma unroll
    for (int o = 1; o < 64; o <<= 1) v += __shfl_xor(v, o);
    return v;
}
__device__ __forceinline__ float sigmoidf_(float x) { return 1.0f / (1.0f + __expf(-x)); }
__device__ __forceinline__ float gelu_tanh(float x) {
    const float a = 0.7978845608028654f * (x + 0.044715f * x * x * x);
    const float e = __expf(2.0f * a);
    const float t = 1.0f - 2.0f / (e + 1.0f);
    return 0.5f * x * (1.0f + t);
}
__device__ __forceinline__ f32x4 mfma16(bf16x8 a, bf16x8 b, f32x4 c) { return __builtin_amdgcn_mfma_f32_16x16x32_bf16(a, b, c, 0, 0, 0); }
__device__ __forceinline__ bf16x8 lds_frag(ldsp lds, int byteoff) { return *(const LAS bf16x8*)(lds + byteoff); }
__device__ __forceinline__ bf16x8 pack8(const float* v) {
    u32x4 w; w.x = cvt_pk_bf16(v[0], v[1]); w.y = cvt_pk_bf16(v[2], v[3]); w.z = cvt_pk_bf16(v[4], v[5]); w.w = cvt_pk_bf16(v[6], v[7]);
    return __builtin_bit_cast(bf16x8, w);
}
__device__ __forceinline__ void unpack8(u32x4 w, float* v) {
    v[0] = __uint_as_float(w.x << 16); v[1] = __uint_as_float(w.x & 0xffff0000u);
    v[2] = __uint_as_float(w.y << 16); v[3] = __uint_as_float(w.y & 0xffff0000u);
    v[4] = __uint_as_float(w.z << 16); v[5] = __uint_as_float(w.z & 0xffff0000u);
    v[6] = __uint_as_float(w.w << 16); v[7] = __uint_as_float(w.w & 0xffff0000u);
}

namespace pg8 {
#define PG8_LAS __attribute__((address_space(3)))
constexpr int BM = 256, BK = 64, HALF = 128, HTB = HALF * BK * 2, STAGE_BYTES = 8 * HTB, NXCD = 8, WGM = 8;
__host__ __device__ __forceinline__ int lds_byte(int r, int c) { const int st = (r >> 4) * 2 + (c >> 5), rr = r & 15, cc = c & 31, ob = rr * 64 + cc * 2; return st * 1024 + (ob ^ (((ob >> 9) & 1) << 5)); }
__host__ __device__ __forceinline__ void stage_rc(int b, int& R, int& C) { const int st = b / 1024, sb = b % 1024, swz = sb ^ (((sb >> 9) & 1) << 5); R = (st >> 1) * 16 + swz / 64; C = (st & 1) * 32 + (swz % 64) / 2; }
__host__ __device__ __forceinline__ int perm32(int rho) { const int n = rho >> 4, i = rho & 15; return 8 * (i >> 2) + 4 * n + (i & 3); }
struct Unit { int pm, pn; };
struct Gemm { const bf16_t* A; const bf16_t* Bt; int M, N, K; };
struct StaticOrder {
    int nM, nN, nwg, G, c;
    __host__ __device__ void init(int M, int N, int G_, int c_) { nM = M / BM; nN = N / BM; nwg = nM * nN; G = G_; c = c_; }
    __host__ __device__ bool next(int i, Unit& u) const {
        const long L = (long)i * G + c; if (L >= nwg) return false;
        int wgid = (int)L; { const int q = nwg / NXCD, r = nwg % NXCD, xcd = wgid % NXCD, off = wgid / NXCD; wgid = (xcd < r ? xcd * (q + 1) : r * (q + 1) + (xcd - r) * q) + off; }
        const int nig = WGM * nN, gid = wgid / nig, fm = gid * WGM, gsz = (nM - fm) < WGM ? (nM - fm) : WGM;
        u.pm = fm + ((wgid % nig) % gsz); u.pn = (wgid % nig) / gsz; return true;
    }
    __device__ __forceinline__ void a_ready(const Unit&) const {}
    __device__ __forceinline__ void done(const Unit&) const {}
};
template <int ACT  > struct EpiBf16 {
    static constexpr bool PERM = true, AFTER_DRAIN = false;
    bf16_t* O; int ldc; float* gate; int gate_pn;
    __device__ __forceinline__ void operator()(const f32x4 (&acc)[2][2][4][2], const Unit& u, int wr, int wc, int fr, int fq) const {
        const int row0 = u.pm * BM + wr * 64 + fr;
        if (u.pn == gate_pn) {
            if (wc == 0) {
#pragma unroll
                for (int ai = 0; ai < 2; ++ai)
#pragma unroll
                    for (int m = 0; m < 4; ++m) { float* gp = gate + (size_t)(row0 + ai * HALF + m * 16) * 32 + 8 * fq;
                        *(f32x4*)(gp) = acc[ai][0][m][0]; *(f32x4*)(gp + 4) = acc[ai][0][m][1]; }
            }
            return;
        }
        const int col0 = u.pn * BM + wc * 32 + 8 * fq;
#pragma unroll
        for (int ai = 0; ai < 2; ++ai)
#pragma unroll
            for (int m = 0; m < 4; ++m) { bf16_t* rowp = O + (size_t)(row0 + ai * HALF + m * 16) * ldc + col0;
#pragma unroll
                for (int bj = 0; bj < 2; ++bj) { f32x4 v0 = acc[ai][bj][m][0], v1 = acc[ai][bj][m][1];
                    if (ACT == 2) {
#pragma unroll
                        for (int e = 0; e < 4; ++e) { float a = fmaxf(v0[e], 0.f); v0[e] = a * a; float b = fmaxf(v1[e], 0.f); v1[e] = b * b; }
                    }
                    u32x4 w; w.x = cvt_pk_bf16(v0[0], v0[1]); w.y = cvt_pk_bf16(v0[2], v0[3]); w.z = cvt_pk_bf16(v1[0], v1[1]); w.w = cvt_pk_bf16(v1[2], v1[3]);
                    *(u32x4*)(rowp + bj * HALF) = w; } }
    }
};

template <class Epi, class Sched, bool ALIGN_EPI = false, bool SP2 = false>
__device__ __forceinline__ void gemm_phase(PG8_LAS unsigned char* lds, const Gemm g, const Sched& S, const Epi& E, const int tid) {
    const int wid = __builtin_amdgcn_readfirstlane(tid >> 6), lane = tid & 63, wr = wid >> 2, wc = wid & 3, fr = lane & 15, fq = lane >> 4;
    const int K = g.K, nt = K / BK;
    unsigned voffA[2], voffB[2];
#pragma unroll
    for (int i = 0; i < 2; ++i) { int R, C; stage_rc(tid * 16 + i * 8192, R, C); const int Rb = Epi::PERM ? ((R & ~31) + perm32(R & 31)) : R;
        voffA[i] = (unsigned)(R * K + C) * 2u; voffB[i] = (unsigned)(Rb * K + C) * 2u; }
    const size_t kstep = (size_t)(BK * 2);
    const size_t hstep = (size_t)HALF * K * 2;
    const size_t tstep = 2 * hstep;
    const unsigned ldsw = (unsigned)wid * 1024u;
    const int aoff = lds_byte(wr * 64 + fr, fq * 8), boff = lds_byte(wc * 32 + fr, fq * 8);
#define PG8_SA(b, h) (((b) * 2 + (h)) * HTB)
#define PG8_SB(b, h) ((4 + (b) * 2 + (h)) * HTB)
#define PG8_STAGE(bufoff, gbase, voff) do { _Pragma("unroll") for (int _i = 0; _i < 2; ++_i) \
        __builtin_amdgcn_global_load_lds((const unsigned*)((const char*)(gbase) + (voff)[_i]), (PG8_LAS unsigned*)(lds + (bufoff) + ldsw + _i * 8192), 16, 0, 0); } while (0)
#define PG8_LDA(dst, b, h) do { _Pragma("unroll") for (int m = 0; m < 4; ++m) _Pragma("unroll") for (int k = 0; k < 2; ++k) dst[m][k] = *(const PG8_LAS bf16x8*)(lds + PG8_SA(b, h) + aoff + m * 2048 + k * 1024); } while (0)
#define PG8_LDB(dst, b, h) do { _Pragma("unroll") for (int n = 0; n < 2; ++n) _Pragma("unroll") for (int k = 0; k < 2; ++k) dst[n][k] = *(const PG8_LAS bf16x8*)(lds + PG8_SB(b, h) + boff + n * 2048 + k * 1024); } while (0)
#define PG8_MMA(ai, bj, At, Bt) do { __builtin_amdgcn_s_setprio(1); _Pragma("unroll") for (int m = 0; m < 4; ++m) _Pragma("unroll") for (int n = 0; n < 2; ++n) _Pragma("unroll") for (int k = 0; k < 2; ++k) \
        acc[ai][bj][m][n] = __builtin_amdgcn_mfma_f32_16x16x32_bf16(Bt[n][k], At[m][k], acc[ai][bj][m][n], 0, 0, 0); __builtin_amdgcn_s_setprio(0); } while (0)
#define PG8_WAIT_V(n) asm volatile("s_waitcnt vmcnt(" #n ")" ::: "memory")
#define PG8_WAIT_L(n) asm volatile("s_waitcnt lgkmcnt(" #n ")" ::: "memory")
#define PG8_BAR __builtin_amdgcn_s_barrier()
#define PG8_SCHED __builtin_amdgcn_sched_barrier(0)
    Unit cur, nxt; int ui = 0;
    if (!S.next(0, cur)) return;
    f32x4 acc[2][2][4][2];
#pragma unroll
    for (int a = 0; a < 2; ++a)
#pragma unroll
        for (int b = 0; b < 2; ++b)
#pragma unroll
            for (int m = 0; m < 4; ++m)
#pragma unroll
                for (int n = 0; n < 2; ++n) acc[a][b][m][n] = (f32x4){0.f, 0.f, 0.f, 0.f};
    bf16x8 At[4][2], B0[2][2], B1[2][2];
    const char* cA = (const char*)g.A + (size_t)cur.pm * tstep; const char* cB = (const char*)g.Bt + (size_t)cur.pn * tstep;
    S.a_ready(cur);
    if constexpr (SP2) {
        PG8_STAGE(PG8_SB(0, 0), cB, voffB); PG8_STAGE(PG8_SB(0, 1), cB + hstep, voffB); PG8_STAGE(PG8_SA(0, 0), cA, voffA); PG8_STAGE(PG8_SA(0, 1), cA + hstep, voffA);
        if (wr == 1) PG8_BAR;
        PG8_WAIT_V(2); PG8_BAR;
        PG8_STAGE(PG8_SB(1, 0), cB + kstep, voffB); PG8_STAGE(PG8_SA(1, 0), cA + kstep, voffA); PG8_STAGE(PG8_SB(1, 1), cB + hstep + kstep, voffB);
        PG8_WAIT_V(6); PG8_BAR;
    } else {
        PG8_STAGE(PG8_SB(0, 0), cB, voffB); PG8_STAGE(PG8_SA(0, 0), cA, voffA); PG8_STAGE(PG8_SB(0, 1), cB + hstep, voffB); PG8_STAGE(PG8_SA(0, 1), cA + hstep, voffA);
        if (wr == 1) PG8_BAR;
        PG8_WAIT_V(4); PG8_BAR;
        PG8_STAGE(PG8_SB(1, 0), cB + kstep, voffB); PG8_STAGE(PG8_SA(1, 0), cA + kstep, voffA); PG8_STAGE(PG8_SB(1, 1), cB + hstep + kstep, voffB);
        PG8_WAIT_V(6); PG8_BAR;
    }
    for (;;) {
        const bool has_next = S.next(ui + 1, nxt);
        const char* nA = has_next ? (const char*)g.A + (size_t)nxt.pm * tstep : cA; const char* nB = has_next ? (const char*)g.Bt + (size_t)nxt.pn * tstep : cB;
        for (int t = 0; t < nt; t += 2) {
            const bool last = (t == nt - 2);
            const char* a1 = cA + (size_t)(t + 1) * kstep;
            const char* a2 = last ? nA : cA + (size_t)(t + 2) * kstep; const char* b2 = last ? nB : cB + (size_t)(t + 2) * kstep;
            const char* a3 = a2 + kstep; const char* b3 = b2 + kstep;
            if (last && has_next) S.a_ready(nxt);
            if constexpr (SP2) {
            PG8_LDB(B0, 0, 0); PG8_LDB(B1, 0, 1); PG8_SCHED; PG8_LDA(At, 0, 0); PG8_STAGE(PG8_SA(1, 1), a1 + hstep, voffA);
            PG8_WAIT_V(8); PG8_WAIT_L(0); PG8_BAR; PG8_MMA(0, 0, At, B0); PG8_MMA(0, 1, At, B1); PG8_BAR; PG8_SCHED;
            PG8_LDA(At, 0, 1); PG8_STAGE(PG8_SB(0, 0), b2, voffB); PG8_STAGE(PG8_SB(0, 1), b2 + hstep, voffB); PG8_STAGE(PG8_SA(0, 0), a2, voffA);
            PG8_WAIT_V(8); PG8_WAIT_L(0); PG8_BAR; PG8_MMA(1, 0, At, B0); PG8_MMA(1, 1, At, B1); PG8_BAR; PG8_SCHED;
            PG8_LDB(B0, 1, 0); PG8_LDB(B1, 1, 1); PG8_SCHED; PG8_LDA(At, 1, 0); PG8_STAGE(PG8_SA(0, 1), a2 + hstep, voffA);
            PG8_WAIT_V(8); PG8_WAIT_L(0); PG8_BAR; PG8_MMA(0, 0, At, B0); PG8_MMA(0, 1, At, B1); PG8_BAR; PG8_SCHED;
            PG8_LDA(At, 1, 1); PG8_STAGE(PG8_SB(1, 0), b3, voffB); PG8_STAGE(PG8_SB(1, 1), b3 + hstep, voffB); PG8_STAGE(PG8_SA(1, 0), a3, voffA);
            PG8_WAIT_V(8); PG8_WAIT_L(0); PG8_BAR; PG8_MMA(1, 0, At, B0); PG8_MMA(1, 1, At, B1); PG8_BAR; PG8_SCHED;
            } else {
            PG8_LDB(B0, 0, 0); PG8_SCHED; PG8_LDA(At, 0, 0); PG8_STAGE(PG8_SA(1, 1), a1 + hstep, voffA);
            PG8_WAIT_L(8); PG8_BAR; PG8_WAIT_L(0); PG8_MMA(0, 0, At, B0); PG8_BAR; PG8_SCHED;
            PG8_LDB(B1, 0, 1); PG8_STAGE(PG8_SB(0, 0), b2, voffB);
            PG8_BAR; PG8_WAIT_L(0); PG8_MMA(0, 1, At, B1); PG8_BAR;
            PG8_LDA(At, 0, 1); PG8_STAGE(PG8_SA(0, 0), a2, voffA);
            PG8_BAR; PG8_WAIT_L(0); PG8_MMA(1, 0, At, B0); PG8_BAR; PG8_SCHED;
            PG8_STAGE(PG8_SB(0, 1), b2 + hstep, voffB);
            PG8_WAIT_V(6); PG8_BAR; PG8_MMA(1, 1, At, B1); PG8_BAR;
            PG8_LDB(B0, 1, 0); PG8_SCHED; PG8_LDA(At, 1, 0); PG8_STAGE(PG8_SA(0, 1), a2 + hstep, voffA);
            PG8_WAIT_L(8); PG8_BAR; PG8_WAIT_L(0); PG8_MMA(0, 0, At, B0); PG8_BAR; PG8_SCHED;
            PG8_LDB(B1, 1, 1); PG8_STAGE(PG8_SB(1, 0), b3, voffB);
            PG8_BAR; PG8_WAIT_L(0); PG8_MMA(0, 1, At, B1); PG8_BAR;
            PG8_LDA(At, 1, 1); PG8_STAGE(PG8_SA(1, 0), a3, voffA);
            PG8_BAR; PG8_WAIT_L(0); PG8_MMA(1, 0, At, B0); PG8_BAR; PG8_SCHED;
            PG8_STAGE(PG8_SB(1, 1), b3 + hstep, voffB);
            PG8_WAIT_V(6); PG8_BAR; PG8_MMA(1, 1, At, B1); PG8_BAR;
            }
        }
        if constexpr (ALIGN_EPI) { if (wr == 0) PG8_BAR; }
        if constexpr (!Epi::AFTER_DRAIN) { E(acc, cur, wr, wc, fr, fq); S.done(cur); }
        if (!has_next) break;
#pragma unroll
        for (int a = 0; a < 2; ++a)
#pragma unroll
            for (int b = 0; b < 2; ++b)
#pragma unroll
                for (int m = 0; m < 4; ++m)
#pragma unroll
                    for (int n = 0; n < 2; ++n) acc[a][b][m][n] = (f32x4){0.f, 0.f, 0.f, 0.f};
        cur = nxt; cA = nA; cB = nB; ++ui;
        if constexpr (ALIGN_EPI) { if (wr == 1) PG8_BAR; }
    }
    PG8_WAIT_V(0);
    if constexpr (!ALIGN_EPI) { if (wr == 0) PG8_BAR; }
    PG8_BAR;
#undef PG8_SA
#undef PG8_SB
#undef PG8_STAGE
#undef PG8_LDA
#undef PG8_LDB
#undef PG8_MMA
#undef PG8_WAIT_V
#undef PG8_WAIT_L
#undef PG8_BAR
#undef PG8_SCHED
}
}

struct Params {
    const float* in[31];
    float* out;
    unsigned char* ws;
};
typedef const __attribute__((address_space(4))) Params* KP;
enum { I_X = 0, I_POS, I_LN_MIX_PRE, I_LN_MIX_POST, I_LN_MLP_PRE, I_LN_MLP_POST, I_W_IN, I_W_OUT, I_LAM_RE, I_LAM_IM, I_B_RE, I_B_IM, I_C_RE, I_C_IM,
       I_SSM_D, I_LOG_DT, I_W_GLU, I_CONV, I_B_I, I_B_F, I_PE_K, I_W1_K, I_W2_K, I_PE_V, I_W1_V, I_W2_V, I_GN_SSM, I_GN_MLSTM, I_GN_NSA, I_MLP_W1, I_MLP_W2 };

constexpr int LDS_BYTES = 147456;
constexpr int MISC_OFF = 131072 + 8192;

__device__ __forceinline__ int win_src_col(int n) {
    if (n < 1280) return n;
    if (n < 2560) return n + 8;
    if (n < 2568) return n - 2560 + 1280;
    if (n < 2592) return n;
    return -1;
}
__device__ __forceinline__ void conv_item(const float* W, int K, int N, bf16_t* WT, int mode, int nblk, LAS float* scr, int item, int lane) {
    const int kb = item / nblk, nb = item % nblk, k0 = 64 * kb, n0 = 32 * nb;
    const int nn = n0 + (lane & 31);
    const int sc = mode ? win_src_col(nn) : nn;
#pragma unroll 8
    for (int i = 0; i < 32; ++i) { const int kk = 2 * i + (lane >> 5); scr[kk * 33 + (lane & 31)] = (sc >= 0) ? W[(size_t)(k0 + kk) * N + sc] : 0.f; }
    asm volatile("s_waitcnt lgkmcnt(0)" ::: "memory");
    const int c = lane & 7;
#pragma unroll
    for (int j = 0; j < 4; ++j) { const int n = (lane >> 3) + 8 * j; const LAS float* s = scr + (8 * c) * 33 + n;
        u32x4 o; o.x = cvt_pk_bf16(s[0 * 33], s[1 * 33]); o.y = cvt_pk_bf16(s[2 * 33], s[3 * 33]); o.z = cvt_pk_bf16(s[4 * 33], s[5 * 33]); o.w = cvt_pk_bf16(s[6 * 33], s[7 * 33]);
        *(u32x4*)(WT + (size_t)(n0 + n) * K + k0 + 8 * c) = o; }
    asm volatile("s_waitcnt lgkmcnt(0)" ::: "memory");
}

__device__ __forceinline__ void convert_layer(KP P, int l, ldsp lds, int gw, int NGW, int wave, int lane) {
    LAS float* scr = (LAS float*)(lds + wave * 16384);
    unsigned char* ws = P->ws;
    constexpr int I0 = 16 * 88, I1 = 16 * 32, I2 = 16 * 128, I3 = 64 * 32, I4 = 4 * 8, I5 = 32 * 8, I6 = 32 * 8, I7 = 4 * 2, I8 = 4 * 2, I9 = 8;
    constexpr int NIT = I0 + I1 + I2 + I3 + I4 + I5 + I6 + I7 + I8 + I9;
    for (int it = gw; it < NIT; it += NGW) {
        int r = it;
        if (r < I0) { conv_item(P->in[I_W_IN] + (size_t)l * DM * DIN, DM, DIN, (bf16_t*)(ws + WS_WIN), 1, 88, scr, r, lane); continue; } r -= I0;
        if (r < I1) { conv_item(P->in[I_W_OUT] + (size_t)l * DM * DM, DM, DM, (bf16_t*)(ws + WS_WOUT), 0, 32, scr, r, lane); continue; } r -= I1;
        if (r < I2) { conv_item(P->in[I_MLP_W1] + (size_t)l * DM * DFF, DM, DFF, (bf16_t*)(ws + WS_W1), 0, 128, scr, r, lane); continue; } r -= I2;
        if (r < I3) { conv_item(P->in[I_MLP_W2] + (size_t)l * DFF * DM, DFF, DM, (bf16_t*)(ws + WS_W2), 0, 32, scr, r, lane); continue; } r -= I3;
        if (r < I4) { conv_item(P->in[I_W_GLU] + (size_t)l * 256 * 256, 256, 256, (bf16_t*)(ws + WS_WGLU), 0, 8, scr, r, lane); continue; } r -= I4;
        if (r < I5) { conv_item(P->in[I_W1_K] + (size_t)l * 2048 * 256, 2048, 256, (bf16_t*)(ws + WS_CW1K), 0, 8, scr, r, lane); continue; } r -= I5;
        if (r < I6) { conv_item(P->in[I_W1_V] + (size_t)l * 2048 * 256, 2048, 256, (bf16_t*)(ws + WS_CW1V), 0, 8, scr, r, lane); continue; } r -= I6;
        if (r < I7) { conv_item(P->in[I_W2_K] + (size_t)l * 256 * 64, 256, 64, (bf16_t*)(ws + WS_CW2K), 0, 2, scr, r, lane); continue; } r -= I7;
        if (r < I8) { conv_item(P->in[I_W2_V] + (size_t)l * 256 * 64, 256, 64, (bf16_t*)(ws + WS_CW2V), 0, 2, scr, r, lane); continue; } r -= I8;
        {
            const int kv = r >> 2, hid = (r & 3) * 64 + lane;
            const float* pe = P->in[kv ? I_PE_V : I_PE_K] + (size_t)l * 2048;
            const float* w1 = P->in[kv ? I_W1_V : I_W1_K] + (size_t)l * 2048 * 256;
            float a = 0.f;
            for (int k = 0; k < 2048; ++k) a += pe[k] * w1[(size_t)k * 256 + hid];
            ((float*)(ws + WS_CB1))[kv * 256 + hid] = a;
        }
    }
}

__device__ __forceinline__ void norm_pass(const float* xin, const bf16_t* f, const float* gpost, const float* gpre, float* h, bf16_t* u, int gw, int NGW, int lane) {
    for (int m = gw; m < MTOK; m += NGW) {
        f32x4 hv[4];
        if (f == nullptr) {
#pragma unroll
            for (int j = 0; j < 4; ++j) hv[j] = *(const f32x4*)(xin + (size_t)m * DM + 4 * lane + 256 * j);
        } else {
            f32x4 fv[4]; float ss = 0.f;
#pragma unroll
            for (int j = 0; j < 4; ++j) {
                hv[j] = *(const f32x4*)(h + (size_t)m * DM + 4 * lane + 256 * j);
                const u32x2 w = *(const u32x2*)(f + (size_t)m * DM + 4 * lane + 256 * j);
                fv[j][0] = __uint_as_float(w.x << 16); fv[j][1] = __uint_as_float(w.x & 0xffff0000u); fv[j][2] = __uint_as_float(w.y << 16); fv[j][3] = __uint_as_float(w.y & 0xffff0000u);
                ss += fv[j][0] * fv[j][0] + fv[j][1] * fv[j][1] + fv[j][2] * fv[j][2] + fv[j][3] * fv[j][3];
            }
            ss = wave_sum(ss);
            const float rs = rsqrtf(ss * (1.0f / DM) + EPS);
#pragma unroll
            for (int j = 0; j < 4; ++j) { const f32x4 g = *(const f32x4*)(gpost + 4 * lane + 256 * j); hv[j] += fv[j] * rs * g; }
        }
#pragma unroll
        for (int j = 0; j < 4; ++j) *(f32x4*)(h + (size_t)m * DM + 4 * lane + 256 * j) = hv[j];
        if (gpre) {
            float ss = 0.f;
#pragma unroll
            for (int j = 0; j < 4; ++j) ss += hv[j][0] * hv[j][0] + hv[j][1] * hv[j][1] + hv[j][2] * hv[j][2] + hv[j][3] * hv[j][3];
            ss = wave_sum(ss);
            const float rs = rsqrtf(ss * (1.0f / DM) + EPS);
#pragma unroll
            for (int j = 0; j < 4; ++j) { const f32x4 g = *(const f32x4*)(gpre + 4 * lane + 256 * j); const f32x4 o = hv[j] * rs * g;
                u32x2 w; w.x = cvt_pk_bf16(o[0], o[1]); w.y = cvt_pk_bf16(o[2], o[3]); *(u32x2*)(u + (size_t)m * DM + 4 * lane + 256 * j) = w; }
        }
    }
}

struct S5P { float ar, ai; float bbr[16], bbi[16]; };
__device__ __forceinline__ void s5_setup(KP P, int l, int g, int p, S5P& s) {
    const float dt = expf(P->in[I_LOG_DT][l * 16 + g]);
    const float lr = P->in[I_LAM_RE][(l * 16 + g) * 64 + p], li = P->in[I_LAM_IM][(l * 16 + g) * 64 + p];
    const float mag = expf(lr * dt), ang = li * dt;
    s.ar = mag * cosf(ang); s.ai = mag * sinf(ang);
    const float den = lr * lr + li * li;
    const float gr = ((s.ar - 1.0f) * lr + s.ai * li) / den, gi = (s.ai * lr - (s.ar - 1.0f) * li) / den;
    const float* br = P->in[I_B_RE] + ((size_t)(l * 16 + g) * 64 + p) * 16;
    const float* bi = P->in[I_B_IM] + ((size_t)(l * 16 + g) * 64 + p) * 16;
#pragma unroll
    for (int q = 0; q < 4; ++q) { const f32x4 a = *(const f32x4*)(br + 4 * q), b = *(const f32x4*)(bi + 4 * q);
#pragma unroll
        for (int e = 0; e < 4; ++e) { s.bbr[4 * q + e] = gr * a[e] - gi * b[e]; s.bbi[4 * q + e] = gr * b[e] + gi * a[e]; } }
}
__device__ __forceinline__ void s5_stage_u(const bf16_t* z, int m0, int g, LAS float* us, int lane) {
    const bf16_t* src = z + (size_t)(m0 + lane) * ZLD + ZC_SU + g * 16;
    const u32x4 w0 = *(const u32x4*)src, w1 = *(const u32x4*)(src + 8);
    float v[16]; unpack8(w0, v); unpack8(w1, v + 8);
#pragma unroll
    for (int q = 0; q < 4; ++q) *(LAS f32x4*)(us + lane * 16 + 4 * q) = (f32x4){v[4 * q], v[4 * q + 1], v[4 * q + 2], v[4 * q + 3]};
}
__device__ __forceinline__ void s5_step(const S5P& s, const LAS float* ut, float& xr, float& xi) {
    float bur = 0.f, bui = 0.f;
#pragma unroll
    for (int q = 0; q < 4; ++q) { const f32x4 u4 = *(const LAS f32x4*)(ut + 4 * q);
#pragma unroll
        for (int e = 0; e < 4; ++e) { bur += s.bbr[4 * q + e] * u4[e]; bui += s.bbi[4 * q + e] * u4[e]; } }
    const float nr = s.ar * xr - s.ai * xi + bur, ni = s.ar * xi + s.ai * xr + bui;
    xr = nr; xi = ni;
}

__device__ __forceinline__ void s5_stage1(KP P, int l, int bitem, ldsp lds, int wave, int lane) {
    const int wi = bitem * 8 + wave;
    const int c = wi & 31, g = (wi >> 5) & 15, b = wi >> 9;
    const bf16_t* z = (const bf16_t*)(P->ws + WS_Z);
    LAS float* us = (LAS float*)(lds + wave * 4096);
    S5P s; s5_setup(P, l, g, lane, s);
    s5_stage_u(z, b * SEQ + c * 64, g, us, lane);
    float xr = 0.f, xi = 0.f;
    for (int t = 0; t < 64; ++t) s5_step(s, us + t * 16, xr, xi);
    float* E = (float*)(P->ws + WS_S5E) + (size_t)wi * 128;
    E[lane] = xr; E[64 + lane] = xi;
}

__device__ __forceinline__ void s5_stage2(KP P, int l, int bitem, ldsp lds, int wave, int lane) {
    const int c = bitem & 31, b = bitem >> 5;
    const bf16_t* z = (const bf16_t*)(P->ws + WS_Z);
    constexpr int YLD = 264;
    const int Y_OFF = 0, US_OFF = 34816 + wave * 4096, XS_OFF = 34816 + 32768 + wave * 4352;
    LAS float* us = (LAS float*)(lds + US_OFF);
    const int r16 = lane & 15, g4 = lane >> 4;
    const int m0 = b * SEQ + c * 64;
    for (int gi = 0; gi < 2; ++gi) {
        const int g = 2 * wave + gi;
        S5P s; s5_setup(P, l, g, lane, s);
        bf16x8 Cf[4];
        {
            const float* cre = P->in[I_C_RE] + ((size_t)(l * 16 + g) * 16 + r16) * 64;
            const float* cim = P->in[I_C_IM] + ((size_t)(l * 16 + g) * 16 + r16) * 64;
#pragma unroll
            for (int ks = 0; ks < 4; ++ks) {
                const float* src = (ks < 2 ? cre : cim) + 32 * (ks & 1) + 8 * g4;
                const f32x4 a = *(const f32x4*)src, bq = *(const f32x4*)(src + 4);
                const float sg = ks < 2 ? 1.f : -1.f;
                float v[8] = {a[0] * sg, a[1] * sg, a[2] * sg, a[3] * sg, bq[0] * sg, bq[1] * sg, bq[2] * sg, bq[3] * sg};
                Cf[ks] = pack8(v);
            }
        }
        const float dsk = P->in[I_SSM_D][l * 256 + g * 16 + r16];
        s5_stage_u(z, m0, g, us, lane);
        float xr = 0.f, xi = 0.f;
        {
            float pr = s.ar, pi = s.ai;
#pragma unroll
            for (int q = 0; q < 6; ++q) { const float nr = pr * pr - pi * pi, ni = 2.f * pr * pi; pr = nr; pi = ni; }
            const float* E = (const float*)(P->ws + WS_S5E) + (size_t)((b * 16 + g) * 32) * 128;
            for (int cc = 0; cc < c; ++cc) { const float er = E[cc * 128 + lane], ei = E[cc * 128 + 64 + lane];
                const float nr = pr * xr - pi * xi + er, ni = pr * xi + pi * xr + ei; xr = nr; xi = ni; }
        }
        for (int tb = 0; tb < 4; ++tb) {
            for (int tt = 0; tt < 16; ++tt) {
                s5_step(s, us + (tb * 16 + tt) * 16, xr, xi);
                *(LAS bf16_t*)(lds + XS_OFF + (tt * 136 + lane) * 2) = f2bf(xr);
                *(LAS bf16_t*)(lds + XS_OFF + (tt * 136 + 64 + lane) * 2) = f2bf(xi);
            }
            f32x4 acc = (f32x4){0.f, 0.f, 0.f, 0.f};
#pragma unroll
            for (int ks = 0; ks < 4; ++ks) acc = mfma16(lds_frag(lds, XS_OFF + (r16 * 136 + 32 * ks + 8 * g4) * 2), Cf[ks], acc);
#pragma unroll
            for (int rg = 0; rg < 4; ++rg) {
                const int tok = tb * 16 + 4 * g4 + rg;
                float y = acc[rg] + dsk * us[tok * 16 + r16];
                y = gelu_tanh(y);
                *(LAS bf16_t*)(lds + Y_OFF + (tok * YLD + g * 16 + r16) * 2) = f2bf(y);
            }
        }
    }
    __syncthreads();
    {
        const bf16_t* wg = (const bf16_t*)(P->ws + WS_WGLU);
        f32x4 acc[4][2];
#pragma unroll
        for (int mf = 0; mf < 4; ++mf) { acc[mf][0] = (f32x4){0.f, 0.f, 0.f, 0.f}; acc[mf][1] = (f32x4){0.f, 0.f, 0.f, 0.f}; }
        for (int ks = 0; ks < 8; ++ks) {
            bf16x8 bf[2];
#pragma unroll
            for (int nf = 0; nf < 2; ++nf) bf[nf] = *(const bf16x8*)(wg + (size_t)(32 * wave + 16 * nf + r16) * 256 + 32 * ks + 8 * g4);
#pragma unroll
            for (int mf = 0; mf < 4; ++mf) { const bf16x8 af = lds_frag(lds, Y_OFF + ((16 * mf + r16) * YLD + 32 * ks + 8 * g4) * 2);
                acc[mf][0] = mfma16(af, bf[0], acc[mf][0]); acc[mf][1] = mfma16(af, bf[1], acc[mf][1]); }
        }
        bf16_t* yo = (bf16_t*)(P->ws + WS_Y);
#pragma unroll
        for (int nf = 0; nf < 2; ++nf) {
            const int n = 32 * wave + 16 * nf + r16;
            const float gn = P->in[I_GN_SSM][l * 256 + n];
#pragma unroll
            for (int mf = 0; mf < 4; ++mf)
#pragma unroll
                for (int rg = 0; rg < 4; ++rg) {
                    const int tok = 16 * mf + 4 * g4 + rg;
                    const float yv = bf2f(*(const LAS bf16_t*)(lds + Y_OFF + (tok * YLD + n) * 2));
                    const float o = yv * sigmoidf_(acc[mf][nf][rg]);
                    float ss = o * o;
                    ss += __shfl_xor(ss, 1); ss += __shfl_xor(ss, 2); ss += __shfl_xor(ss, 4); ss += __shfl_xor(ss, 8);
                    const float rs = rsqrtf(ss * (1.0f / 16.0f) + EPS);
                    yo[(size_t)(m0 + tok) * DM + n] = f2bf(o * rs * gn);
                }
        }
    }
}

__device__ __forceinline__ float log_sigmoid(float x) { return x > 0.f ? -log1pf(expf(-x)) : x - log1pf(expf(x)); }

__device__ __forceinline__ void conv_silu16(const bf16_t* z, const float* convw  , int b, int t, int zcol, int ch0, float* out) {
#pragma unroll
    for (int i = 0; i < 16; ++i) out[i] = 0.f;
#pragma unroll
    for (int j = 0; j < 4; ++j) {
        const int ts = t - 3 + j;
        if (ts >= 0) {
            const bf16_t* src = z + (size_t)(b * SEQ + ts) * ZLD + zcol;
            const u32x4 w0 = *(const u32x4*)src, w1 = *(const u32x4*)(src + 8);
            float v[16]; unpack8(w0, v); unpack8(w1, v + 8);
            const float* cw = convw + j * 512 + ch0;
#pragma unroll
            for (int q = 0; q < 4; ++q) { const f32x4 c4 = *(const f32x4*)(cw + 4 * q);
#pragma unroll
                for (int e = 0; e < 4; ++e) out[4 * q + e] += v[4 * q + e] * c4[e]; }
        }
    }
#pragma unroll
    for (int i = 0; i < 16; ++i) out[i] = out[i] * sigmoidf_(out[i]);
}

__device__ __forceinline__ void mlstm_gates(KP P, int l, int b, int hh, int c, LAS float* G, int tid) {
    const float* gate = (const float*)(P->ws + WS_GATE);
    if (tid < 128) {
        const int m = b * SEQ + c * 128 + tid;
        G[tid] = gate[(size_t)m * 32 + hh] + P->in[I_B_I][l * 4 + hh];
        G[128 + tid] = log_sigmoid(gate[(size_t)m * 32 + 4 + hh] + P->in[I_B_F][l * 4 + hh]);
    }
    __syncthreads();
    if (tid == 0) { float a = 0.f; for (int s = 0; s < 128; ++s) { a += G[128 + s]; G[128 + s] = a; } }
    __syncthreads();
}

__device__ __forceinline__ void mlstm_stage1(KP P, int l, int item, ldsp lds, int tid, int wave, int lane) {
    const int c = item & 15, hh = (item >> 4) & 3, b = item >> 6;
    const bf16_t* z = (const bf16_t*)(P->ws + WS_Z);
    constexpr int KW_OFF = 0, VT_OFF = 17408, G_OFF = 34816, LD = 136;
    LAS float* G = (LAS float*)(lds + G_OFF);
    mlstm_gates(P, l, b, hh, c, G, tid);
    if (tid == 0) { const float bL = G[128 + 127]; float mx = NEGF; for (int s = 0; s < 128; ++s) mx = fmaxf(mx, bL - G[128 + s] + G[s]); G[384] = bL; G[385] = mx; }
    __syncthreads();
    if (tid < 128) G[256 + tid] = __expf(G[384] - G[128 + tid] + G[tid] - G[385]);
    __syncthreads();
    {
        const int s = tid >> 2, q4 = tid & 3, t = c * 128 + s;
        float kv[16];
        conv_silu16(z, P->in[I_CONV] + (size_t)l * 2048, b, t, ZC_MK + hh * 64 + 16 * q4, 256 + hh * 64 + 16 * q4, kv);
        const float wk = G[256 + s] * 0.125f;
#pragma unroll
        for (int i = 0; i < 16; ++i) *(LAS bf16_t*)(lds + KW_OFF + ((16 * q4 + i) * LD + s) * 2) = f2bf(kv[i] * wk);
        const bf16_t* vs = z + (size_t)(b * SEQ + t) * ZLD + ZC_MV + hh * 64 + 16 * q4;
        const u32x4 w0 = *(const u32x4*)vs, w1 = *(const u32x4*)(vs + 8);
        const unsigned ww[8] = {w0.x, w0.y, w0.z, w0.w, w1.x, w1.y, w1.z, w1.w};
#pragma unroll
        for (int i = 0; i < 8; ++i) {
            *(LAS bf16_t*)(lds + VT_OFF + ((16 * q4 + 2 * i) * LD + s) * 2) = (bf16_t)(ww[i] & 0xffffu);
            *(LAS bf16_t*)(lds + VT_OFF + ((16 * q4 + 2 * i + 1) * LD + s) * 2) = (bf16_t)(ww[i] >> 16);
        }
    }
    __syncthreads();
    float* out = (float*)(P->ws + WS_MLC) + (size_t)item * MLC_STRIDE;
    {
        const int r16 = lane & 15, g4 = lane >> 4, mf = wave >> 1, nf0 = (wave & 1) * 2;
        f32x4 acc[2] = {(f32x4){0.f, 0.f, 0.f, 0.f}, (f32x4){0.f, 0.f, 0.f, 0.f}};
#pragma unroll
        for (int ks = 0; ks < 4; ++ks) {
            const bf16x8 af = lds_frag(lds, KW_OFF + ((16 * mf + r16) * LD + 32 * ks + 8 * g4) * 2);
#pragma unroll
            for (int nfi = 0; nfi < 2; ++nfi) acc[nfi] = mfma16(af, lds_frag(lds, VT_OFF + ((16 * (nf0 + nfi) + r16) * LD + 32 * ks + 8 * g4) * 2), acc[nfi]);
        }
#pragma unroll
        for (int nfi = 0; nfi < 2; ++nfi)
#pragma unroll
            for (int rg = 0; rg < 4; ++rg) out[(16 * mf + 4 * g4 + rg) * 64 + 16 * (nf0 + nfi) + r16] = acc[nfi][rg];
    }
    if (tid < 64) { float a = 0.f; for (int s = 0; s < 128; ++s) a += bf2f(*(const LAS bf16_t*)(lds + KW_OFF + (tid * LD + s) * 2)); out[4096 + tid] = a; }
    if (tid == 0) { out[4160] = G[384]; out[4161] = G[385]; }
}

__device__ __forceinline__ void mlstm_stage2(KP P, int l, int item, ldsp lds, int tid, int wave, int lane) {
    const int c = item & 15, hh = (item >> 4) & 3, b = item >> 6;
    const bf16_t* z = (const bf16_t*)(P->ws + WS_Z);
    constexpr int Q_OFF = 0, K_OFF = 18432, VT_OFF = 36864, CT_OFF = 58624, P_OFF = 70144, G_OFF = 104960, QLD = 72, VLD = 136;
    LAS float* G = (LAS float*)(lds + G_OFF);
    mlstm_gates(P, l, b, hh, c, G, tid);
    if (tid == 0) { float mx = NEGF; for (int s = 0; s < 128; ++s) { mx = fmaxf(mx, G[s] - G[128 + s]); G[256 + s] = mx; } }
    float Cv[8]; float nv = 0.f; float Mp = 0.f;
#pragma unroll
    for (int i = 0; i < 8; ++i) Cv[i] = 0.f;
    {
        const float* base = (const float*)(P->ws + WS_MLC) + (size_t)(item - c) * MLC_STRIDE;
        for (int cc = 0; cc < c; ++cc) {
            const float* src = base + (size_t)cc * MLC_STRIDE;
            const float bL = src[4160], ml = src[4161];
            const float Mn = fmaxf(bL + Mp, ml);
            const float dec = __expf(bL + Mp - Mn), sc = __expf(ml - Mn);
            const f32x4 a = *(const f32x4*)(src + tid * 8), bq = *(const f32x4*)(src + tid * 8 + 4);
#pragma unroll
            for (int e = 0; e < 4; ++e) { Cv[e] = dec * Cv[e] + sc * a[e]; Cv[4 + e] = dec * Cv[4 + e] + sc * bq[e]; }
            if (tid < 64) nv = dec * nv + sc * src[4096 + tid];
            Mp = Mn;
        }
    }
    {
        const int dk = tid >> 3, dv0 = (tid & 7) * 8;
#pragma unroll
        for (int i = 0; i < 8; ++i) *(LAS bf16_t*)(lds + CT_OFF + ((dv0 + i) * QLD + dk) * 2) = f2bf(Cv[i]);
        if (tid < 64) *(LAS bf16_t*)(lds + CT_OFF + (64 * QLD + tid) * 2) = f2bf(nv);
        for (int e = tid; e < 15 * 64; e += 512) *(LAS bf16_t*)(lds + CT_OFF + ((65 + e / 64) * QLD + (e & 63)) * 2) = 0;
        for (int e = tid; e < 15 * 128; e += 512) *(LAS bf16_t*)(lds + VT_OFF + ((65 + e / 128) * VLD + (e & 127)) * 2) = 0;
        if (tid < 128) *(LAS bf16_t*)(lds + VT_OFF + (64 * VLD + tid) * 2) = 0x3f80;
    }
    {
        const int s = tid >> 2, q4 = tid & 3, t = c * 128 + s;
        float qv[16], kv[16];
        conv_silu16(z, P->in[I_CONV] + (size_t)l * 2048, b, t, ZC_MQ + hh * 64 + 16 * q4, hh * 64 + 16 * q4, qv);
        conv_silu16(z, P->in[I_CONV] + (size_t)l * 2048, b, t, ZC_MK + hh * 64 + 16 * q4, 256 + hh * 64 + 16 * q4, kv);
#pragma unroll
        for (int i = 0; i < 16; ++i) kv[i] *= 0.125f;
        *(LAS bf16x8*)(lds + Q_OFF + (s * QLD + 16 * q4) * 2) = pack8(qv); *(LAS bf16x8*)(lds + Q_OFF + (s * QLD + 16 * q4 + 8) * 2) = pack8(qv + 8);
        *(LAS bf16x8*)(lds + K_OFF + (s * QLD + 16 * q4) * 2) = pack8(kv); *(LAS bf16x8*)(lds + K_OFF + (s * QLD + 16 * q4 + 8) * 2) = pack8(kv + 8);
        const bf16_t* vs = z + (size_t)(b * SEQ + t) * ZLD + ZC_MV + hh * 64 + 16 * q4;
        const u32x4 w0 = *(const u32x4*)vs, w1 = *(const u32x4*)(vs + 8);
        const unsigned ww[8] = {w0.x, w0.y, w0.z, w0.w, w1.x, w1.y, w1.z, w1.w};
#pragma unroll
        for (int i = 0; i < 8; ++i) {
            *(LAS bf16_t*)(lds + VT_OFF + ((16 * q4 + 2 * i) * VLD + s) * 2) = (bf16_t)(ww[i] & 0xffffu);
            *(LAS bf16_t*)(lds + VT_OFF + ((16 * q4 + 2 * i + 1) * VLD + s) * 2) = (bf16_t)(ww[i] >> 16);
        }
    }
    __syncthreads();
    if (tid < 128) G[384 + tid] = G[128 + tid] + fmaxf(Mp, G[256 + tid]);
    __syncthreads();
    {
        const int r16 = lane & 15, g4 = lane >> 4;
        const int PW = P_OFF + wave * 4352;
        bf16x8 qf[2];
#pragma unroll
        for (int ks = 0; ks < 2; ++ks) qf[ks] = lds_frag(lds, Q_OFF + ((16 * wave + r16) * QLD + 32 * ks + 8 * g4) * 2);
        f32x4 accO[5];
#pragma unroll
        for (int nf = 0; nf < 5; ++nf) { accO[nf] = (f32x4){0.f, 0.f, 0.f, 0.f};
#pragma unroll
            for (int ks = 0; ks < 2; ++ks) accO[nf] = mfma16(qf[ks], lds_frag(lds, CT_OFF + ((16 * nf + r16) * QLD + 32 * ks + 8 * g4) * 2), accO[nf]); }
        float bt[4], mt[4];
#pragma unroll
        for (int rg = 0; rg < 4; ++rg) { const int t = 16 * wave + 4 * g4 + rg; bt[rg] = G[128 + t]; mt[rg] = G[384 + t];
            const float wi = __expf(bt[rg] + Mp - mt[rg]);
#pragma unroll
            for (int nf = 0; nf < 5; ++nf) accO[nf][rg] *= wi; }
        const int nfmax = (wave | 1);
        for (int nf = 0; nf <= nfmax; ++nf) {
            f32x4 sacc = (f32x4){0.f, 0.f, 0.f, 0.f};
            if (nf <= wave) {
#pragma unroll
                for (int ks = 0; ks < 2; ++ks) sacc = mfma16(qf[ks], lds_frag(lds, K_OFF + ((16 * nf + r16) * QLD + 32 * ks + 8 * g4) * 2), sacc);
            }
            const int s = 16 * nf + r16;
            const float ds = G[s] - G[128 + s];
#pragma unroll
            for (int rg = 0; rg < 4; ++rg) {
                const int t = 16 * wave + 4 * g4 + rg;
                const float p = (s <= t) ? sacc[rg] * __expf(bt[rg] + ds - mt[rg]) : 0.f;
                *(LAS bf16_t*)(lds + PW + ((4 * g4 + rg) * VLD + s) * 2) = f2bf(p);
            }
        }
        for (int ks = 0; ks <= (wave >> 1); ++ks) {
            const bf16x8 pf = lds_frag(lds, PW + (r16 * VLD + 32 * ks + 8 * g4) * 2);
#pragma unroll
            for (int nf = 0; nf < 5; ++nf) accO[nf] = mfma16(pf, lds_frag(lds, VT_OFF + ((16 * nf + r16) * VLD + 32 * ks + 8 * g4) * 2), accO[nf]);
        }
        bf16_t* yo = (bf16_t*)(P->ws + WS_Y);
#pragma unroll
        for (int rg = 0; rg < 4; ++rg) {
            const int t = 16 * wave + 4 * g4 + rg;
            const size_t m = (size_t)b * SEQ + c * 128 + t;
            const float den = __shfl(accO[4][rg], lane & 48);
            const float dn = fmaxf(fabsf(den), __expf(-mt[rg]));
            float o[4]; float ss = 0.f;
#pragma unroll
            for (int nf = 0; nf < 4; ++nf) {
                const float op = bf2f(z[m * ZLD + ZC_MO + hh * 64 + 16 * nf + r16]);
                o[nf] = sigmoidf_(op) * (accO[nf][rg] / dn);
                ss += o[nf] * o[nf];
            }
            ss += __shfl_xor(ss, 1); ss += __shfl_xor(ss, 2); ss += __shfl_xor(ss, 4); ss += __shfl_xor(ss, 8);
            const float rs = rsqrtf(ss * (1.0f / 64.0f) + EPS);
#pragma unroll
            for (int nf = 0; nf < 4; ++nf) yo[m * DM + 256 + hh * 64 + 16 * nf + r16] = f2bf(o[nf] * rs * P->in[I_GN_MLSTM][l * 256 + hh * 64 + 16 * nf + r16]);
        }
    }
}

__device__ __forceinline__ void compress_item(KP P, int l, int item, ldsp lds, int tid, int wave, int lane) {
    const int nt = item & 3, bg = (item >> 2) & 15, kv = item >> 6;
    const int b = bg >> 1, g = bg & 1, n0 = 32 * nt;
    const bf16_t* z = (const bf16_t*)(P->ws + WS_Z);
    constexpr int CK_OFF = 0, CLD = 72, H_OFF = 76032, HLD = 264;
    const float* rc = (const float*)(P->ws + WS_ROPE);
    for (int e = tid; e < 528 * 4; e += 512) {
        const int tk = e >> 2, q4 = e & 3, t = 16 * n0 + tk;
        float v[16];
        if (t < SEQ) {
            const size_t m = (size_t)b * SEQ + t;
            const bf16_t* src = z + m * ZLD + (kv ? ZC_CV : ZC_CK) + g * 64 + 16 * q4;
            const u32x4 w0 = *(const u32x4*)src, w1 = *(const u32x4*)(src + 8);
            unpack8(w0, v); unpack8(w1, v + 8);
            if (kv == 0 && q4 == 0) {
#pragma unroll
                for (int i = 0; i < 8; ++i) { const float cs = rc[m * 8 + i], sn = rc[(size_t)MTOK * 8 + m * 8 + i];
                    const float x1 = v[i], x2 = v[8 + i]; v[i] = bf2f(f2bf(x1 * cs - x2 * sn)); v[8 + i] = bf2f(f2bf(x2 * cs + x1 * sn)); }
            }
        } else {
#pragma unroll
            for (int i = 0; i < 16; ++i) v[i] = 0.f;
        }
        *(LAS bf16x8*)(lds + CK_OFF + (tk * CLD + 16 * q4) * 2) = pack8(v); *(LAS bf16x8*)(lds + CK_OFF + (tk * CLD + 16 * q4 + 8) * 2) = pack8(v + 8);
    }
    __syncthreads();
    const int r16 = lane & 15, g4 = lane >> 4;
    {
        const bf16_t* w1t = (const bf16_t*)(P->ws + (kv ? WS_CW1V : WS_CW1K));
        f32x4 acc[2][2];
#pragma unroll
        for (int a = 0; a < 2; ++a) { acc[a][0] = (f32x4){0.f, 0.f, 0.f, 0.f}; acc[a][1] = (f32x4){0.f, 0.f, 0.f, 0.f}; }
#pragma unroll 4
        for (int ks = 0; ks < 64; ++ks) {
            const int tt = ks >> 1, dd = 32 * (ks & 1) + 8 * g4;
            bf16x8 bf[2], af[2];
#pragma unroll
            for (int nfi = 0; nfi < 2; ++nfi) bf[nfi] = *(const bf16x8*)(w1t + (size_t)(32 * wave + 16 * nfi + r16) * 2048 + 32 * ks + 8 * g4);
#pragma unroll
            for (int mf = 0; mf < 2; ++mf) af[mf] = lds_frag(lds, CK_OFF + ((16 * (16 * mf + r16) + tt) * CLD + dd) * 2);
#pragma unroll
            for (int mf = 0; mf < 2; ++mf)
#pragma unroll
                for (int nfi = 0; nfi < 2; ++nfi) acc[mf][nfi] = mfma16(af[mf], bf[nfi], acc[mf][nfi]);
        }
        const float* cb1 = (const float*)(P->ws + WS_CB1) + kv * 256;
#pragma unroll
        for (int nfi = 0; nfi < 2; ++nfi) { const int hid = 32 * wave + 16 * nfi + r16; const float bb = cb1[hid];
#pragma unroll
            for (int mf = 0; mf < 2; ++mf)
#pragma unroll
                for (int rg = 0; rg < 4; ++rg) *(LAS bf16_t*)(lds + H_OFF + ((16 * mf + 4 * g4 + rg) * HLD + hid) * 2) = f2bf(gelu_tanh(acc[mf][nfi][rg] + bb)); }
    }
    __syncthreads();
    {
        const bf16_t* w2t = (const bf16_t*)(P->ws + (kv ? WS_CW2V : WS_CW2K));
        const int mf = wave >> 2, nf = wave & 3;
        f32x4 acc = (f32x4){0.f, 0.f, 0.f, 0.f};
#pragma unroll
        for (int ks = 0; ks < 8; ++ks)
            acc = mfma16(lds_frag(lds, H_OFF + ((16 * mf + r16) * HLD + 32 * ks + 8 * g4) * 2), *(const bf16x8*)(w2t + (size_t)(16 * nf + r16) * 256 + 32 * ks + 8 * g4), acc);
        bf16_t* dst = (bf16_t*)(P->ws + (kv ? WS_VCMP : WS_KCMP)) + (size_t)bg * 128 * 64;
#pragma unroll
        for (int rg = 0; rg < 4; ++rg) { const int n = n0 + 16 * mf + 4 * g4 + rg; dst[n * 64 + 16 * nf + r16] = (n < 127) ? f2bf(acc[rg]) : (bf16_t)0; }
    }
}

__device__ __forceinline__ void rope_item(KP P, int item, int tid) {
    bf16_t* z = (bf16_t*)(P->ws + WS_Z);
    const float* rc = (const float*)(P->ws + WS_ROPE);
    for (int e = item * 4096 + tid; e < item * 4096 + 4096; e += 512) {
        const int m = e / 12, hsel = e % 12;
        const int col = hsel < 8 ? ZC_AQ + hsel * 64 : (hsel < 10 ? ZC_SK + (hsel - 8) * 64 : ZC_WK + (hsel - 10) * 64);
        bf16_t* src = z + (size_t)m * ZLD + col;
        const u32x4 w0 = *(const u32x4*)src, w1 = *(const u32x4*)(src + 8);
        float v[16]; unpack8(w0, v); unpack8(w1, v + 8);
        const f32x4 c0 = *(const f32x4*)(rc + (size_t)m * 8), c1 = *(const f32x4*)(rc + (size_t)m * 8 + 4);
        const f32x4 s0 = *(const f32x4*)(rc + (size_t)MTOK * 8 + (size_t)m * 8), s1 = *(const f32x4*)(rc + (size_t)MTOK * 8 + (size_t)m * 8 + 4);
        const float cs[8] = {c0[0], c0[1], c0[2], c0[3], c1[0], c1[1], c1[2], c1[3]}, sn[8] = {s0[0], s0[1], s0[2], s0[3], s1[0], s1[1], s1[2], s1[3]};
        float o[16];
#pragma unroll
        for (int i = 0; i < 8; ++i) { o[i] = v[i] * cs[i] - v[8 + i] * sn[i]; o[8 + i] = v[8 + i] * cs[i] + v[i] * sn[i]; }
        *(bf16x8*)src = pack8(o); *(bf16x8*)(src + 8) = pack8(o + 8);
    }
}

struct NsaCtx { int tq; unsigned selm; };
template <int MODE  >
__device__ __forceinline__ void nsa_tile(ldsp lds, int kbase, const bf16x8 (&Qf)[2][2], f32x4 (&OB)[4][2], float (&mrun)[2], float (&lrun)[2], int tq, bool selbit, int r16, int g4) {
    constexpr int KS_OFF = 0, VT_OFF = 18432, KLD = 72, VLD = 136;
    constexpr float SC2 = 0.125f * 1.4426950408889634f;
#pragma unroll
    for (int f = 0; f < 2; ++f) {
        f32x4 S[4];
#pragma unroll
        for (int kf = 0; kf < 4; ++kf) { S[kf] = (f32x4){0.f, 0.f, 0.f, 0.f};
#pragma unroll
            for (int ks = 0; ks < 2; ++ks) S[kf] = mfma16(lds_frag(lds, KS_OFF + ((16 * kf + r16) * KLD + 32 * ks + 8 * g4) * 2), Qf[f][ks], S[kf]); }
        float mx = NEGF; bool ok[4][4];
#pragma unroll
        for (int kf = 0; kf < 4; ++kf)
#pragma unroll
            for (int rg = 0; rg < 4; ++rg) {
                const int kp = kbase + 16 * kf + 4 * g4 + rg;
                bool v;
                if (MODE == 1) v = selbit && (kp <= tq); else v = (kp <= tq) && (tq - kp < 256);
                ok[kf][rg] = v;
                const float s = v ? S[kf][rg] * SC2 : NEGF;
                S[kf][rg] = s; mx = fmaxf(mx, s);
            }
        mx = fmaxf(mx, __shfl_xor(mx, 16)); mx = fmaxf(mx, __shfl_xor(mx, 32));
        const float mn = fmaxf(mrun[f], mx);
        const float alpha = exp2f(mrun[f] - mn);
        float ls = 0.f;
#pragma unroll
        for (int kf = 0; kf < 4; ++kf)
#pragma unroll
            for (int rg = 0; rg < 4; ++rg) { const float p = ok[kf][rg] ? exp2f(S[kf][rg] - mn) : 0.f; S[kf][rg] = p; ls += p; }
        ls += __shfl_xor(ls, 16); ls += __shfl_xor(ls, 32);
        lrun[f] = lrun[f] * alpha + ls; mrun[f] = mn;
#pragma unroll
        for (int df = 0; df < 4; ++df) OB[df][f] *= alpha;
#pragma unroll
        for (int k2 = 0; k2 < 2; ++k2) {
            const float pv[8] = {S[2 * k2][0], S[2 * k2][1], S[2 * k2][2], S[2 * k2][3], S[2 * k2 + 1][0], S[2 * k2 + 1][1], S[2 * k2 + 1][2], S[2 * k2 + 1][3]};
            const bf16x8 pb = pack8(pv);
#pragma unroll
            for (int df = 0; df < 4; ++df) {
                const bf16x4 lo = *(const LAS bf16x4*)(lds + VT_OFF + ((16 * df + r16) * VLD + 32 * k2 + 4 * g4) * 2);
                const bf16x4 hi = *(const LAS bf16x4*)(lds + VT_OFF + ((16 * df + r16) * VLD + 32 * k2 + 16 + 4 * g4) * 2);
                const bf16x8 va = __builtin_shufflevector(lo, hi, 0, 1, 2, 3, 4, 5, 6, 7);
                OB[df][f] = mfma16(va, pb, OB[df][f]);
            }
        }
    }
}

__device__ __forceinline__ void nsa_load_tile(ldsp lds, const bf16_t* kbase, const bf16_t* vbase, size_t ld, int keyoff, int tid) {
    constexpr int KS_OFF = 0, VT_OFF = 18432, KLD = 72, VLD = 136;
    const int key = tid >> 3, dc = tid & 7;
    const u32x4 kw = *(const u32x4*)(kbase + (size_t)key * ld + 8 * dc);
    const u32x4 vw = *(const u32x4*)(vbase + (size_t)key * ld + 8 * dc);
    *(LAS u32x4*)(lds + KS_OFF + ((keyoff + key) * KLD + 8 * dc) * 2) = kw;
    const unsigned ww[4] = {vw.x, vw.y, vw.z, vw.w};
#pragma unroll
    for (int i = 0; i < 4; ++i) {
        *(LAS bf16_t*)(lds + VT_OFF + ((8 * dc + 2 * i) * VLD + keyoff + key) * 2) = (bf16_t)(ww[i] & 0xffffu);
        *(LAS bf16_t*)(lds + VT_OFF + ((8 * dc + 2 * i + 1) * VLD + keyoff + key) * 2) = (bf16_t)(ww[i] >> 16);
    }
}

__device__ __forceinline__ void nsa_item(KP P, int l, int item, ldsp lds, int tid, int wave, int lane) {
    const int qt = 31 - (item >> 4), bg = item & 15, b = bg >> 1, g = bg & 1;
    const int T0 = 64 * qt;
    const bf16_t* z = (const bf16_t*)(P->ws + WS_Z);
    const float* gate = (const float*)(P->ws + WS_GATE);
    constexpr int KS_OFF = 0, VT_OFF = 18432, KLD = 72, VLD = 136, IMP_OFF = 35840, SEL_OFF = 52224, OR_OFF = 52480;
    constexpr float SC2 = 0.125f * 1.4426950408889634f;
    const int r16 = lane & 15, g4 = lane >> 4;
    const int tq = T0 + 8 * wave + (r16 & 7);
    const size_t mq = (size_t)b * SEQ + tq;
    int hd[2]; hd[0] = 4 * g + (r16 >> 3); hd[1] = 4 * g + 2 + (r16 >> 3);
    bf16x8 Qf[2][2];
#pragma unroll
    for (int f = 0; f < 2; ++f)
#pragma unroll
        for (int ks = 0; ks < 2; ++ks) Qf[f][ks] = *(const bf16x8*)(z + mq * ZLD + ZC_AQ + hd[f] * 64 + 32 * ks + 8 * g4);
    float gt[2][3];
#pragma unroll
    for (int f = 0; f < 2; ++f)
#pragma unroll
        for (int br = 0; br < 3; ++br) gt[f][br] = sigmoidf_(gate[mq * 32 + 8 + hd[f] * 3 + br]);
    f32x4 OF[4][2], OB[4][2];
    if (tid == 0) *(LAS unsigned*)(lds + OR_OFF) = 0u;
    {
        const bf16_t* kc = (const bf16_t*)(P->ws + WS_KCMP) + (size_t)bg * 128 * 64;
        const bf16_t* vc = (const bf16_t*)(P->ws + WS_VCMP) + (size_t)bg * 128 * 64;
        nsa_load_tile(lds, kc, vc, 64, 0, tid);
        nsa_load_tile(lds, kc + 64 * 64, vc + 64 * 64, 64, 64, tid);
        __syncthreads();
        f32x4 ps[8];
#pragma unroll
        for (int kf = 0; kf < 8; ++kf) ps[kf] = (f32x4){0.f, 0.f, 0.f, 0.f};
#pragma unroll
        for (int f = 0; f < 2; ++f) {
            f32x4 S[8];
#pragma unroll
            for (int kf = 0; kf < 8; ++kf) { S[kf] = (f32x4){0.f, 0.f, 0.f, 0.f};
#pragma unroll
                for (int ks = 0; ks < 2; ++ks) S[kf] = mfma16(lds_frag(lds, KS_OFF + ((16 * kf + r16) * KLD + 32 * ks + 8 * g4) * 2), Qf[f][ks], S[kf]); }
            float mx = NEGF;
#pragma unroll
            for (int kf = 0; kf < 8; ++kf)
#pragma unroll
                for (int rg = 0; rg < 4; ++rg) { const int n = 16 * kf + 4 * g4 + rg; const bool v = (16 * n + 31 <= tq); const float s = v ? S[kf][rg] * SC2 : NEGF; S[kf][rg] = s; mx = fmaxf(mx, s); }
            mx = fmaxf(mx, __shfl_xor(mx, 16)); mx = fmaxf(mx, __shfl_xor(mx, 32));
            float ls = 0.f;
#pragma unroll
            for (int kf = 0; kf < 8; ++kf)
#pragma unroll
                for (int rg = 0; rg < 4; ++rg) { const int n = 16 * kf + 4 * g4 + rg; const bool v = (16 * n + 31 <= tq); const float p = v ? exp2f(S[kf][rg] - mx) : 0.f; S[kf][rg] = p; ls += p; }
            ls += __shfl_xor(ls, 16); ls += __shfl_xor(ls, 32);
            const float inv = ls > 0.f ? 1.0f / ls : 0.f;
#pragma unroll
            for (int kf = 0; kf < 8; ++kf) { S[kf] *= inv; ps[kf] += S[kf]; }
#pragma unroll
            for (int df = 0; df < 4; ++df) OB[df][f] = (f32x4){0.f, 0.f, 0.f, 0.f};
#pragma unroll
            for (int k2 = 0; k2 < 4; ++k2) {
                const float pv[8] = {S[2 * k2][0], S[2 * k2][1], S[2 * k2][2], S[2 * k2][3], S[2 * k2 + 1][0], S[2 * k2 + 1][1], S[2 * k2 + 1][2], S[2 * k2 + 1][3]};
                const bf16x8 pb = pack8(pv);
#pragma unroll
                for (int df = 0; df < 4; ++df) {
                    const bf16x4 lo = *(const LAS bf16x4*)(lds + VT_OFF + ((16 * df + r16) * VLD + 32 * k2 + 4 * g4) * 2);
                    const bf16x4 hi = *(const LAS bf16x4*)(lds + VT_OFF + ((16 * df + r16) * VLD + 32 * k2 + 16 + 4 * g4) * 2);
                    OB[df][f] = mfma16(__builtin_shufflevector(lo, hi, 0, 1, 2, 3, 4, 5, 6, 7), pb, OB[df][f]);
                }
            }
#pragma unroll
            for (int df = 0; df < 4; ++df) OF[df][f] = OB[df][f] * gt[f][0];
        }
        LAS float* impA = (LAS float*)(lds + IMP_OFF + wave * 2048);
        LAS float* impB = impA + 256;
#pragma unroll
        for (int kf = 0; kf < 8; ++kf) {
            f32x4 v = ps[kf];
#pragma unroll
            for (int e = 0; e < 4; ++e) v[e] += __shfl_xor(v[e], 8);
            if (r16 < 8) {
                const int j = 4 * kf + g4;
                impA[r16 * 32 + j] = 2.0f * (v[0] + v[1] + v[2]) + v[3];
                if (j < 31) impB[r16 * 32 + j + 1] = v[3];
                if (j == 0) impB[r16 * 32] = 0.f;
            }
        }
        {
            const int tk = lane & 7, jg = lane >> 3;
            const int tt = T0 + 8 * wave + tk, jcur = tt >> 6;
            float myv[4];
#pragma unroll
            for (int i = 0; i < 4; ++i) { const int j = 4 * jg + i; float v = impA[tk * 32 + j] + impB[tk * 32 + j];
                if (j == 0 || j == jcur) v = 1e4f; else if (j > jcur) v = -1e4f; myv[i] = v; }
            asm volatile("s_waitcnt lgkmcnt(0)" ::: "memory");
#pragma unroll
            for (int i = 0; i < 4; ++i) impA[tk * 32 + 4 * jg + i] = myv[i];
            asm volatile("s_waitcnt lgkmcnt(0)" ::: "memory");
            int cnt[4] = {0, 0, 0, 0};
            for (int j2 = 0; j2 < 32; ++j2) { const float v2 = impA[tk * 32 + j2];
#pragma unroll
                for (int i = 0; i < 4; ++i) { const int j = 4 * jg + i; cnt[i] += (v2 > myv[i] || (v2 == myv[i] && j2 < j)) ? 1 : 0; } }
            unsigned bits = 0u;
#pragma unroll
            for (int i = 0; i < 4; ++i) { const int j = 4 * jg + i; if (cnt[i] < 8 && j <= jcur) bits |= (1u << j); }
            bits |= __shfl_xor(bits, 8); bits |= __shfl_xor(bits, 16); bits |= __shfl_xor(bits, 32);
            if (lane < 8) { *(LAS unsigned*)(lds + SEL_OFF + (wave * 8 + lane) * 4) = bits; __hip_atomic_fetch_or((LAS unsigned*)(lds + OR_OFF), bits, __ATOMIC_RELAXED, __HIP_MEMORY_SCOPE_WORKGROUP); }
        }
    }
    __syncthreads();
    const unsigned selm = *(const LAS unsigned*)(lds + SEL_OFF + (wave * 8 + (r16 & 7)) * 4);
    const unsigned selor = *(const LAS unsigned*)(lds + OR_OFF);
    {
        float mrun[2] = {NEGF, NEGF}, lrun[2] = {0.f, 0.f};
#pragma unroll
        for (int f = 0; f < 2; ++f)
#pragma unroll
            for (int df = 0; df < 4; ++df) OB[df][f] = (f32x4){0.f, 0.f, 0.f, 0.f};
        for (int j = 0; j <= qt; ++j) {
            if (!((selor >> j) & 1u)) continue;
            __syncthreads();
            nsa_load_tile(lds, z + ((size_t)b * SEQ + 64 * j) * ZLD + ZC_SK + g * 64, z + ((size_t)b * SEQ + 64 * j) * ZLD + ZC_SV + g * 64, ZLD, 0, tid);
            __syncthreads();
            nsa_tile<1>(lds, 64 * j, Qf, OB, mrun, lrun, tq, ((selm >> j) & 1u) != 0u, r16, g4);
        }
#pragma unroll
        for (int f = 0; f < 2; ++f) { const float sc = gt[f][1] / lrun[f];
#pragma unroll
            for (int df = 0; df < 4; ++df) OF[df][f] += OB[df][f] * sc; }
    }
    {
        float mrun[2] = {NEGF, NEGF}, lrun[2] = {0.f, 0.f};
#pragma unroll
        for (int f = 0; f < 2; ++f)
#pragma unroll
            for (int df = 0; df < 4; ++df) OB[df][f] = (f32x4){0.f, 0.f, 0.f, 0.f};
        for (int j = (qt >= 4 ? qt - 4 : 0); j <= qt; ++j) {
            __syncthreads();
            nsa_load_tile(lds, z + ((size_t)b * SEQ + 64 * j) * ZLD + ZC_WK + g * 64, z + ((size_t)b * SEQ + 64 * j) * ZLD + ZC_WV + g * 64, ZLD, 0, tid);
            __syncthreads();
            nsa_tile<2>(lds, 64 * j, Qf, OB, mrun, lrun, tq, true, r16, g4);
        }
#pragma unroll
        for (int f = 0; f < 2; ++f) { const float sc = gt[f][2] / lrun[f];
#pragma unroll
            for (int df = 0; df < 4; ++df) OF[df][f] += OB[df][f] * sc; }
    }
    {
        bf16_t* yo = (bf16_t*)(P->ws + WS_Y);
#pragma unroll
        for (int f = 0; f < 2; ++f) {
            float ss = 0.f;
#pragma unroll
            for (int df = 0; df < 4; ++df)
#pragma unroll
                for (int rg = 0; rg < 4; ++rg) ss += OF[df][f][rg] * OF[df][f][rg];
            ss += __shfl_xor(ss, 16); ss += __shfl_xor(ss, 32);
            const float rs = rsqrtf(ss * (1.0f / 64.0f) + EPS);
#pragma unroll
            for (int df = 0; df < 4; ++df) {
                const f32x4 gn = *(const f32x4*)(P->in[I_GN_NSA] + l * 512 + hd[f] * 64 + 16 * df + 4 * g4);
                const f32x4 o = OF[df][f] * rs * gn;
                u32x2 w; w.x = cvt_pk_bf16(o[0], o[1]); w.y = cvt_pk_bf16(o[2], o[3]);
                *(u32x2*)(yo + mq * DM + 512 + hd[f] * 64 + 16 * df + 4 * g4) = w;
            }
        }
    }
}

#ifndef EN_MASK
#define EN_MASK 0xFFFF
#endif
#define EN(b) (((EN_MASK) >> (b)) & 1)
__global__ void __launch_bounds__(512, 2) hybrid_fwd(Params P_unused) {
    KP P = (KP)__builtin_amdgcn_kernarg_segment_ptr();
    extern __shared__ __attribute__((aligned(16))) unsigned char lds_raw[];
    ldsp lds = (ldsp)lds_raw;
    cg::grid_group grid = cg::this_grid();
    const int tid0 = threadIdx.x;
    volatile LAS unsigned* misc = (volatile LAS unsigned*)(lds + MISC_OFF);
#define PHASE_BEGIN() asm volatile("" : "+s"(P)); int tid = tid0; asm volatile("" : "+v"(tid)); const int lane = tid & 63, wave = __builtin_amdgcn_readfirstlane(tid >> 6); \
    const int G = gridDim.x, gw = blockIdx.x * 8 + wave, NGW = G * 8; unsigned char* ws = P->ws; (void)lane; (void)gw; (void)NGW; (void)ws; (void)G

    {
        PHASE_BEGIN();
        if (EN(0)) norm_pass(P->in[I_X], nullptr, nullptr, P->in[I_LN_MIX_PRE], P->out, (bf16_t*)(ws + WS_U), gw, NGW, lane);
        if (EN(1)) {
            const int* pos = (const int*)P->in[I_POS];
            float* rc = (float*)(ws + WS_ROPE);
            for (int e = blockIdx.x * 512 + tid; e < MTOK * 8; e += G * 512) {
                const int m = e >> 3, j = e & 7;
                const float inv = powf(500000.0f, -(float)j * 0.125f);
                const float ang = (float)pos[m] * inv;
                rc[e] = cosf(ang); rc[(size_t)MTOK * 8 + e] = sinf(ang);
            }
        }
        if (EN(2)) convert_layer(P, 0, lds, gw, NGW, wave, lane);
    }
    grid.sync();

    for (int l = 0; l < DEPTH; ++l) {
        if (EN(3)) {
            PHASE_BEGIN();
            pg8::Gemm g{(const bf16_t*)(ws + WS_U), (const bf16_t*)(ws + WS_WIN), MTOK, ZLD, DM}; pg8::StaticOrder S; S.init(MTOK, ZLD, G, (int)blockIdx.x);
            pg8::EpiBf16<0> E{(bf16_t*)(ws + WS_Z), ZLD, (float*)(ws + WS_GATE), 10};
            pg8::gemm_phase<pg8::EpiBf16<0>, pg8::StaticOrder, true, true>(lds, g, S, E, tid);
        }
        grid.sync();
        {
            constexpr int N_CMP = 128, N_ML = 512, N_S5 = 512, N_ROPE = 48, NTOT = N_CMP + N_ML + N_S5 + N_ROPE;
            for (;;) {
                __syncthreads();
                if (tid0 == 0) misc[0] = atomicAdd((unsigned*)(P->ws + WS_CTL) + 64 * (2 * l), 1u);
                __syncthreads();
                int item = (int)misc[0];
                PHASE_BEGIN();
                if (item >= NTOT) break;
                if (item < N_CMP) { if (EN(4)) compress_item(P, l, item, lds, tid, wave, lane); continue; } item -= N_CMP;
                if (item < N_ML) { if (EN(5)) mlstm_stage1(P, l, item, lds, tid, wave, lane); continue; } item -= N_ML;
                if (item < N_S5) { if (EN(6)) s5_stage1(P, l, item, lds, wave, lane); continue; } item -= N_S5;
                if (EN(7)) rope_item(P, item, tid);
            }
        }
        grid.sync();
        {
            constexpr int N_NSA = 512, N_ML = 512, N_S5 = 256, NTOT = N_NSA + N_ML + N_S5;
            for (;;) {
                __syncthreads();
                if (tid0 == 0) misc[0] = atomicAdd((unsigned*)(P->ws + WS_CTL) + 64 * (2 * l + 1), 1u);
                __syncthreads();
                int item = (int)misc[0];
                PHASE_BEGIN();
                if (item >= NTOT) break;
                if (item < N_NSA) { if (EN(8)) nsa_item(P, l, item, lds, tid, wave, lane); continue; } item -= N_NSA;
                if (item < N_ML) { if (EN(9)) mlstm_stage2(P, l, item, lds, tid, wave, lane); continue; } item -= N_ML;
                if (EN(10)) s5_stage2(P, l, item, lds, wave, lane);
            }
        }
        grid.sync();
        if (EN(11)) {
            PHASE_BEGIN();
            pg8::Gemm g{(const bf16_t*)(ws + WS_Y), (const bf16_t*)(ws + WS_WOUT), MTOK, DM, DM}; pg8::StaticOrder S; S.init(MTOK, DM, G, (int)blockIdx.x);
            pg8::EpiBf16<0> E{(bf16_t*)(ws + WS_Z), DM, nullptr, -1};
            pg8::gemm_phase<pg8::EpiBf16<0>, pg8::StaticOrder, true, true>(lds, g, S, E, tid);
        }
        grid.sync();
        if (EN(12)) {
            PHASE_BEGIN();
            norm_pass(nullptr, (const bf16_t*)(ws + WS_Z), P->in[I_LN_MIX_POST] + l * DM, P->in[I_LN_MLP_PRE] + l * DM, P->out, (bf16_t*)(ws + WS_U), gw, NGW, lane);
        }
        grid.sync();
        if (EN(13)) {
            PHASE_BEGIN();
            pg8::Gemm g{(const bf16_t*)(ws + WS_U), (const bf16_t*)(ws + WS_W1), MTOK, DFF, DM}; pg8::StaticOrder S; S.init(MTOK, DFF, G, (int)blockIdx.x);
            pg8::EpiBf16<2> E{(bf16_t*)(ws + WS_Z), DFF, nullptr, -1};
            pg8::gemm_phase<pg8::EpiBf16<2>, pg8::StaticOrder, true, true>(lds, g, S, E, tid);
        }
        grid.sync();
        if (EN(14)) {
            PHASE_BEGIN();
            pg8::Gemm g{(const bf16_t*)(ws + WS_Z), (const bf16_t*)(ws + WS_W2), MTOK, DM, DFF}; pg8::StaticOrder S; S.init(MTOK, DM, G, (int)blockIdx.x);
            pg8::EpiBf16<0> E{(bf16_t*)(ws + WS_Y), DM, nullptr, -1};
            pg8::gemm_phase<pg8::EpiBf16<0>, pg8::StaticOrder, true, true>(lds, g, S, E, tid);
        }
        grid.sync();
        {
            PHASE_BEGIN();
            if (EN(15)) norm_pass(nullptr, (const bf16_t*)(ws + WS_Y), P->in[I_LN_MLP_POST] + l * DM, (l + 1 < DEPTH) ? P->in[I_LN_MIX_PRE] + (l + 1) * DM : nullptr, P->out, (bf16_t*)(ws + WS_U), gw, NGW, lane);
            if (l + 1 < DEPTH) { if (EN(2)) convert_layer(P, l + 1, lds, gw, NGW, wave, lane); }
        }
        if (l + 1 < DEPTH) grid.sync();
    }
}

extern "C" void kernel_launch(void* const* d_in, const int* in_sizes, int n_in, void* d_out, int out_size, void* d_ws, size_t ws_size, hipStream_t stream) {
    static int grid = 0;
    if (grid == 0) {
        if (n_in != 31 || out_size != MTOK * DM || ws_size < WS_END) { fprintf(stderr, "kernel_launch: unexpected shapes (n_in %d out %d ws %zu)\n", n_in, out_size, ws_size); grid = -1; return; }
        int dev = 0, cus = 0, per_cu = 0;
        (void)hipGetDevice(&dev);
        (void)hipDeviceGetAttribute(&cus, hipDeviceAttributeMultiprocessorCount, dev);
        (void)hipFuncSetAttribute((const void*)hybrid_fwd, hipFuncAttributeMaxDynamicSharedMemorySize, LDS_BYTES);
        (void)hipOccupancyMaxActiveBlocksPerMultiprocessor(&per_cu, (const void*)hybrid_fwd, 512, LDS_BYTES);
        if (per_cu < 1) { fprintf(stderr, "kernel_launch: occupancy query says %d blocks/CU\n", per_cu); per_cu = 1; }
        grid = cus * 1;
        (void)hipGetLastError();
    }
    if (grid < 0) return;
    (void)hipMemsetAsync((char*)d_ws + WS_CTL, 0, 65536, stream);
    Params p{};
    for (int i = 0; i < 31; ++i) p.in[i] = (const float*)d_in[i];
    p.out = (float*)d_out; p.ws = (unsigned char*)d_ws;
    void* args[] = {&p};
    hipError_t e = hipLaunchCooperativeKernel((const void*)hybrid_fwd, dim3(grid), dim3(512), args, LDS_BYTES, stream);
    if (e != hipSuccess) fprintf(stderr, "cooperative launch failed: %s (grid %d)\n", hipGetErrorString(e), grid);
}
```

```cpp
#include <hip/hip_runtime.h>
#include <hip/hip_cooperative_groups.h>
#include <cstdio>
#include <cstdint>
namespace cg = cooperative_groups;

#define LAS __attribute__((address_space(3)))
typedef unsigned short bf16_t;
typedef short bf16x8 __attribute__((ext_vector_type(8)));
typedef short bf16x4 __attribute__((ext_vector_type(4)));
typedef float f32x4 __attribute__((ext_vector_type(4)));
typedef float f32x2 __attribute__((ext_vector_type(2)));
typedef unsigned u32x4 __attribute__((ext_vector_type(4)));
typedef unsigned u32x2 __attribute__((ext_vector_type(2)));
typedef LAS unsigned char* ldsp;

constexpr int NB = 8, SEQ = 2048, MTOK = NB * SEQ, DM = 1024, DEPTH = 4, DIN = 2592, ZLD = 2816, DFF = 4096;
constexpr int ZC_SU = 0, ZC_MQ = 256, ZC_MK = 512, ZC_MV = 768, ZC_MO = 1024, ZC_AQ = 1280, ZC_CK = 1792, ZC_CV = 1920,
              ZC_SK = 2048, ZC_SV = 2176, ZC_WK = 2304, ZC_WV = 2432, ZC_G = 2560;
constexpr float EPS = 1e-6f;
constexpr float NEGF = -1e30f;

constexpr size_t MiB = 1u << 20;
constexpr size_t WS_CTL = 0;
constexpr size_t WS_WIN = 1 * MiB;
constexpr size_t WS_WOUT = 7 * MiB;
constexpr size_t WS_W1 = 9 * MiB;
constexpr size_t WS_W2 = 17 * MiB;
constexpr size_t WS_WGLU = 25 * MiB;
constexpr size_t WS_CW1K = 25 * MiB + 256 * 1024;
constexpr size_t WS_CW1V = 26 * MiB + 256 * 1024;
constexpr size_t WS_CW2K = 27 * MiB + 256 * 1024;
constexpr size_t WS_CW2V = 27 * MiB + 320 * 1024;
constexpr size_t WS_CB1 = 27 * MiB + 384 * 1024;
constexpr size_t WS_ROPE = 28 * MiB;
constexpr size_t WS_GATE = 29 * MiB;
constexpr size_t WS_S5E = 31 * MiB;
constexpr size_t WS_MLC = 33 * MiB;
constexpr size_t WS_KCMP = 42 * MiB;
constexpr size_t WS_VCMP = 42 * MiB + 512 * 1024;
constexpr size_t WS_U = 44 * MiB;
constexpr size_t WS_Y = 76 * MiB;
constexpr size_t WS_Z = 108 * MiB;
constexpr size_t WS_END = 236 * MiB;
constexpr int MLC_STRIDE = 4224;

__device__ __forceinline__ float bf2f(unsigned short v) { return __uint_as_float(((unsigned)v) << 16); }
__device__ __forceinline__ unsigned cvt_pk_bf16(float lo, float hi) { unsigned r; asm volatile("v_cvt_pk_bf16_f32 %0, %1, %2" : "=v"(r) : "v"(lo), "v"(hi)); return r; }
__device__ __forceinline__ unsigned short f2bf(float f) { return (unsigned short)(cvt_pk_bf16(f, 0.f) & 0xffffu); }
__device__ __forceinline__ float wave_sum(float v) {
#pragma unroll
    for (int o = 1; o < 64; o <<= 1) v += __shfl_xor(v, o);
    return v;
}
__device__ __forceinline__ float sigmoidf_(float x) { return 1.0f / (1.0f + __expf(-x)); }
__device__ __forceinline__ float gelu_tanh(float x) {
    const float a = 0.7978845608028654f * (x + 0.044715f * x * x * x);
    const float e = __expf(2.0f * a);
    const float t = 1.0f - 2.0f / (e + 1.0f);
    return 0.5f * x * (1.0f + t);
}
__device__ __forceinline__ f32x4 mfma16(bf16x8 a, bf16x8 b, f32x4 c) { return __builtin_amdgcn_mfma_f32_16x16x32_bf16(a, b, c, 0, 0, 0); }
__device__ __forceinline__ bf16x8 lds_frag(ldsp lds, int byteoff) { return *(const LAS bf16x8*)(lds + byteoff); }
__device__ __forceinline__ bf16x8 pack8(const float* v) {
    u32x4 w; w.x = cvt_pk_bf16(v[0], v[1]); w.y = cvt_pk_bf16(v[2], v[3]); w.z = cvt_pk_bf16(v[4], v[5]); w.w = cvt_pk_bf16(v[6], v[7]);
    return __builtin_bit_cast(bf16x8, w);
}
__device__ __forceinline__ void unpack8(u32x4 w, float* v) {
    v[0] = __uint_as_float(w.x << 16); v[1] = __uint_as_float(w.x & 0xffff0000u);
    v[2] = __uint_as_float(w.y << 16); v[3] = __uint_as_float(w.y & 0xffff0000u);
    v[4] = __uint_as_float(w.z << 16); v[5] = __uint_as_float(w.z & 0xffff0000u);
    v[6] = __uint_as_float(w.w << 16); v[7] = __uint_as_float(w.w & 0xffff0000u);
}

namespace pg8 {
#define PG8_LAS __attribute__((address_space(3)))
constexpr int BM = 256, BK = 64, HALF = 128, HTB = HALF * BK * 2, STAGE_BYTES = 8 * HTB, NXCD = 8, WGM = 8;
__host__ __device__ __forceinline__ int lds_byte(int r, int c) { const int st = (r >> 4) * 2 + (c >> 5), rr = r & 15, cc = c & 31, ob = rr * 64 + cc * 2; return st * 1024 + (ob ^ (((ob >> 9) & 1) << 5)); }
__host__ __device__ __forceinline__ void stage_rc(int b, int& R, int& C) { const int st = b / 1024, sb = b % 1024, swz = sb ^ (((sb >> 9) & 1) << 5); R = (st >> 1) * 16 + swz / 64; C = (st & 1) * 32 + (swz % 64) / 2; }
__host__ __device__ __forceinline__ int perm32(int rho) { const int n = rho >> 4, i = rho & 15; return 8 * (i >> 2) + 4 * n + (i & 3); }
struct Unit { int pm, pn; };
struct Gemm { const bf16_t* A; const bf16_t* Bt; int M, N, K; };
struct StaticOrder {
    int nM, nN, nwg, G, c;
    __host__ __device__ void init(int M, int N, int G_, int c_) { nM = M / BM; nN = N / BM; nwg = nM * nN; G = G_; c = c_; }
    __host__ __device__ bool next(int i, Unit& u) const {
        const long L = (long)i * G + c; if (L >= nwg) return false;
        int wgid = (int)L; { const int q = nwg / NXCD, r = nwg % NXCD, xcd = wgid % NXCD, off = wgid / NXCD; wgid = (xcd < r ? xcd * (q + 1) : r * (q + 1) + (xcd - r) * q) + off; }
        const int nig = WGM * nN, gid = wgid / nig, fm = gid * WGM, gsz = (nM - fm) < WGM ? (nM - fm) : WGM;
        u.pm = fm + ((wgid % nig) % gsz); u.pn = (wgid % nig) / gsz; return true;
    }
    __device__ __forceinline__ void a_ready(const Unit&) const {}
    __device__ __forceinline__ void done(const Unit&) const {}
};
template <int ACT  > struct EpiBf16 {
    static constexpr bool PERM = true, AFTER_DRAIN = false;
    bf16_t* O; int ldc; float* gate; int gate_pn;
    __device__ __forceinline__ void operator()(const f32x4 (&acc)[2][2][4][2], const Unit& u, int wr, int wc, int fr, int fq) const {
        const int row0 = u.pm * BM + wr * 64 + fr;
        if (u.pn == gate_pn) {
            if (wc == 0) {
#pragma unroll
                for (int ai = 0; ai < 2; ++ai)
#pragma unroll
                    for (int m = 0; m < 4; ++m) { float* gp = gate + (size_t)(row0 + ai * HALF + m * 16) * 32 + 8 * fq;
                        *(f32x4*)(gp) = acc[ai][0][m][0]; *(f32x4*)(gp + 4) = acc[ai][0][m][1]; }
            }
            return;
        }
        const int col0 = u.pn * BM + wc * 32 + 8 * fq;
#pragma unroll
        for (int ai = 0; ai < 2; ++ai)
#pragma unroll
            for (int m = 0; m < 4; ++m) { bf16_t* rowp = O + (size_t)(row0 + ai * HALF + m * 16) * ldc + col0;
#pragma unroll
                for (int bj = 0; bj < 2; ++bj) { f32x4 v0 = acc[ai][bj][m][0], v1 = acc[ai][bj][m][1];
                    if (ACT == 2) {
#pragma unroll
                        for (int e = 0; e < 4; ++e) { float a = fmaxf(v0[e], 0.f); v0[e] = a * a; float b = fmaxf(v1[e], 0.f); v1[e] = b * b; }
                    }
                    u32x4 w; w.x = cvt_pk_bf16(v0[0], v0[1]); w.y = cvt_pk_bf16(v0[2], v0[3]); w.z = cvt_pk_bf16(v1[0], v1[1]); w.w = cvt_pk_bf16(v1[2], v1[3]);
                    *(u32x4*)(rowp + bj * HALF) = w; } }
    }
};

template <class Epi, class Sched, bool ALIGN_EPI = false, bool SP2 = false>
__device__ __forceinline__ void gemm_phase(PG8_LAS unsigned char* lds, const Gemm g, const Sched& S, const Epi& E, const int tid) {
    const int wid = __builtin_amdgcn_readfirstlane(tid >> 6), lane = tid & 63, wr = wid >> 2, wc = wid & 3, fr = lane & 15, fq = lane >> 4;
    const int K = g.K, nt = K / BK;
    unsigned voffA[2], voffB[2];
#pragma unroll
    for (int i = 0; i < 2; ++i) { int R, C; stage_rc(tid * 16 + i * 8192, R, C); const int Rb = Epi::PERM ? ((R & ~31) + perm32(R & 31)) : R;
        voffA[i] = (unsigned)(R * K + C) * 2u; voffB[i] = (unsigned)(Rb * K + C) * 2u; }
    const size_t kstep = (size_t)(BK * 2);
    const size_t hstep = (size_t)HALF * K * 2;
    const size_t tstep = 2 * hstep;
    const unsigned ldsw = (unsigned)wid * 1024u;
    const int aoff = lds_byte(wr * 64 + fr, fq * 8), boff = lds_byte(wc * 32 + fr, fq * 8);
#define PG8_SA(b, h) (((b) * 2 + (h)) * HTB)
#define PG8_SB(b, h) ((4 + (b) * 2 + (h)) * HTB)
#define PG8_STAGE(bufoff, gbase, voff) do { _Pragma("unroll") for (int _i = 0; _i < 2; ++_i) \
        __builtin_amdgcn_global_load_lds((const unsigned*)((const char*)(gbase) + (voff)[_i]), (PG8_LAS unsigned*)(lds + (bufoff) + ldsw + _i * 8192), 16, 0, 0); } while (0)
#define PG8_LDA(dst, b, h) do { _Pragma("unroll") for (int m = 0; m < 4; ++m) _Pragma("unroll") for (int k = 0; k < 2; ++k) dst[m][k] = *(const PG8_LAS bf16x8*)(lds + PG8_SA(b, h) + aoff + m * 2048 + k * 1024); } while (0)
#define PG8_LDB(dst, b, h) do { _Pragma("unroll") for (int n = 0; n < 2; ++n) _Pragma("unroll") for (int k = 0; k < 2; ++k) dst[n][k] = *(const PG8_LAS bf16x8*)(lds + PG8_SB(b, h) + boff + n * 2048 + k * 1024); } while (0)
#define PG8_MMA(ai, bj, At, Bt) do { __builtin_amdgcn_s_setprio(1); _Pragma("unroll") for (int m = 0; m < 4; ++m) _Pragma("unroll") for (int n = 0; n < 2; ++n) _Pragma("unroll") for (int k = 0; k < 2; ++k) \
        acc[ai][bj][m][n] = __builtin_amdgcn_mfma_f32_16x16x32_bf16(Bt[n][k], At[m][k], acc[ai][bj][m][n], 0, 0, 0); __builtin_amdgcn_s_setprio(0); } while (0)
#define PG8_WAIT_V(n) asm volatile("s_waitcnt vmcnt(" #n ")" ::: "memory")
#define PG8_WAIT_L(n) asm volatile("s_waitcnt lgkmcnt(" #n ")" ::: "memory")
#define PG8_BAR __builtin_amdgcn_s_barrier()
#define PG8_SCHED __builtin_amdgcn_sched_barrier(0)
    Unit cur, nxt; int ui = 0;
    if (!S.next(0, cur)) return;
    f32x4 acc[2][2][4][2];
#pragma unroll
    for (int a = 0; a < 2; ++a)
#pragma unroll
        for (int b = 0; b < 2; ++b)
#pragma unroll
            for (int m = 0; m < 4; ++m)
#pragma unroll
                for (int n = 0; n < 2; ++n) acc[a][b][m][n] = (f32x4){0.f, 0.f, 0.f, 0.f};
    bf16x8 At[4][2], B0[2][2], B1[2][2];
    const char* cA = (const char*)g.A + (size_t)cur.pm * tstep; const char* cB = (const char*)g.Bt + (size_t)cur.pn * tstep;
    S.a_ready(cur);
    if constexpr (SP2) {
        PG8_STAGE(PG8_SB(0, 0), cB, voffB); PG8_STAGE(PG8_SB(0, 1), cB + hstep, voffB); PG8_STAGE(PG8_SA(0, 0), cA, voffA); PG8_STAGE(PG8_SA(0, 1), cA + hstep, voffA);
        if (wr == 1) PG8_BAR;
        PG8_WAIT_V(2); PG8_BAR;
        PG8_STAGE(PG8_SB(1, 0), cB + kstep, voffB); PG8_STAGE(PG8_SA(1, 0), cA + kstep, voffA); PG8_STAGE(PG8_SB(1, 1), cB + hstep + kstep, voffB);
        PG8_WAIT_V(6); PG8_BAR;
    } else {
        PG8_STAGE(PG8_SB(0, 0), cB, voffB); PG8_STAGE(PG8_SA(0, 0), cA, voffA); PG8_STAGE(PG8_SB(0, 1), cB + hstep, voffB); PG8_STAGE(PG8_SA(0, 1), cA + hstep, voffA);
        if (wr == 1) PG8_BAR;
        PG8_WAIT_V(4); PG8_BAR;
        PG8_STAGE(PG8_SB(1, 0), cB + kstep, voffB); PG8_STAGE(PG8_SA(1, 0), cA + kstep, voffA); PG8_STAGE(PG8_SB(1, 1), cB + hstep + kstep, voffB);
        PG8_WAIT_V(6); PG8_BAR;
    }
    for (;;) {
        const bool has_next = S.next(ui + 1, nxt);
        const char* nA = has_next ? (const char*)g.A + (size_t)nxt.pm * tstep : cA; const char* nB = has_next ? (const char*)g.Bt + (size_t)nxt.pn * tstep : cB;
        for (int t = 0; t < nt; t += 2) {
            const bool last = (t == nt - 2);
            const char* a1 = cA + (size_t)(t + 1) * kstep;
            const char* a2 = last ? nA : cA + (size_t)(t + 2) * kstep; const char* b2 = last ? nB : cB + (size_t)(t + 2) * kstep;
            const char* a3 = a2 + kstep; const char* b3 = b2 + kstep;
            if (last && has_next) S.a_ready(nxt);
            if constexpr (SP2) {
            PG8_LDB(B0, 0, 0); PG8_LDB(B1, 0, 1); PG8_SCHED; PG8_LDA(At, 0, 0); PG8_STAGE(PG8_SA(1, 1), a1 + hstep, voffA);
            PG8_WAIT_V(8); PG8_WAIT_L(0); PG8_BAR; PG8_MMA(0, 0, At, B0); PG8_MMA(0, 1, At, B1); PG8_BAR; PG8_SCHED;
            PG8_LDA(At, 0, 1); PG8_STAGE(PG8_SB(0, 0), b2, voffB); PG8_STAGE(PG8_SB(0, 1), b2 + hstep, voffB); PG8_STAGE(PG8_SA(0, 0), a2, voffA);
            PG8_WAIT_V(8); PG8_WAIT_L(0); PG8_BAR; PG8_MMA(1, 0, At, B0); PG8_MMA(1, 1, At, B1); PG8_BAR; PG8_SCHED;
            PG8_LDB(B0, 1, 0); PG8_LDB(B1, 1, 1); PG8_SCHED; PG8_LDA(At, 1, 0); PG8_STAGE(PG8_SA(0, 1), a2 + hstep, voffA);
            PG8_WAIT_V(8); PG8_WAIT_L(0); PG8_BAR; PG8_MMA(0, 0, At, B0); PG8_MMA(0, 1, At, B1); PG8_BAR; PG8_SCHED;
            PG8_LDA(At, 1, 1); PG8_STAGE(PG8_SB(1, 0), b3, voffB); PG8_STAGE(PG8_SB(1, 1), b3 + hstep, voffB); PG8_STAGE(PG8_SA(1, 0), a3, voffA);
            PG8_WAIT_V(8); PG8_WAIT_L(0); PG8_BAR; PG8_MMA(1, 0, At, B0); PG8_MMA(1, 1, At, B1); PG8_BAR; PG8_SCHED;
            } else {
            PG8_LDB(B0, 0, 0); PG8_SCHED; PG8_LDA(At, 0, 0); PG8_STAGE(PG8_SA(1, 1), a1 + hstep, voffA);
            PG8_WAIT_L(8); PG8_BAR; PG8_WAIT_L(0); PG8_MMA(0, 0, At, B0); PG8_BAR; PG8_SCHED;
            PG8_LDB(B1, 0, 1); PG8_STAGE(PG8_SB(0, 0), b2, voffB);
            PG8_BAR; PG8_WAIT_L(0); PG8_MMA(0, 1, At, B1); PG8_BAR;
            PG8_LDA(At, 0, 1); PG8_STAGE(PG8_SA(0, 0), a2, voffA);
            PG8_BAR; PG8_WAIT_L(0); PG8_MMA(1, 0, At, B0); PG8_BAR; PG8_SCHED;
            PG8_STAGE(PG8_SB(0, 1), b2 + hstep, voffB);
            PG8_WAIT_V(6); PG8_BAR; PG8_MMA(1, 1, At, B1); PG8_BAR;
            PG8_LDB(B0, 1, 0); PG8_SCHED; PG8_LDA(At, 1, 0); PG8_STAGE(PG8_SA(0, 1), a2 + hstep, voffA);
            PG8_WAIT_L(8); PG8_BAR; PG8_WAIT_L(0); PG8_MMA(0, 0, At, B0); PG8_BAR; PG8_SCHED;
            PG8_LDB(B1, 1, 1); PG8_STAGE(PG8_SB(1, 0), b3, voffB);
            PG8_BAR; PG8_WAIT_L(0); PG8_MMA(0, 1, At, B1); PG8_BAR;
            PG8_LDA(At, 1, 1); PG8_STAGE(PG8_SA(1, 0), a3, voffA);
            PG8_BAR; PG8_WAIT_L(0); PG8_MMA(1, 0, At, B0); PG8_BAR; PG8_SCHED;
            PG8_STAGE(PG8_SB(1, 1), b3 + hstep, voffB);
            PG8_WAIT_V(6); PG8_BAR; PG8_MMA(1, 1, At, B1); PG8_BAR;
            }
        }
        if constexpr (ALIGN_EPI) { if (wr == 0) PG8_BAR; }
        if constexpr (!Epi::AFTER_DRAIN) { E(acc, cur, wr, wc, fr, fq); S.done(cur); }
        if (!has_next) break;
#pragma unroll
        for (int a = 0; a < 2; ++a)
#pragma unroll
            for (int b = 0; b < 2; ++b)
#pragma unroll
                for (int m = 0; m < 4; ++m)
#pragma unroll
                    for (int n = 0; n < 2; ++n) acc[a][b][m][n] = (f32x4){0.f, 0.f, 0.f, 0.f};
        cur = nxt; cA = nA; cB = nB; ++ui;
        if constexpr (ALIGN_EPI) { if (wr == 1) PG8_BAR; }
    }
    PG8_WAIT_V(0);
    if constexpr (!ALIGN_EPI) { if (wr == 0) PG8_BAR; }
    PG8_BAR;
#undef PG8_SA
#undef PG8_SB
#undef PG8_STAGE
#undef PG8_LDA
#undef PG8_LDB
#undef PG8_MMA
#undef PG8_WAIT_V
#undef PG8_WAIT_L
#undef PG8_BAR
#undef PG8_SCHED
}
}

struct Params {
    const float* in[31];
    float* out;
    unsigned char* ws;
};
typedef const __attribute__((address_space(4))) Params* KP;
enum { I_X = 0, I_POS, I_LN_MIX_PRE, I_LN_MIX_POST, I_LN_MLP_PRE, I_LN_MLP_POST, I_W_IN, I_W_OUT, I_LAM_RE, I_LAM_IM, I_B_RE, I_B_IM, I_C_RE, I_C_IM,
       I_SSM_D, I_LOG_DT, I_W_GLU, I_CONV, I_B_I, I_B_F, I_PE_K, I_W1_K, I_W2_K, I_PE_V, I_W1_V, I_W2_V, I_GN_SSM, I_GN_MLSTM, I_GN_NSA, I_MLP_W1, I_MLP_W2 };

constexpr int LDS_BYTES = 147456;
constexpr int MISC_OFF = 131072 + 8192;

__device__ __forceinline__ int win_src_col(int n) {
    if (n < 1280) return n;
    if (n < 2560) return n + 8;
    if (n < 2568) return n - 2560 + 1280;
    if (n < 2592) return n;
    return -1;
}
__device__ __forceinline__ void conv_item(const float* W, int K, int N, bf16_t* WT, int mode, int nblk, LAS float* scr, int item, int lane) {
    const int kb = item / nblk, nb = item % nblk, k0 = 64 * kb, n0 = 32 * nb;
    const int nn = n0 + (lane & 31);
    const int sc = mode ? win_src_col(nn) : nn;
#pragma unroll 8
    for (int i = 0; i < 32; ++i) { const int kk = 2 * i + (lane >> 5); scr[kk * 33 + (lane & 31)] = (sc >= 0) ? W[(size_t)(k0 + kk) * N + sc] : 0.f; }
    asm volatile("s_waitcnt lgkmcnt(0)" ::: "memory");
    const int c = lane & 7;
#pragma unroll
    for (int j = 0; j < 4; ++j) { const int n = (lane >> 3) + 8 * j; const LAS float* s = scr + (8 * c) * 33 + n;
        u32x4 o; o.x = cvt_pk_bf16(s[0 * 33], s[1 * 33]); o.y = cvt_pk_bf16(s[2 * 33], s[3 * 33]); o.z = cvt_pk_bf16(s[4 * 33], s[5 * 33]); o.w = cvt_pk_bf16(s[6 * 33], s[7 * 33]);
        *(u32x4*)(WT + (size_t)(n0 + n) * K + k0 + 8 * c) = o; }
    asm volatile("s_waitcnt lgkmcnt(0)" ::: "memory");
}

__device__ __forceinline__ void convert_layer(KP P, int l, ldsp lds, int gw, int NGW, int wave, int lane) {
    LAS float* scr = (LAS float*)(lds + wave * 16384);
    unsigned char* ws = P->ws;
    constexpr int I0 = 16 * 88, I1 = 16 * 32, I2 = 16 * 128, I3 = 64 * 32, I4 = 4 * 8, I5 = 32 * 8, I6 = 32 * 8, I7 = 4 * 2, I8 = 4 * 2, I9 = 128;
    constexpr int NIT = I0 + I1 + I2 + I3 + I4 + I5 + I6 + I7 + I8 + I9;
    for (int it = gw; it < NIT; it += NGW) {
        int r = it;
        if (r < I0) { conv_item(P->in[I_W_IN] + (size_t)l * DM * DIN, DM, DIN, (bf16_t*)(ws + WS_WIN), 1, 88, scr, r, lane); continue; } r -= I0;
        if (r < I1) { conv_item(P->in[I_W_OUT] + (size_t)l * DM * DM, DM, DM, (bf16_t*)(ws + WS_WOUT), 0, 32, scr, r, lane); continue; } r -= I1;
        if (r < I2) { conv_item(P->in[I_MLP_W1] + (size_t)l * DM * DFF, DM, DFF, (bf16_t*)(ws + WS_W1), 0, 128, scr, r, lane); continue; } r -= I2;
        if (r < I3) { conv_item(P->in[I_MLP_W2] + (size_t)l * DFF * DM, DFF, DM, (bf16_t*)(ws + WS_W2), 0, 32, scr, r, lane); continue; } r -= I3;
        if (r < I4) { conv_item(P->in[I_W_GLU] + (size_t)l * 256 * 256, 256, 256, (bf16_t*)(ws + WS_WGLU), 0, 8, scr, r, lane); continue; } r -= I4;
        if (r < I5) { conv_item(P->in[I_W1_K] + (size_t)l * 2048 * 256, 2048, 256, (bf16_t*)(ws + WS_CW1K), 0, 8, scr, r, lane); continue; } r -= I5;
        if (r < I6) { conv_item(P->in[I_W1_V] + (size_t)l * 2048 * 256, 2048, 256, (bf16_t*)(ws + WS_CW1V), 0, 8, scr, r, lane); continue; } r -= I6;
        if (r < I7) { conv_item(P->in[I_W2_K] + (size_t)l * 256 * 64, 256, 64, (bf16_t*)(ws + WS_CW2K), 0, 2, scr, r, lane); continue; } r -= I7;
        if (r < I8) { conv_item(P->in[I_W2_V] + (size_t)l * 256 * 64, 256, 64, (bf16_t*)(ws + WS_CW2V), 0, 2, scr, r, lane); continue; } r -= I8;
        {
            const int kv = r >> 6, hid = ((r >> 4) & 3) * 64 + lane, kc = r & 15;
            const float* pe = P->in[kv ? I_PE_V : I_PE_K] + (size_t)l * 2048 + kc * 128;
            const float* w1 = P->in[kv ? I_W1_V : I_W1_K] + (size_t)l * 2048 * 256 + (size_t)kc * 128 * 256;
            float a0 = 0.f, a1 = 0.f, a2 = 0.f, a3 = 0.f;
#pragma unroll 4
            for (int k = 0; k < 128; k += 4) {
                a0 += pe[k] * w1[(size_t)k * 256 + hid]; a1 += pe[k + 1] * w1[(size_t)(k + 1) * 256 + hid];
                a2 += pe[k + 2] * w1[(size_t)(k + 2) * 256 + hid]; a3 += pe[k + 3] * w1[(size_t)(k + 3) * 256 + hid];
            }
            ((float*)(ws + WS_CB1))[kc * 512 + kv * 256 + hid] = (a0 + a1) + (a2 + a3);
        }
    }
}

__device__ __forceinline__ void norm_pass(const float* xin, const bf16_t* f, const float* gpost, const float* gpre, float* h, bf16_t* u, int gw, int NGW, int lane) {
    for (int m = gw; m < MTOK; m += NGW) {
        f32x4 hv[4];
        if (f == nullptr) {
#pragma unroll
            for (int j = 0; j < 4; ++j) hv[j] = *(const f32x4*)(xin + (size_t)m * DM + 4 * lane + 256 * j);
        } else {
            f32x4 fv[4]; float ss = 0.f;
#pragma unroll
            for (int j = 0; j < 4; ++j) {
                hv[j] = *(const f32x4*)(h + (size_t)m * DM + 4 * lane + 256 * j);
                const u32x2 w = *(const u32x2*)(f + (size_t)m * DM + 4 * lane + 256 * j);
                fv[j][0] = __uint_as_float(w.x << 16); fv[j][1] = __uint_as_float(w.x & 0xffff0000u); fv[j][2] = __uint_as_float(w.y << 16); fv[j][3] = __uint_as_float(w.y & 0xffff0000u);
                ss += fv[j][0] * fv[j][0] + fv[j][1] * fv[j][1] + fv[j][2] * fv[j][2] + fv[j][3] * fv[j][3];
            }
            ss = wave_sum(ss);
            const float rs = rsqrtf(ss * (1.0f / DM) + EPS);
#pragma unroll
            for (int j = 0; j < 4; ++j) { const f32x4 g = *(const f32x4*)(gpost + 4 * lane + 256 * j); hv[j] += fv[j] * rs * g; }
        }
#pragma unroll
        for (int j = 0; j < 4; ++j) *(f32x4*)(h + (size_t)m * DM + 4 * lane + 256 * j) = hv[j];
        if (gpre) {
            float ss = 0.f;
#pragma unroll
            for (int j = 0; j < 4; ++j) ss += hv[j][0] * hv[j][0] + hv[j][1] * hv[j][1] + hv[j][2] * hv[j][2] + hv[j][3] * hv[j][3];
            ss = wave_sum(ss);
            const float rs = rsqrtf(ss * (1.0f / DM) + EPS);
#pragma unroll
            for (int j = 0; j < 4; ++j) { const f32x4 g = *(const f32x4*)(gpre + 4 * lane + 256 * j); const f32x4 o = hv[j] * rs * g;
                u32x2 w; w.x = cvt_pk_bf16(o[0], o[1]); w.y = cvt_pk_bf16(o[2], o[3]); *(u32x2*)(u + (size_t)m * DM + 4 * lane + 256 * j) = w; }
        }
    }
}

struct S5P { float ar, ai; float bbr[16], bbi[16]; };
__device__ __forceinline__ void s5_setup(KP P, int l, int g, int p, S5P& s) {
    const float dt = expf(P->in[I_LOG_DT][l * 16 + g]);
    const float lr = P->in[I_LAM_RE][(l * 16 + g) * 64 + p], li = P->in[I_LAM_IM][(l * 16 + g) * 64 + p];
    const float mag = expf(lr * dt), ang = li * dt;
    s.ar = mag * cosf(ang); s.ai = mag * sinf(ang);
    const float den = lr * lr + li * li;
    const float gr = ((s.ar - 1.0f) * lr + s.ai * li) / den, gi = (s.ai * lr - (s.ar - 1.0f) * li) / den;
    const float* br = P->in[I_B_RE] + ((size_t)(l * 16 + g) * 64 + p) * 16;
    const float* bi = P->in[I_B_IM] + ((size_t)(l * 16 + g) * 64 + p) * 16;
#pragma unroll
    for (int q = 0; q < 4; ++q) { const f32x4 a = *(const f32x4*)(br + 4 * q), b = *(const f32x4*)(bi + 4 * q);
#pragma unroll
        for (int e = 0; e < 4; ++e) { s.bbr[4 * q + e] = gr * a[e] - gi * b[e]; s.bbi[4 * q + e] = gr * b[e] + gi * a[e]; } }
}
__device__ __forceinline__ void s5_stage_u(const bf16_t* z, int m0, int g, LAS float* us, int lane) {
    const bf16_t* src = z + (size_t)(m0 + lane) * ZLD + ZC_SU + g * 16;
    const u32x4 w0 = *(const u32x4*)src, w1 = *(const u32x4*)(src + 8);
    float v[16]; unpack8(w0, v); unpack8(w1, v + 8);
#pragma unroll
    for (int q = 0; q < 4; ++q) *(LAS f32x4*)(us + lane * 16 + 4 * q) = (f32x4){v[4 * q], v[4 * q + 1], v[4 * q + 2], v[4 * q + 3]};
}
__device__ __forceinline__ void s5_step(const S5P& s, const LAS float* ut, float& xr, float& xi) {
    float bur = 0.f, bui = 0.f;
#pragma unroll
    for (int q = 0; q < 4; ++q) { const f32x4 u4 = *(const LAS f32x4*)(ut + 4 * q);
#pragma unroll
        for (int e = 0; e < 4; ++e) { bur += s.bbr[4 * q + e] * u4[e]; bui += s.bbi[4 * q + e] * u4[e]; } }
    const float nr = s.ar * xr - s.ai * xi + bur, ni = s.ar * xi + s.ai * xr + bui;
    xr = nr; xi = ni;
}

__device__ __forceinline__ void s5_stage1(KP P, int l, int bitem, ldsp lds, int wave, int lane) {
    const int wi = bitem * 8 + wave;
    const int c = wi & 31, g = (wi >> 5) & 15, b = wi >> 9;
    const bf16_t* z = (const bf16_t*)(P->ws + WS_Z);
    LAS float* us = (LAS float*)(lds + wave * 4096);
    S5P s; s5_setup(P, l, g, lane, s);
    s5_stage_u(z, b * SEQ + c * 64, g, us, lane);
    float xr = 0.f, xi = 0.f;
    for (int t = 0; t < 64; ++t) s5_step(s, us + t * 16, xr, xi);
    float* E = (float*)(P->ws + WS_S5E) + (size_t)wi * 128;
    E[lane] = xr; E[64 + lane] = xi;
}

__device__ __forceinline__ void s5_stage2(KP P, int l, int bitem, ldsp lds, int wave, int lane) {
    const int c = bitem & 31, b = bitem >> 5;
    const bf16_t* z = (const bf16_t*)(P->ws + WS_Z);
    constexpr int YLD = 264;
    const int Y_OFF = 0, US_OFF = 34816 + wave * 4096, XS_OFF = 34816 + 32768 + wave * 4352;
    LAS float* us = (LAS float*)(lds + US_OFF);
    const int r16 = lane & 15, g4 = lane >> 4;
    const int m0 = b * SEQ + c * 64;
    for (int gi = 0; gi < 2; ++gi) {
        const int g = 2 * wave + gi;
        S5P s; s5_setup(P, l, g, lane, s);
        bf16x8 Cf[4];
        {
            const float* cre = P->in[I_C_RE] + ((size_t)(l * 16 + g) * 16 + r16) * 64;
            const float* cim = P->in[I_C_IM] + ((size_t)(l * 16 + g) * 16 + r16) * 64;
#pragma unroll
            for (int ks = 0; ks < 4; ++ks) {
                const float* src = (ks < 2 ? cre : cim) + 32 * (ks & 1) + 8 * g4;
                const f32x4 a = *(const f32x4*)src, bq = *(const f32x4*)(src + 4);
                const float sg = ks < 2 ? 1.f : -1.f;
                float v[8] = {a[0] * sg, a[1] * sg, a[2] * sg, a[3] * sg, bq[0] * sg, bq[1] * sg, bq[2] * sg, bq[3] * sg};
                Cf[ks] = pack8(v);
            }
        }
        const float dsk = P->in[I_SSM_D][l * 256 + g * 16 + r16];
        s5_stage_u(z, m0, g, us, lane);
        float xr = 0.f, xi = 0.f;
        {
            float pr = s.ar, pi = s.ai;
#pragma unroll
            for (int q = 0; q < 6; ++q) { const float nr = pr * pr - pi * pi, ni = 2.f * pr * pi; pr = nr; pi = ni; }
            const float* E = (const float*)(P->ws + WS_S5E) + (size_t)((b * 16 + g) * 32) * 128;
            for (int cc = 0; cc < c; ++cc) { const float er = E[cc * 128 + lane], ei = E[cc * 128 + 64 + lane];
                const float nr = pr * xr - pi * xi + er, ni = pr * xi + pi * xr + ei; xr = nr; xi = ni; }
        }
        for (int tb = 0; tb < 4; ++tb) {
            for (int tt = 0; tt < 16; ++tt) {
                s5_step(s, us + (tb * 16 + tt) * 16, xr, xi);
                *(LAS bf16_t*)(lds + XS_OFF + (tt * 136 + lane) * 2) = f2bf(xr);
                *(LAS bf16_t*)(lds + XS_OFF + (tt * 136 + 64 + lane) * 2) = f2bf(xi);
            }
            f32x4 acc = (f32x4){0.f, 0.f, 0.f, 0.f};
#pragma unroll
            for (int ks = 0; ks < 4; ++ks) acc = mfma16(lds_frag(lds, XS_OFF + (r16 * 136 + 32 * ks + 8 * g4) * 2), Cf[ks], acc);
#pragma unroll
            for (int rg = 0; rg < 4; ++rg) {
                const int tok = tb * 16 + 4 * g4 + rg;
                float y = acc[rg] + dsk * us[tok * 16 + r16];
                y = gelu_tanh(y);
                *(LAS bf16_t*)(lds + Y_OFF + (tok * YLD + g * 16 + r16) * 2) = f2bf(y);
            }
        }
    }
    __syncthreads();
    {
        const bf16_t* wg = (const bf16_t*)(P->ws + WS_WGLU);
        f32x4 acc[4][2];
#pragma unroll
        for (int mf = 0; mf < 4; ++mf) { acc[mf][0] = (f32x4){0.f, 0.f, 0.f, 0.f}; acc[mf][1] = (f32x4){0.f, 0.f, 0.f, 0.f}; }
        for (int ks = 0; ks < 8; ++ks) {
            bf16x8 bf[2];
#pragma unroll
            for (int nf = 0; nf < 2; ++nf) bf[nf] = *(const bf16x8*)(wg + (size_t)(32 * wave + 16 * nf + r16) * 256 + 32 * ks + 8 * g4);
#pragma unroll
            for (int mf = 0; mf < 4; ++mf) { const bf16x8 af = lds_frag(lds, Y_OFF + ((16 * mf + r16) * YLD + 32 * ks + 8 * g4) * 2);
                acc[mf][0] = mfma16(af, bf[0], acc[mf][0]); acc[mf][1] = mfma16(af, bf[1], acc[mf][1]); }
        }
        bf16_t* yo = (bf16_t*)(P->ws + WS_Y);
#pragma unroll
        for (int nf = 0; nf < 2; ++nf) {
            const int n = 32 * wave + 16 * nf + r16;
            const float gn = P->in[I_GN_SSM][l * 256 + n];
#pragma unroll
            for (int mf = 0; mf < 4; ++mf)
#pragma unroll
                for (int rg = 0; rg < 4; ++rg) {
                    const int tok = 16 * mf + 4 * g4 + rg;
                    const float yv = bf2f(*(const LAS bf16_t*)(lds + Y_OFF + (tok * YLD + n) * 2));
                    const float o = yv * sigmoidf_(acc[mf][nf][rg]);
                    float ss = o * o;
                    ss += __shfl_xor(ss, 1); ss += __shfl_xor(ss, 2); ss += __shfl_xor(ss, 4); ss += __shfl_xor(ss, 8);
                    const float rs = rsqrtf(ss * (1.0f / 16.0f) + EPS);
                    yo[(size_t)(m0 + tok) * DM + n] = f2bf(o * rs * gn);
                }
        }
    }
}

__device__ __forceinline__ float log_sigmoid(float x) { return x > 0.f ? -log1pf(expf(-x)) : x - log1pf(expf(x)); }

__device__ __forceinline__ void conv_silu16(const bf16_t* z, const float* convw  , int b, int t, int zcol, int ch0, float* out) {
#pragma unroll
    for (int i = 0; i < 16; ++i) out[i] = 0.f;
#pragma unroll
    for (int j = 0; j < 4; ++j) {
        const int ts = t - 3 + j;
        if (ts >= 0) {
            const bf16_t* src = z + (size_t)(b * SEQ + ts) * ZLD + zcol;
            const u32x4 w0 = *(const u32x4*)src, w1 = *(const u32x4*)(src + 8);
            float v[16]; unpack8(w0, v); unpack8(w1, v + 8);
            const float* cw = convw + j * 512 + ch0;
#pragma unroll
            for (int q = 0; q < 4; ++q) { const f32x4 c4 = *(const f32x4*)(cw + 4 * q);
#pragma unroll
                for (int e = 0; e < 4; ++e) out[4 * q + e] += v[4 * q + e] * c4[e]; }
        }
    }
#pragma unroll
    for (int i = 0; i < 16; ++i) out[i] = out[i] * sigmoidf_(out[i]);
}

__device__ __forceinline__ void mlstm_gates(KP P, int l, int b, int hh, int c, LAS float* G, int tid) {
    const float* gate = (const float*)(P->ws + WS_GATE);
    if (tid < 128) {
        const int m = b * SEQ + c * 128 + tid;
        G[tid] = gate[(size_t)m * 32 + hh] + P->in[I_B_I][l * 4 + hh];
        G[128 + tid] = log_sigmoid(gate[(size_t)m * 32 + 4 + hh] + P->in[I_B_F][l * 4 + hh]);
    }
    __syncthreads();
    if (tid == 0) { float a = 0.f; for (int s = 0; s < 128; ++s) { a += G[128 + s]; G[128 + s] = a; } }
    __syncthreads();
}

__device__ __forceinline__ void mlstm_stage1(KP P, int l, int item, ldsp lds, int tid, int wave, int lane) {
    const int c = item & 15, hh = (item >> 4) & 3, b = item >> 6;
    const bf16_t* z = (const bf16_t*)(P->ws + WS_Z);
    constexpr int KW_OFF = 0, VT_OFF = 17408, G_OFF = 34816, LD = 136;
    LAS float* G = (LAS float*)(lds + G_OFF);
    mlstm_gates(P, l, b, hh, c, G, tid);
    if (tid == 0) { const float bL = G[128 + 127]; float mx = NEGF; for (int s = 0; s < 128; ++s) mx = fmaxf(mx, bL - G[128 + s] + G[s]); G[384] = bL; G[385] = mx; }
    __syncthreads();
    if (tid < 128) G[256 + tid] = __expf(G[384] - G[128 + tid] + G[tid] - G[385]);
    __syncthreads();
    {
        const int s = tid >> 2, q4 = tid & 3, t = c * 128 + s;
        float kv[16];
        conv_silu16(z, P->in[I_CONV] + (size_t)l * 2048, b, t, ZC_MK + hh * 64 + 16 * q4, 256 + hh * 64 + 16 * q4, kv);
        const float wk = G[256 + s] * 0.125f;
#pragma unroll
        for (int i = 0; i < 16; ++i) *(LAS bf16_t*)(lds + KW_OFF + ((16 * q4 + i) * LD + s) * 2) = f2bf(kv[i] * wk);
        const bf16_t* vs = z + (size_t)(b * SEQ + t) * ZLD + ZC_MV + hh * 64 + 16 * q4;
        const u32x4 w0 = *(const u32x4*)vs, w1 = *(const u32x4*)(vs + 8);
        const unsigned ww[8] = {w0.x, w0.y, w0.z, w0.w, w1.x, w1.y, w1.z, w1.w};
#pragma unroll
        for (int i = 0; i < 8; ++i) {
            *(LAS bf16_t*)(lds + VT_OFF + ((16 * q4 + 2 * i) * LD + s) * 2) = (bf16_t)(ww[i] & 0xffffu);
            *(LAS bf16_t*)(lds + VT_OFF + ((16 * q4 + 2 * i + 1) * LD + s) * 2) = (bf16_t)(ww[i] >> 16);
        }
    }
    __syncthreads();
    float* out = (float*)(P->ws + WS_MLC) + (size_t)item * MLC_STRIDE;
    {
        const int r16 = lane & 15, g4 = lane >> 4, mf = wave >> 1, nf0 = (wave & 1) * 2;
        f32x4 acc[2] = {(f32x4){0.f, 0.f, 0.f, 0.f}, (f32x4){0.f, 0.f, 0.f, 0.f}};
#pragma unroll
        for (int ks = 0; ks < 4; ++ks) {
            const bf16x8 af = lds_frag(lds, KW_OFF + ((16 * mf + r16) * LD + 32 * ks + 8 * g4) * 2);
#pragma unroll
            for (int nfi = 0; nfi < 2; ++nfi) acc[nfi] = mfma16(af, lds_frag(lds, VT_OFF + ((16 * (nf0 + nfi) + r16) * LD + 32 * ks + 8 * g4) * 2), acc[nfi]);
        }
#pragma unroll
        for (int nfi = 0; nfi < 2; ++nfi)
#pragma unroll
            for (int rg = 0; rg < 4; ++rg) out[(16 * mf + 4 * g4 + rg) * 64 + 16 * (nf0 + nfi) + r16] = acc[nfi][rg];
    }
    if (tid < 64) { float a = 0.f; for (int s = 0; s < 128; ++s) a += bf2f(*(const LAS bf16_t*)(lds + KW_OFF + (tid * LD + s) * 2)); out[4096 + tid] = a; }
    if (tid == 0) { out[4160] = G[384]; out[4161] = G[385]; }
}

__device__ __forceinline__ void mlstm_stage2(KP P, int l, int item, ldsp lds, int tid, int wave, int lane) {
    const int c = item & 15, hh = (item >> 4) & 3, b = item >> 6;
    const bf16_t* z = (const bf16_t*)(P->ws + WS_Z);
    constexpr int Q_OFF = 0, K_OFF = 18432, VT_OFF = 36864, CT_OFF = 58624, P_OFF = 70144, G_OFF = 104960, QLD = 72, VLD = 136;
    LAS float* G = (LAS float*)(lds + G_OFF);
    mlstm_gates(P, l, b, hh, c, G, tid);
    if (tid == 0) { float mx = NEGF; for (int s = 0; s < 128; ++s) { mx = fmaxf(mx, G[s] - G[128 + s]); G[256 + s] = mx; } }
    float Cv[8]; float nv = 0.f; float Mp = 0.f;
#pragma unroll
    for (int i = 0; i < 8; ++i) Cv[i] = 0.f;
    {
        const float* base = (const float*)(P->ws + WS_MLC) + (size_t)(item - c) * MLC_STRIDE;
        for (int cc = 0; cc < c; ++cc) {
            const float* src = base + (size_t)cc * MLC_STRIDE;
            const float bL = src[4160], ml = src[4161];
            const float Mn = fmaxf(bL + Mp, ml);
            const float dec = __expf(bL + Mp - Mn), sc = __expf(ml - Mn);
            const f32x4 a = *(const f32x4*)(src + tid * 8), bq = *(const f32x4*)(src + tid * 8 + 4);
#pragma unroll
            for (int e = 0; e < 4; ++e) { Cv[e] = dec * Cv[e] + sc * a[e]; Cv[4 + e] = dec * Cv[4 + e] + sc * bq[e]; }
            if (tid < 64) nv = dec * nv + sc * src[4096 + tid];
            Mp = Mn;
        }
    }
    {
        const int dk = tid >> 3, dv0 = (tid & 7) * 8;
#pragma unroll
        for (int i = 0; i < 8; ++i) *(LAS bf16_t*)(lds + CT_OFF + ((dv0 + i) * QLD + dk) * 2) = f2bf(Cv[i]);
        if (tid < 64) *(LAS bf16_t*)(lds + CT_OFF + (64 * QLD + tid) * 2) = f2bf(nv);
        for (int e = tid; e < 15 * 64; e += 512) *(LAS bf16_t*)(lds + CT_OFF + ((65 + e / 64) * QLD + (e & 63)) * 2) = 0;
        for (int e = tid; e < 15 * 128; e += 512) *(LAS bf16_t*)(lds + VT_OFF + ((65 + e / 128) * VLD + (e & 127)) * 2) = 0;
        if (tid < 128) *(LAS bf16_t*)(lds + VT_OFF + (64 * VLD + tid) * 2) = 0x3f80;
    }
    {
        const int s = tid >> 2, q4 = tid & 3, t = c * 128 + s;
        float qv[16], kv[16];
        conv_silu16(z, P->in[I_CONV] + (size_t)l * 2048, b, t, ZC_MQ + hh * 64 + 16 * q4, hh * 64 + 16 * q4, qv);
        conv_silu16(z, P->in[I_CONV] + (size_t)l * 2048, b, t, ZC_MK + hh * 64 + 16 * q4, 256 + hh * 64 + 16 * q4, kv);
#pragma unroll
        for (int i = 0; i < 16; ++i) kv[i] *= 0.125f;
        *(LAS bf16x8*)(lds + Q_OFF + (s * QLD + 16 * q4) * 2) = pack8(qv); *(LAS bf16x8*)(lds + Q_OFF + (s * QLD + 16 * q4 + 8) * 2) = pack8(qv + 8);
        *(LAS bf16x8*)(lds + K_OFF + (s * QLD + 16 * q4) * 2) = pack8(kv); *(LAS bf16x8*)(lds + K_OFF + (s * QLD + 16 * q4 + 8) * 2) = pack8(kv + 8);
        const bf16_t* vs = z + (size_t)(b * SEQ + t) * ZLD + ZC_MV + hh * 64 + 16 * q4;
        const u32x4 w0 = *(const u32x4*)vs, w1 = *(const u32x4*)(vs + 8);
        const unsigned ww[8] = {w0.x, w0.y, w0.z, w0.w, w1.x, w1.y, w1.z, w1.w};
#pragma unroll
        for (int i = 0; i < 8; ++i) {
            *(LAS bf16_t*)(lds + VT_OFF + ((16 * q4 + 2 * i) * VLD + s) * 2) = (bf16_t)(ww[i] & 0xffffu);
            *(LAS bf16_t*)(lds + VT_OFF + ((16 * q4 + 2 * i + 1) * VLD + s) * 2) = (bf16_t)(ww[i] >> 16);
        }
    }
    __syncthreads();
    if (tid < 128) G[384 + tid] = G[128 + tid] + fmaxf(Mp, G[256 + tid]);
    __syncthreads();
    {
        const int r16 = lane & 15, g4 = lane >> 4;
        const int PW = P_OFF + wave * 4352;
        bf16x8 qf[2];
#pragma unroll
        for (int ks = 0; ks < 2; ++ks) qf[ks] = lds_frag(lds, Q_OFF + ((16 * wave + r16) * QLD + 32 * ks + 8 * g4) * 2);
        f32x4 accO[5];
#pragma unroll
        for (int nf = 0; nf < 5; ++nf) { accO[nf] = (f32x4){0.f, 0.f, 0.f, 0.f};
#pragma unroll
            for (int ks = 0; ks < 2; ++ks) accO[nf] = mfma16(qf[ks], lds_frag(lds, CT_OFF + ((16 * nf + r16) * QLD + 32 * ks + 8 * g4) * 2), accO[nf]); }
        float bt[4], mt[4];
#pragma unroll
        for (int rg = 0; rg < 4; ++rg) { const int t = 16 * wave + 4 * g4 + rg; bt[rg] = G[128 + t]; mt[rg] = G[384 + t];
            const float wi = __expf(bt[rg] + Mp - mt[rg]);
#pragma unroll
            for (int nf = 0; nf < 5; ++nf) accO[nf][rg] *= wi; }
        const int nfmax = (wave | 1);
        for (int nf = 0; nf <= nfmax; ++nf) {
            f32x4 sacc = (f32x4){0.f, 0.f, 0.f, 0.f};
            if (nf <= wave) {
#pragma unroll
                for (int ks = 0; ks < 2; ++ks) sacc = mfma16(qf[ks], lds_frag(lds, K_OFF + ((16 * nf + r16) * QLD + 32 * ks + 8 * g4) * 2), sacc);
            }
            const int s = 16 * nf + r16;
            const float ds = G[s] - G[128 + s];
#pragma unroll
            for (int rg = 0; rg < 4; ++rg) {
                const int t = 16 * wave + 4 * g4 + rg;
                const float p = (s <= t) ? sacc[rg] * __expf(bt[rg] + ds - mt[rg]) : 0.f;
                *(LAS bf16_t*)(lds + PW + ((4 * g4 + rg) * VLD + s) * 2) = f2bf(p);
            }
        }
        for (int ks = 0; ks <= (wave >> 1); ++ks) {
            const bf16x8 pf = lds_frag(lds, PW + (r16 * VLD + 32 * ks + 8 * g4) * 2);
#pragma unroll
            for (int nf = 0; nf < 5; ++nf) accO[nf] = mfma16(pf, lds_frag(lds, VT_OFF + ((16 * nf + r16) * VLD + 32 * ks + 8 * g4) * 2), accO[nf]);
        }
        bf16_t* yo = (bf16_t*)(P->ws + WS_Y);
#pragma unroll
        for (int rg = 0; rg < 4; ++rg) {
            const int t = 16 * wave + 4 * g4 + rg;
            const size_t m = (size_t)b * SEQ + c * 128 + t;
            const float den = __shfl(accO[4][rg], lane & 48);
            const float dn = fmaxf(fabsf(den), __expf(-mt[rg]));
            float o[4]; float ss = 0.f;
#pragma unroll
            for (int nf = 0; nf < 4; ++nf) {
                const float op = bf2f(z[m * ZLD + ZC_MO + hh * 64 + 16 * nf + r16]);
                o[nf] = sigmoidf_(op) * (accO[nf][rg] / dn);
                ss += o[nf] * o[nf];
            }
            ss += __shfl_xor(ss, 1); ss += __shfl_xor(ss, 2); ss += __shfl_xor(ss, 4); ss += __shfl_xor(ss, 8);
            const float rs = rsqrtf(ss * (1.0f / 64.0f) + EPS);
#pragma unroll
            for (int nf = 0; nf < 4; ++nf) yo[m * DM + 256 + hh * 64 + 16 * nf + r16] = f2bf(o[nf] * rs * P->in[I_GN_MLSTM][l * 256 + hh * 64 + 16 * nf + r16]);
        }
    }
}

__device__ __forceinline__ void compress_item(KP P, int l, int item, ldsp lds, int tid, int wave, int lane) {
    const int nt = item & 3, bg = (item >> 2) & 15, kv = item >> 6;
    const int b = bg >> 1, g = bg & 1, n0 = 32 * nt;
    const bf16_t* z = (const bf16_t*)(P->ws + WS_Z);
    constexpr int CK_OFF = 0, CLD = 72, H_OFF = 76032, HLD = 264;
    const float* rc = (const float*)(P->ws + WS_ROPE);
    for (int e = tid; e < 528 * 4; e += 512) {
        const int tk = e >> 2, q4 = e & 3, t = 16 * n0 + tk;
        float v[16];
        if (t < SEQ) {
            const size_t m = (size_t)b * SEQ + t;
            const bf16_t* src = z + m * ZLD + (kv ? ZC_CV : ZC_CK) + g * 64 + 16 * q4;
            const u32x4 w0 = *(const u32x4*)src, w1 = *(const u32x4*)(src + 8);
            unpack8(w0, v); unpack8(w1, v + 8);
            if (kv == 0 && q4 == 0) {
#pragma unroll
                for (int i = 0; i < 8; ++i) { const float cs = rc[m * 8 + i], sn = rc[(size_t)MTOK * 8 + m * 8 + i];
                    const float x1 = v[i], x2 = v[8 + i]; v[i] = bf2f(f2bf(x1 * cs - x2 * sn)); v[8 + i] = bf2f(f2bf(x2 * cs + x1 * sn)); }
            }
        } else {
#pragma unroll
            for (int i = 0; i < 16; ++i) v[i] = 0.f;
        }
        *(LAS bf16x8*)(lds + CK_OFF + (tk * CLD + 16 * q4) * 2) = pack8(v); *(LAS bf16x8*)(lds + CK_OFF + (tk * CLD + 16 * q4 + 8) * 2) = pack8(v + 8);
    }
    __syncthreads();
    const int r16 = lane & 15, g4 = lane >> 4;
    {
        const bf16_t* w1t = (const bf16_t*)(P->ws + (kv ? WS_CW1V : WS_CW1K));
        f32x4 acc[2][2];
#pragma unroll
        for (int a = 0; a < 2; ++a) { acc[a][0] = (f32x4){0.f, 0.f, 0.f, 0.f}; acc[a][1] = (f32x4){0.f, 0.f, 0.f, 0.f}; }
#pragma unroll 4
        for (int ks = 0; ks < 64; ++ks) {
            const int tt = ks >> 1, dd = 32 * (ks & 1) + 8 * g4;
            bf16x8 bf[2], af[2];
#pragma unroll
            for (int nfi = 0; nfi < 2; ++nfi) bf[nfi] = *(const bf16x8*)(w1t + (size_t)(32 * wave + 16 * nfi + r16) * 2048 + 32 * ks + 8 * g4);
#pragma unroll
            for (int mf = 0; mf < 2; ++mf) af[mf] = lds_frag(lds, CK_OFF + ((16 * (16 * mf + r16) + tt) * CLD + dd) * 2);
#pragma unroll
            for (int mf = 0; mf < 2; ++mf)
#pragma unroll
                for (int nfi = 0; nfi < 2; ++nfi) acc[mf][nfi] = mfma16(af[mf], bf[nfi], acc[mf][nfi]);
        }
        const float* cb1 = (const float*)(P->ws + WS_CB1) + kv * 256;
#pragma unroll
        for (int nfi = 0; nfi < 2; ++nfi) { const int hid = 32 * wave + 16 * nfi + r16; float bb = 0.f;
#pragma unroll
            for (int kc = 0; kc < 16; ++kc) bb += cb1[kc * 512 + hid];
#pragma unroll
            for (int mf = 0; mf < 2; ++mf)
#pragma unroll
                for (int rg = 0; rg < 4; ++rg) *(LAS bf16_t*)(lds + H_OFF + ((16 * mf + 4 * g4 + rg) * HLD + hid) * 2) = f2bf(gelu_tanh(acc[mf][nfi][rg] + bb)); }
    }
    __syncthreads();
    {
        const bf16_t* w2t = (const bf16_t*)(P->ws + (kv ? WS_CW2V : WS_CW2K));
        const int mf = wave >> 2, nf = wave & 3;
        f32x4 acc = (f32x4){0.f, 0.f, 0.f, 0.f};
#pragma unroll
        for (int ks = 0; ks < 8; ++ks)
            acc = mfma16(lds_frag(lds, H_OFF + ((16 * mf + r16) * HLD + 32 * ks + 8 * g4) * 2), *(const bf16x8*)(w2t + (size_t)(16 * nf + r16) * 256 + 32 * ks + 8 * g4), acc);
        bf16_t* dst = (bf16_t*)(P->ws + (kv ? WS_VCMP : WS_KCMP)) + (size_t)bg * 128 * 64;
#pragma unroll
        for (int rg = 0; rg < 4; ++rg) { const int n = n0 + 16 * mf + 4 * g4 + rg; dst[n * 64 + 16 * nf + r16] = (n < 127) ? f2bf(acc[rg]) : (bf16_t)0; }
    }
}

__device__ __forceinline__ void rope_item(KP P, int item, int tid) {
    bf16_t* z = (bf16_t*)(P->ws + WS_Z);
    const float* rc = (const float*)(P->ws + WS_ROPE);
    for (int e = item * 4096 + tid; e < item * 4096 + 4096; e += 512) {
        const int m = e / 12, hsel = e % 12;
        const int col = hsel < 8 ? ZC_AQ + hsel * 64 : (hsel < 10 ? ZC_SK + (hsel - 8) * 64 : ZC_WK + (hsel - 10) * 64);
        bf16_t* src = z + (size_t)m * ZLD + col;
        const u32x4 w0 = *(const u32x4*)src, w1 = *(const u32x4*)(src + 8);
        float v[16]; unpack8(w0, v); unpack8(w1, v + 8);
        const f32x4 c0 = *(const f32x4*)(rc + (size_t)m * 8), c1 = *(const f32x4*)(rc + (size_t)m * 8 + 4);
        const f32x4 s0 = *(const f32x4*)(rc + (size_t)MTOK * 8 + (size_t)m * 8), s1 = *(const f32x4*)(rc + (size_t)MTOK * 8 + (size_t)m * 8 + 4);
        const float cs[8] = {c0[0], c0[1], c0[2], c0[3], c1[0], c1[1], c1[2], c1[3]}, sn[8] = {s0[0], s0[1], s0[2], s0[3], s1[0], s1[1], s1[2], s1[3]};
        float o[16];
#pragma unroll
        for (int i = 0; i < 8; ++i) { o[i] = v[i] * cs[i] - v[8 + i] * sn[i]; o[8 + i] = v[8 + i] * cs[i] + v[i] * sn[i]; }
        *(bf16x8*)src = pack8(o); *(bf16x8*)(src + 8) = pack8(o + 8);
    }
}

struct NsaCtx { int tq; unsigned selm; };
template <int MODE  >
__device__ __forceinline__ void nsa_tile(ldsp lds, int kbase, const bf16x8 (&Qf)[2][2], f32x4 (&OB)[4][2], float (&mrun)[2], float (&lrun)[2], int tq, bool selbit, int r16, int g4) {
    constexpr int KS_OFF = 0, VT_OFF = 18432, KLD = 72, VLD = 136;
    constexpr float SC2 = 0.125f * 1.4426950408889634f;
#pragma unroll
    for (int f = 0; f < 2; ++f) {
        f32x4 S[4];
#pragma unroll
        for (int kf = 0; kf < 4; ++kf) { S[kf] = (f32x4){0.f, 0.f, 0.f, 0.f};
#pragma unroll
            for (int ks = 0; ks < 2; ++ks) S[kf] = mfma16(lds_frag(lds, KS_OFF + ((16 * kf + r16) * KLD + 32 * ks + 8 * g4) * 2), Qf[f][ks], S[kf]); }
        float mx = NEGF; bool ok[4][4];
#pragma unroll
        for (int kf = 0; kf < 4; ++kf)
#pragma unroll
            for (int rg = 0; rg < 4; ++rg) {
                const int kp = kbase + 16 * kf + 4 * g4 + rg;
                bool v;
                if (MODE == 1) v = selbit && (kp <= tq); else v = (kp <= tq) && (tq - kp < 256);
                ok[kf][rg] = v;
                const float s = v ? S[kf][rg] * SC2 : NEGF;
                S[kf][rg] = s; mx = fmaxf(mx, s);
            }
        mx = fmaxf(mx, __shfl_xor(mx, 16)); mx = fmaxf(mx, __shfl_xor(mx, 32));
        const float mn = fmaxf(mrun[f], mx);
        const float alpha = exp2f(mrun[f] - mn);
        float ls = 0.f;
#pragma unroll
        for (int kf = 0; kf < 4; ++kf)
#pragma unroll
            for (int rg = 0; rg < 4; ++rg) { const float p = ok[kf][rg] ? exp2f(S[kf][rg] - mn) : 0.f; S[kf][rg] = p; ls += p; }
        ls += __shfl_xor(ls, 16); ls += __shfl_xor(ls, 32);
        lrun[f] = lrun[f] * alpha + ls; mrun[f] = mn;
#pragma unroll
        for (int df = 0; df < 4; ++df) OB[df][f] *= alpha;
#pragma unroll
        for (int k2 = 0; k2 < 2; ++k2) {
            const float pv[8] = {S[2 * k2][0], S[2 * k2][1], S[2 * k2][2], S[2 * k2][3], S[2 * k2 + 1][0], S[2 * k2 + 1][1], S[2 * k2 + 1][2], S[2 * k2 + 1][3]};
            const bf16x8 pb = pack8(pv);
#pragma unroll
            for (int df = 0; df < 4; ++df) {
                const bf16x4 lo = *(const LAS bf16x4*)(lds + VT_OFF + ((16 * df + r16) * VLD + 32 * k2 + 4 * g4) * 2);
                const bf16x4 hi = *(const LAS bf16x4*)(lds + VT_OFF + ((16 * df + r16) * VLD + 32 * k2 + 16 + 4 * g4) * 2);
                const bf16x8 va = __builtin_shufflevector(lo, hi, 0, 1, 2, 3, 4, 5, 6, 7);
                OB[df][f] = mfma16(va, pb, OB[df][f]);
            }
        }
    }
}

__device__ __forceinline__ void nsa_load_tile(ldsp lds, const bf16_t* kbase, const bf16_t* vbase, size_t ld, int keyoff, int tid) {
    constexpr int KS_OFF = 0, VT_OFF = 18432, KLD = 72, VLD = 136;
    const int key = tid >> 3, dc = tid & 7;
    const u32x4 kw = *(const u32x4*)(kbase + (size_t)key * ld + 8 * dc);
    const u32x4 vw = *(const u32x4*)(vbase + (size_t)key * ld + 8 * dc);
    *(LAS u32x4*)(lds + KS_OFF + ((keyoff + key) * KLD + 8 * dc) * 2) = kw;
    const unsigned ww[4] = {vw.x, vw.y, vw.z, vw.w};
#pragma unroll
    for (int i = 0; i < 4; ++i) {
        *(LAS bf16_t*)(lds + VT_OFF + ((8 * dc + 2 * i) * VLD + keyoff + key) * 2) = (bf16_t)(ww[i] & 0xffffu);
        *(LAS bf16_t*)(lds + VT_OFF + ((8 * dc + 2 * i + 1) * VLD + keyoff + key) * 2) = (bf16_t)(ww[i] >> 16);
    }
}

__device__ __forceinline__ void nsa_item(KP P, int l, int item, ldsp lds, int tid, int wave, int lane) {
    const int qt = 31 - (item >> 4), bg = item & 15, b = bg >> 1, g = bg & 1;
    const int T0 = 64 * qt;
    const bf16_t* z = (const bf16_t*)(P->ws + WS_Z);
    const float* gate = (const float*)(P->ws + WS_GATE);
    constexpr int KS_OFF = 0, VT_OFF = 18432, KLD = 72, VLD = 136, IMP_OFF = 35840, SEL_OFF = 52224, OR_OFF = 52480;
    constexpr float SC2 = 0.125f * 1.4426950408889634f;
    const int r16 = lane & 15, g4 = lane >> 4;
    const int tq = T0 + 8 * wave + (r16 & 7);
    const size_t mq = (size_t)b * SEQ + tq;
    int hd[2]; hd[0] = 4 * g + (r16 >> 3); hd[1] = 4 * g + 2 + (r16 >> 3);
    bf16x8 Qf[2][2];
#pragma unroll
    for (int f = 0; f < 2; ++f)
#pragma unroll
        for (int ks = 0; ks < 2; ++ks) Qf[f][ks] = *(const bf16x8*)(z + mq * ZLD + ZC_AQ + hd[f] * 64 + 32 * ks + 8 * g4);
    float gt[2][3];
#pragma unroll
    for (int f = 0; f < 2; ++f)
#pragma unroll
        for (int br = 0; br < 3; ++br) gt[f][br] = sigmoidf_(gate[mq * 32 + 8 + hd[f] * 3 + br]);
    f32x4 OF[4][2], OB[4][2];
    if (tid == 0) *(LAS unsigned*)(lds + OR_OFF) = 0u;
    {
        const bf16_t* kc = (const bf16_t*)(P->ws + WS_KCMP) + (size_t)bg * 128 * 64;
        const bf16_t* vc = (const bf16_t*)(P->ws + WS_VCMP) + (size_t)bg * 128 * 64;
        nsa_load_tile(lds, kc, vc, 64, 0, tid);
        nsa_load_tile(lds, kc + 64 * 64, vc + 64 * 64, 64, 64, tid);
        __syncthreads();
        f32x4 ps[8];
#pragma unroll
        for (int kf = 0; kf < 8; ++kf) ps[kf] = (f32x4){0.f, 0.f, 0.f, 0.f};
#pragma unroll
        for (int f = 0; f < 2; ++f) {
            f32x4 S[8];
#pragma unroll
            for (int kf = 0; kf < 8; ++kf) { S[kf] = (f32x4){0.f, 0.f, 0.f, 0.f};
#pragma unroll
                for (int ks = 0; ks < 2; ++ks) S[kf] = mfma16(lds_frag(lds, KS_OFF + ((16 * kf + r16) * KLD + 32 * ks + 8 * g4) * 2), Qf[f][ks], S[kf]); }
            float mx = NEGF;
#pragma unroll
            for (int kf = 0; kf < 8; ++kf)
#pragma unroll
                for (int rg = 0; rg < 4; ++rg) { const int n = 16 * kf + 4 * g4 + rg; const bool v = (16 * n + 31 <= tq); const float s = v ? S[kf][rg] * SC2 : NEGF; S[kf][rg] = s; mx = fmaxf(mx, s); }
            mx = fmaxf(mx, __shfl_xor(mx, 16)); mx = fmaxf(mx, __shfl_xor(mx, 32));
            float ls = 0.f;
#pragma unroll
            for (int kf = 0; kf < 8; ++kf)
#pragma unroll
                for (int rg = 0; rg < 4; ++rg) { const int n = 16 * kf + 4 * g4 + rg; const bool v = (16 * n + 31 <= tq); const float p = v ? exp2f(S[kf][rg] - mx) : 0.f; S[kf][rg] = p; ls += p; }
            ls += __shfl_xor(ls, 16); ls += __shfl_xor(ls, 32);
            const float inv = ls > 0.f ? 1.0f / ls : 0.f;
#pragma unroll
            for (int kf = 0; kf < 8; ++kf) { S[kf] *= inv; ps[kf] += S[kf]; }
#pragma unroll
            for (int df = 0; df < 4; ++df) OB[df][f] = (f32x4){0.f, 0.f, 0.f, 0.f};
#pragma unroll
            for (int k2 = 0; k2 < 4; ++k2) {
                const float pv[8] = {S[2 * k2][0], S[2 * k2][1], S[2 * k2][2], S[2 * k2][3], S[2 * k2 + 1][0], S[2 * k2 + 1][1], S[2 * k2 + 1][2], S[2 * k2 + 1][3]};
                const bf16x8 pb = pack8(pv);
#pragma unroll
                for (int df = 0; df < 4; ++df) {
                    const bf16x4 lo = *(const LAS bf16x4*)(lds + VT_OFF + ((16 * df + r16) * VLD + 32 * k2 + 4 * g4) * 2);
                    const bf16x4 hi = *(const LAS bf16x4*)(lds + VT_OFF + ((16 * df + r16) * VLD + 32 * k2 + 16 + 4 * g4) * 2);
                    OB[df][f] = mfma16(__builtin_shufflevector(lo, hi, 0, 1, 2, 3, 4, 5, 6, 7), pb, OB[df][f]);
                }
            }
#pragma unroll
            for (int df = 0; df < 4; ++df) OF[df][f] = OB[df][f] * gt[f][0];
        }
        LAS float* impA = (LAS float*)(lds + IMP_OFF + wave * 2048);
        LAS float* impB = impA + 256;
#pragma unroll
        for (int kf = 0; kf < 8; ++kf) {
            f32x4 v = ps[kf];
#pragma unroll
            for (int e = 0; e < 4; ++e) v[e] += __shfl_xor(v[e], 8);
            if (r16 < 8) {
                const int j = 4 * kf + g4;
                impA[r16 * 32 + j] = 2.0f * (v[0] + v[1] + v[2]) + v[3];
                if (j < 31) impB[r16 * 32 + j + 1] = v[3];
                if (j == 0) impB[r16 * 32] = 0.f;
            }
        }
        {
            const int tk = lane & 7, jg = lane >> 3;
            const int tt = T0 + 8 * wave + tk, jcur = tt >> 6;
            float myv[4];
#pragma unroll
            for (int i = 0; i < 4; ++i) { const int j = 4 * jg + i; float v = impA[tk * 32 + j] + impB[tk * 32 + j];
                if (j == 0 || j == jcur) v = 1e4f; else if (j > jcur) v = -1e4f; myv[i] = v; }
            asm volatile("s_waitcnt lgkmcnt(0)" ::: "memory");
#pragma unroll
            for (int i = 0; i < 4; ++i) impA[tk * 32 + 4 * jg + i] = myv[i];
            asm volatile("s_waitcnt lgkmcnt(0)" ::: "memory");
            int cnt[4] = {0, 0, 0, 0};
            for (int j2 = 0; j2 < 32; ++j2) { const float v2 = impA[tk * 32 + j2];
#pragma unroll
                for (int i = 0; i < 4; ++i) { const int j = 4 * jg + i; cnt[i] += (v2 > myv[i] || (v2 == myv[i] && j2 < j)) ? 1 : 0; } }
            unsigned bits = 0u;
#pragma unroll
            for (int i = 0; i < 4; ++i) { const int j = 4 * jg + i; if (cnt[i] < 8 && j <= jcur) bits |= (1u << j); }
            bits |= __shfl_xor(bits, 8); bits |= __shfl_xor(bits, 16); bits |= __shfl_xor(bits, 32);
            if (lane < 8) { *(LAS unsigned*)(lds + SEL_OFF + (wave * 8 + lane) * 4) = bits; __hip_atomic_fetch_or((LAS unsigned*)(lds + OR_OFF), bits, __ATOMIC_RELAXED, __HIP_MEMORY_SCOPE_WORKGROUP); }
        }
    }
    __syncthreads();
    const unsigned selm = *(const LAS unsigned*)(lds + SEL_OFF + (wave * 8 + (r16 & 7)) * 4);
    const unsigned selor = *(const LAS unsigned*)(lds + OR_OFF);
    {
        float mrun[2] = {NEGF, NEGF}, lrun[2] = {0.f, 0.f};
#pragma unroll
        for (int f = 0; f < 2; ++f)
#pragma unroll
            for (int df = 0; df < 4; ++df) OB[df][f] = (f32x4){0.f, 0.f, 0.f, 0.f};
        for (int j = 0; j <= qt; ++j) {
            if (!((selor >> j) & 1u)) continue;
            __syncthreads();
            nsa_load_tile(lds, z + ((size_t)b * SEQ + 64 * j) * ZLD + ZC_SK + g * 64, z + ((size_t)b * SEQ + 64 * j) * ZLD + ZC_SV + g * 64, ZLD, 0, tid);
            __syncthreads();
            nsa_tile<1>(lds, 64 * j, Qf, OB, mrun, lrun, tq, ((selm >> j) & 1u) != 0u, r16, g4);
        }
#pragma unroll
        for (int f = 0; f < 2; ++f) { const float sc = gt[f][1] / lrun[f];
#pragma unroll
            for (int df = 0; df < 4; ++df) OF[df][f] += OB[df][f] * sc; }
    }
    {
        float mrun[2] = {NEGF, NEGF}, lrun[2] = {0.f, 0.f};
#pragma unroll
        for (int f = 0; f < 2; ++f)
#pragma unroll
            for (int df = 0; df < 4; ++df) OB[df][f] = (f32x4){0.f, 0.f, 0.f, 0.f};
        for (int j = (qt >= 4 ? qt - 4 : 0); j <= qt; ++j) {
            __syncthreads();
            nsa_load_tile(lds, z + ((size_t)b * SEQ + 64 * j) * ZLD + ZC_WK + g * 64, z + ((size_t)b * SEQ + 64 * j) * ZLD + ZC_WV + g * 64, ZLD, 0, tid);
            __syncthreads();
            nsa_tile<2>(lds, 64 * j, Qf, OB, mrun, lrun, tq, true, r16, g4);
        }
#pragma unroll
        for (int f = 0; f < 2; ++f) { const float sc = gt[f][2] / lrun[f];
#pragma unroll
            for (int df = 0; df < 4; ++df) OF[df][f] += OB[df][f] * sc; }
    }
    {
        bf16_t* yo = (bf16_t*)(P->ws + WS_Y);
#pragma unroll
        for (int f = 0; f < 2; ++f) {
            float ss = 0.f;
#pragma unroll
            for (int df = 0; df < 4; ++df)
#pragma unroll
                for (int rg = 0; rg < 4; ++rg) ss += OF[df][f][rg] * OF[df][f][rg];
            ss += __shfl_xor(ss, 16); ss += __shfl_xor(ss, 32);
            const float rs = rsqrtf(ss * (1.0f / 64.0f) + EPS);
#pragma unroll
            for (int df = 0; df < 4; ++df) {
                const f32x4 gn = *(const f32x4*)(P->in[I_GN_NSA] + l * 512 + hd[f] * 64 + 16 * df + 4 * g4);
                const f32x4 o = OF[df][f] * rs * gn;
                u32x2 w; w.x = cvt_pk_bf16(o[0], o[1]); w.y = cvt_pk_bf16(o[2], o[3]);
                *(u32x2*)(yo + mq * DM + 512 + hd[f] * 64 + 16 * df + 4 * g4) = w;
            }
        }
    }
}

#define XB_TMO      128
#define XB_XCNT(j)  (256  + 64 * (j))
#define XB_XSUB(j)  (1280 + 64 * (j))
#define XB_XGEN(j)  (2304 + 64 * (j))
#define XB_TOP      3328
#define XB_TOPGEN   3392
#define XCD_BAR_WORDS 3456
#define XB_SPIN_CAP (1u << 22)
__device__ __forceinline__ unsigned xb_ld(unsigned* p)              { return __hip_atomic_load(p, __ATOMIC_RELAXED, __HIP_MEMORY_SCOPE_AGENT); }
__device__ __forceinline__ unsigned xb_add(unsigned* p, unsigned v) { return __hip_atomic_fetch_add(p, v, __ATOMIC_RELAXED, __HIP_MEMORY_SCOPE_AGENT); }
__device__ __forceinline__ unsigned xb_xcc_id() { return (unsigned)__builtin_amdgcn_s_getreg((3 << 11) | 20) & 0xFu; }
#define XB_SPIN(cond, bar) do { unsigned _sp = 0; while (cond) { __builtin_amdgcn_s_sleep(1); \
    if ((++_sp & 255u) == 0u) { if (xb_ld(&(bar)[XB_TMO])) break; if (_sp > XB_SPIN_CAP) { atomicAdd(&(bar)[XB_TMO], 1u); break; } } } } while (0)
struct XcdBarrier { unsigned* bar; unsigned x; volatile LAS unsigned* st; };
__device__ __forceinline__ XcdBarrier xcd_barrier_post(unsigned* bar, volatile LAS unsigned* st) {
    XcdBarrier b; b.bar = bar; b.x = xb_xcc_id(); b.st = st;
    if (threadIdx.x == 0) (void)xb_add(&bar[XB_XCNT(b.x)], 1u);
    return b;
}
__device__ __forceinline__ void xcd_barrier_complete(unsigned* bar, unsigned x, unsigned& nloc, unsigned& nx) {
    const unsigned G = gridDim.x * gridDim.y * gridDim.z;
    unsigned sum, cnt, mine, sp = 0u;
    for (;;) {
        sum = 0u; cnt = 0u; mine = 0u;
#pragma unroll
        for (unsigned j = 0; j < 16; ++j) { const unsigned c = xb_ld(&bar[XB_XCNT(j)]); sum += c; cnt += (c > 0u) ? 1u : 0u; mine = (j == x) ? c : mine; }
        if (sum == G) break;
        __builtin_amdgcn_s_sleep(1);
        if ((++sp & 255u) == 0u) { if (xb_ld(&bar[XB_TMO])) break; if (sp > XB_SPIN_CAP) { atomicAdd(&bar[XB_TMO], 1u); break; } }
    }
    nloc = mine > 0u ? mine : 1u; nx = cnt > 0u ? cnt : 1u;
}
__device__ __forceinline__ void xcd_barrier(const XcdBarrier& b) {
    asm volatile("s_waitcnt vmcnt(0)" ::: "memory");
    __syncthreads();
    if (threadIdx.x == 0) {
        unsigned* bar = b.bar;
        __builtin_amdgcn_s_waitcnt(0);
        unsigned nloc = b.st[0], nx = b.st[1];
        if (nloc == 0u) { xcd_barrier_complete(bar, b.x, nloc, nx); b.st[0] = nloc; b.st[1] = nx; }
        const unsigned old = xb_add(&bar[XB_XSUB(b.x)], 1u);
        const unsigned gen = old / nloc;
        if (old + 1u == (gen + 1u) * nloc) {
            __builtin_amdgcn_fence(__ATOMIC_RELEASE, "agent");
            asm volatile("s_waitcnt vmcnt(0)" ::: "memory");
            const unsigned og = xb_add(&bar[XB_TOP], 1u);
            const unsigned tg = og / nx;
            if (og + 1u == (tg + 1u) * nx) xb_add(&bar[XB_TOPGEN], 1u);
            else XB_SPIN(xb_ld(&bar[XB_TOPGEN]) == tg, bar);
            __builtin_amdgcn_fence(__ATOMIC_ACQUIRE, "agent");
            xb_add(&bar[XB_XGEN(b.x)], 1u);
            asm volatile("s_waitcnt vmcnt(0)" ::: "memory");
        } else {
            XB_SPIN(xb_ld(&bar[XB_XGEN(b.x)]) == gen, bar);
            __builtin_amdgcn_fence(__ATOMIC_ACQUIRE, "agent");
            asm volatile("s_waitcnt vmcnt(0)" ::: "memory");
        }
    }
    __syncthreads();
}

#ifndef EN_MASK
#define EN_MASK 0xFFFF
#endif
#define EN(b) (((EN_MASK) >> (b)) & 1)
#ifndef DUP
#define DUP 0
#endif
#define NREP(k) ((DUP) == (k) ? 2 : 1)
__global__ void __launch_bounds__(512, 2) hybrid_fwd(Params P_unused) {
    KP P = (KP)__builtin_amdgcn_kernarg_segment_ptr();
    extern __shared__ __attribute__((aligned(16))) unsigned char lds_raw[];
    ldsp lds = (ldsp)lds_raw;
    cg::grid_group grid = cg::this_grid();
    const int tid0 = threadIdx.x;
    volatile LAS unsigned* misc = (volatile LAS unsigned*)(lds + MISC_OFF);
    if (tid0 < 16) misc[tid0] = 0u;
    __syncthreads();
    (void)xcd_barrier_post((unsigned*)(P->ws + WS_CTL) + 4096, misc + 8);
#define GRID_SYNC() do { asm volatile("" : "+s"(P)); XcdBarrier xb_; xb_.bar = (unsigned*)(P->ws + WS_CTL) + 4096; xb_.x = xb_xcc_id(); xb_.st = (volatile LAS unsigned*)(lds + MISC_OFF) + 8; xcd_barrier(xb_); } while (0)
#define PHASE_BEGIN() asm volatile("" : "+s"(P)); int tid = tid0; asm volatile("" : "+v"(tid)); const int lane = tid & 63, wave = __builtin_amdgcn_readfirstlane(tid >> 6); \
    const int G = gridDim.x, gw = blockIdx.x * 8 + wave, NGW = G * 8; unsigned char* ws = P->ws; (void)lane; (void)gw; (void)NGW; (void)ws; (void)G

    {
        PHASE_BEGIN();
        if (EN(0)) norm_pass(P->in[I_X], nullptr, nullptr, P->in[I_LN_MIX_PRE], P->out, (bf16_t*)(ws + WS_U), gw, NGW, lane);
        if (EN(1)) {
            const int* pos = (const int*)P->in[I_POS];
            float* rc = (float*)(ws + WS_ROPE);
            for (int e = blockIdx.x * 512 + tid; e < MTOK * 8; e += G * 512) {
                const int m = e >> 3, j = e & 7;
                const float inv = powf(500000.0f, -(float)j * 0.125f);
                const float ang = (float)pos[m] * inv;
                rc[e] = cosf(ang); rc[(size_t)MTOK * 8 + e] = sinf(ang);
            }
        }
        if (EN(2)) convert_layer(P, 0, lds, gw, NGW, wave, lane);
    }
    grid.sync();

    for (int l = 0; l < DEPTH; ++l) {
        for (int rep = 0; rep < NREP(1); ++rep) {
            PHASE_BEGIN();
            pg8::Gemm g{(const bf16_t*)(ws + WS_U), (const bf16_t*)(ws + WS_WIN), MTOK, ZLD, DM}; pg8::StaticOrder S; S.init(MTOK, ZLD, G, (int)blockIdx.x);
            pg8::EpiBf16<0> E{(bf16_t*)(ws + WS_Z), ZLD, (float*)(ws + WS_GATE), 10};
            pg8::gemm_phase<pg8::EpiBf16<0>, pg8::StaticOrder, true, true>(lds, g, S, E, tid);
            GRID_SYNC();
        }
        for (int rep = 0; rep < ((DUP) / 10 == 2 || (DUP) == 2 ? 2 : 1); ++rep) {
            constexpr int N_CMP = 128, N_ML = 512, N_S5 = 512, N_ROPE = 48, NTOT = N_CMP + N_ML + N_S5 + N_ROPE;
            for (;;) {
                __syncthreads();
                if (tid0 == 0) misc[0] = atomicAdd((unsigned*)(P->ws + WS_CTL) + 64 * (2 * l) + 1024 * rep, 1u);
                __syncthreads();
                int item = (int)misc[0];
                PHASE_BEGIN();
                if (item >= NTOT) break;
                if (item < N_CMP) { if (EN(4) && (rep == 0 || DUP == 2 || DUP == 21)) compress_item(P, l, item, lds, tid, wave, lane); continue; } item -= N_CMP;
                if (item < N_ML) { if (EN(5) && (rep == 0 || DUP == 2 || DUP == 22)) mlstm_stage1(P, l, item, lds, tid, wave, lane); continue; } item -= N_ML;
                if (item < N_S5) { if (EN(6) && (rep == 0 || DUP == 2 || DUP == 23)) s5_stage1(P, l, item, lds, wave, lane); continue; } item -= N_S5;
                if (EN(7) && rep == 0) rope_item(P, item, tid);
            }
            GRID_SYNC();
        }
        for (int rep = 0; rep < ((DUP) / 10 == 3 || (DUP) == 3 ? 2 : 1); ++rep) {
            constexpr int N_NSA = 512, N_ML = 512, N_S5 = 256, NTOT = N_NSA + N_ML + N_S5;
            for (;;) {
                __syncthreads();
                if (tid0 == 0) misc[0] = atomicAdd((unsigned*)(P->ws + WS_CTL) + 64 * (2 * l + 1) + 1024 * rep, 1u);
                __syncthreads();
                int item = (int)misc[0];
                PHASE_BEGIN();
                if (item >= NTOT) break;
                if (item < N_NSA) { if (EN(8) && (rep == 0 || DUP == 3 || DUP == 31)) nsa_item(P, l, item, lds, tid, wave, lane); continue; } item -= N_NSA;
                if (item < N_ML) { if (EN(9) && (rep == 0 || DUP == 3 || DUP == 32)) mlstm_stage2(P, l, item, lds, tid, wave, lane); continue; } item -= N_ML;
                if (EN(10) && (rep == 0 || DUP == 3 || DUP == 33)) s5_stage2(P, l, item, lds, wave, lane);
            }
            GRID_SYNC();
        }
        for (int rep = 0; rep < NREP(4); ++rep) {
            PHASE_BEGIN();
            pg8::Gemm g{(const bf16_t*)(ws + WS_Y), (const bf16_t*)(ws + WS_WOUT), MTOK, DM, DM}; pg8::StaticOrder S; S.init(MTOK, DM, G, (int)blockIdx.x);
            pg8::EpiBf16<0> E{(bf16_t*)(ws + WS_Z), DM, nullptr, -1};
            pg8::gemm_phase<pg8::EpiBf16<0>, pg8::StaticOrder, true, true>(lds, g, S, E, tid);
            GRID_SYNC();
        }
        if (EN(12)) {
            PHASE_BEGIN();
            norm_pass(nullptr, (const bf16_t*)(ws + WS_Z), P->in[I_LN_MIX_POST] + l * DM, P->in[I_LN_MLP_PRE] + l * DM, P->out, (bf16_t*)(ws + WS_U), gw, NGW, lane);
        }
        GRID_SYNC();
        for (int rep = 0; rep < NREP(6); ++rep) {
            PHASE_BEGIN();
            pg8::Gemm g{(const bf16_t*)(ws + WS_U), (const bf16_t*)(ws + WS_W1), MTOK, DFF, DM}; pg8::StaticOrder S; S.init(MTOK, DFF, G, (int)blockIdx.x);
            pg8::EpiBf16<2> E{(bf16_t*)(ws + WS_Z), DFF, nullptr, -1};
            pg8::gemm_phase<pg8::EpiBf16<2>, pg8::StaticOrder, true, true>(lds, g, S, E, tid);
            GRID_SYNC();
        }
        for (int rep = 0; rep < NREP(7); ++rep) {
            PHASE_BEGIN();
            pg8::Gemm g{(const bf16_t*)(ws + WS_Z), (const bf16_t*)(ws + WS_W2), MTOK, DM, DFF}; pg8::StaticOrder S; S.init(MTOK, DM, G, (int)blockIdx.x);
            pg8::EpiBf16<0> E{(bf16_t*)(ws + WS_Y), DM, nullptr, -1};
            pg8::gemm_phase<pg8::EpiBf16<0>, pg8::StaticOrder, true, true>(lds, g, S, E, tid);
            GRID_SYNC();
        }
        {
            PHASE_BEGIN();
            if (EN(15)) norm_pass(nullptr, (const bf16_t*)(ws + WS_Y), P->in[I_LN_MLP_POST] + l * DM, (l + 1 < DEPTH) ? P->in[I_LN_MIX_PRE] + (l + 1) * DM : nullptr, P->out, (bf16_t*)(ws + WS_U), gw, NGW, lane);
            if (l + 1 < DEPTH) { for (int rep = 0; rep < NREP(8); ++rep) convert_layer(P, l + 1, lds, gw, NGW, wave, lane); }
        }
        if (l + 1 < DEPTH) GRID_SYNC();
    }
}

extern "C" void kernel_launch(void* const* d_in, const int* in_sizes, int n_in, void* d_out, int out_size, void* d_ws, size_t ws_size, hipStream_t stream) {
    static int grid = 0;
    if (grid == 0) {
        if (n_in != 31 || out_size != MTOK * DM || ws_size < WS_END) { fprintf(stderr, "kernel_launch: unexpected shapes (n_in %d out %d ws %zu)\n", n_in, out_size, ws_size); grid = -1; return; }
        int dev = 0, cus = 0, per_cu = 0;
        (void)hipGetDevice(&dev);
        (void)hipDeviceGetAttribute(&cus, hipDeviceAttributeMultiprocessorCount, dev);
        (void)hipFuncSetAttribute((const void*)hybrid_fwd, hipFuncAttributeMaxDynamicSharedMemorySize, LDS_BYTES);
        (void)hipOccupancyMaxActiveBlocksPerMultiprocessor(&per_cu, (const void*)hybrid_fwd, 512, LDS_BYTES);
        if (per_cu < 1) { fprintf(stderr, "kernel_launch: occupancy query says %d blocks/CU\n", per_cu); per_cu = 1; }
        grid = cus * 1;
        (void)hipGetLastError();
    }
    if (grid < 0) return;
    (void)hipMemsetAsync((char*)d_ws + WS_CTL, 0, 65536, stream);
    Params p{};
    for (int i = 0; i < 31; ++i) p.in[i] = (const float*)d_in[i];
    p.out = (float*)d_out; p.ws = (unsigned char*)d_ws;
    void* args[] = {&p};
    hipError_t e = hipLaunchCooperativeKernel((const void*)hybrid_fwd, dim3(grid), dim3(512), args, LDS_BYTES, stream);
    if (e != hipSuccess) fprintf(stderr, "cooperative launch failed: %s (grid %d)\n", hipGetErrorString(e), grid);
}
```

```cpp
#include <hip/hip_runtime.h>
#include <hip/hip_cooperative_groups.h>
#include <cstdio>
#include <cstdint>
namespace cg = cooperative_groups;

#define LAS __attribute__((address_space(3)))
typedef unsigned short bf16_t;
typedef short bf16x8 __attribute__((ext_vector_type(8)));
typedef short bf16x4 __attribute__((ext_vector_type(4)));
typedef float f32x4 __attribute__((ext_vector_type(4)));
typedef float f32x2 __attribute__((ext_vector_type(2)));
typedef unsigned u32x4 __attribute__((ext_vector_type(4)));
typedef unsigned u32x2 __attribute__((ext_vector_type(2)));
typedef LAS unsigned char* ldsp;

constexpr int NB = 8, SEQ = 2048, MTOK = NB * SEQ, DM = 1024, DEPTH = 4, DIN = 2592, ZLD = 2816, DFF = 4096;
constexpr int ZC_SU = 0, ZC_MQ = 256, ZC_MK = 512, ZC_MV = 768, ZC_MO = 1024, ZC_AQ = 1280, ZC_CK = 1792, ZC_CV = 1920,
              ZC_SK = 2048, ZC_SV = 2176, ZC_WK = 2304, ZC_WV = 2432, ZC_G = 2560;
constexpr float EPS = 1e-6f;
constexpr float NEGF = -1e30f;

constexpr size_t MiB = 1u << 20;
constexpr size_t WS_CTL = 0;
constexpr size_t WS_WIN = 1 * MiB;
constexpr size_t WS_WOUT = 7 * MiB;
constexpr size_t WS_W1 = 9 * MiB;
constexpr size_t WS_W2 = 17 * MiB;
constexpr size_t WS_WGLU = 25 * MiB;
constexpr size_t WS_CW1K = 25 * MiB + 256 * 1024;
constexpr size_t WS_CW1V = 26 * MiB + 256 * 1024;
constexpr size_t WS_CW2K = 27 * MiB + 256 * 1024;
constexpr size_t WS_CW2V = 27 * MiB + 320 * 1024;
constexpr size_t WS_CB1 = 27 * MiB + 384 * 1024;
constexpr size_t WS_ROPE = 28 * MiB;
constexpr size_t WS_GATE = 29 * MiB;
constexpr size_t WS_S5E = 31 * MiB;
constexpr size_t WS_MLC = 33 * MiB;
constexpr size_t WS_KCMP = 42 * MiB;
constexpr size_t WS_VCMP = 42 * MiB + 512 * 1024;
constexpr size_t WS_U = 44 * MiB;
constexpr size_t WS_Y = 76 * MiB;
constexpr size_t WS_Z = 108 * MiB;
constexpr size_t WS_END = 236 * MiB;
constexpr int MLC_STRIDE = 4224;

__device__ __forceinline__ float bf2f(unsigned short v) { return __uint_as_float(((unsigned)v) << 16); }
__device__ __forceinline__ unsigned cvt_pk_bf16(float lo, float hi) { unsigned r; asm volatile("v_cvt_pk_bf16_f32 %0, %1, %2" : "=v"(r) : "v"(lo), "v"(hi)); return r; }
__device__ __forceinline__ unsigned short f2bf(float f) { return (unsigned short)(cvt_pk_bf16(f, 0.f) & 0xffffu); }
template <class T> __device__ __forceinline__ T bperm_(T v, int srclane) { return __builtin_bit_cast(T, __builtin_amdgcn_ds_bpermute(srclane << 2, __builtin_bit_cast(int, v))); }
#define SHX(v, o) bperm_((v), lane ^ (o))
#define SHUP(v, o) bperm_((v), (lane >= (o)) ? lane - (o) : lane)
#define SHIDX(v, src) bperm_((v), (src))
__device__ __forceinline__ float wave_sum(float v, int lane) {
#pragma unroll
    for (int o = 1; o < 64; o <<= 1) v += SHX(v, o);
    return v;
}
__device__ __forceinline__ float sigmoidf_(float x) { return 1.0f / (1.0f + __expf(-x)); }
__device__ __forceinline__ float gelu_tanh(float x) {
    const float a = 0.7978845608028654f * (x + 0.044715f * x * x * x);
    const float e = __expf(2.0f * a);
    const float t = 1.0f - 2.0f / (e + 1.0f);
    return 0.5f * x * (1.0f + t);
}
__device__ __forceinline__ f32x4 mfma16(bf16x8 a, bf16x8 b, f32x4 c) { return __builtin_amdgcn_mfma_f32_16x16x32_bf16(a, b, c, 0, 0, 0); }
__device__ __forceinline__ bf16x8 lds_frag(ldsp lds, int byteoff) { return *(const LAS bf16x8*)(lds + byteoff); }
__device__ __forceinline__ bf16x8 pack8(const float* v) {
    u32x4 w; w.x = cvt_pk_bf16(v[0], v[1]); w.y = cvt_pk_bf16(v[2], v[3]); w.z = cvt_pk_bf16(v[4], v[5]); w.w = cvt_pk_bf16(v[6], v[7]);
    return __builtin_bit_cast(bf16x8, w);
}
__device__ __forceinline__ void unpack8(u32x4 w, float* v) {
    v[0] = __uint_as_float(w.x << 16); v[1] = __uint_as_float(w.x & 0xffff0000u);
    v[2] = __uint_as_float(w.y << 16); v[3] = __uint_as_float(w.y & 0xffff0000u);
    v[4] = __uint_as_float(w.z << 16); v[5] = __uint_as_float(w.z & 0xffff0000u);
    v[6] = __uint_as_float(w.w << 16); v[7] = __uint_as_float(w.w & 0xffff0000u);
}

namespace pg8 {
#define PG8_LAS __attribute__((address_space(3)))
constexpr int BM = 256, BK = 64, HALF = 128, HTB = HALF * BK * 2, STAGE_BYTES = 8 * HTB, NXCD = 8, WGM = 8;
__host__ __device__ __forceinline__ int lds_byte(int r, int c) { const int st = (r >> 4) * 2 + (c >> 5), rr = r & 15, cc = c & 31, ob = rr * 64 + cc * 2; return st * 1024 + (ob ^ (((ob >> 9) & 1) << 5)); }
__host__ __device__ __forceinline__ void stage_rc(int b, int& R, int& C) { const int st = b / 1024, sb = b % 1024, swz = sb ^ (((sb >> 9) & 1) << 5); R = (st >> 1) * 16 + swz / 64; C = (st & 1) * 32 + (swz % 64) / 2; }
__host__ __device__ __forceinline__ int perm32(int rho) { const int n = rho >> 4, i = rho & 15; return 8 * (i >> 2) + 4 * n + (i & 3); }
struct Unit { int pm, pn; };
struct Gemm { const bf16_t* A; const bf16_t* Bt; int M, N, K; };
struct StaticOrder {
    int nM, nN, nwg, G, c;
    __host__ __device__ void init(int M, int N, int G_, int c_) { nM = M / BM; nN = N / BM; nwg = nM * nN; G = G_; c = c_; }
    __host__ __device__ bool next(int i, Unit& u) const {
        const long L = (long)i * G + c; if (L >= nwg) return false;
        int wgid = (int)L; { const int q = nwg / NXCD, r = nwg % NXCD, xcd = wgid % NXCD, off = wgid / NXCD; wgid = (xcd < r ? xcd * (q + 1) : r * (q + 1) + (xcd - r) * q) + off; }
        const int nig = WGM * nN, gid = wgid / nig, fm = gid * WGM, gsz = (nM - fm) < WGM ? (nM - fm) : WGM;
        u.pm = fm + ((wgid % nig) % gsz); u.pn = (wgid % nig) / gsz; return true;
    }
    __device__ __forceinline__ void a_ready(const Unit&) const {}
    __device__ __forceinline__ void done(const Unit&) const {}
};
template <int ACT  > struct EpiBf16 {
    static constexpr bool PERM = true, AFTER_DRAIN = false;
    bf16_t* O; int ldc; float* gate; int gate_pn;
    __device__ __forceinline__ void operator()(const f32x4 (&acc)[2][2][4][2], const Unit& u, int wr, int wc, int fr, int fq) const {
        const int row0 = u.pm * BM + wr * 64 + fr;
        if (u.pn == gate_pn) {
            if (wc == 0) {
#pragma unroll
                for (int ai = 0; ai < 2; ++ai)
#pragma unroll
                    for (int m = 0; m < 4; ++m) { float* gp = gate + (size_t)(row0 + ai * HALF + m * 16) * 32 + 8 * fq;
                        *(f32x4*)(gp) = acc[ai][0][m][0]; *(f32x4*)(gp + 4) = acc[ai][0][m][1]; }
            }
            return;
        }
        const int col0 = u.pn * BM + wc * 32 + 8 * fq;
#pragma unroll
        for (int ai = 0; ai < 2; ++ai)
#pragma unroll
            for (int m = 0; m < 4; ++m) { bf16_t* rowp = O + (size_t)(row0 + ai * HALF + m * 16) * ldc + col0;
#pragma unroll
                for (int bj = 0; bj < 2; ++bj) { f32x4 v0 = acc[ai][bj][m][0], v1 = acc[ai][bj][m][1];
                    if (ACT == 2) {
#pragma unroll
                        for (int e = 0; e < 4; ++e) { float a = fmaxf(v0[e], 0.f); v0[e] = a * a; float b = fmaxf(v1[e], 0.f); v1[e] = b * b; }
                    }
                    u32x4 w; w.x = cvt_pk_bf16(v0[0], v0[1]); w.y = cvt_pk_bf16(v0[2], v0[3]); w.z = cvt_pk_bf16(v1[0], v1[1]); w.w = cvt_pk_bf16(v1[2], v1[3]);
                    *(u32x4*)(rowp + bj * HALF) = w; } }
    }
};

template <class Epi, class Sched, bool ALIGN_EPI = false, bool SP2 = false>
__device__ __forceinline__ void gemm_phase(PG8_LAS unsigned char* lds, const Gemm g, const Sched& S, const Epi& E, const int tid) {
    const int wid = __builtin_amdgcn_readfirstlane(tid >> 6), lane = tid & 63, wr = wid >> 2, wc = wid & 3, fr = lane & 15, fq = lane >> 4;
    const int K = g.K, nt = K / BK;
    unsigned voffA[2], voffB[2];
#pragma unroll
    for (int i = 0; i < 2; ++i) { int R, C; stage_rc(tid * 16 + i * 8192, R, C); const int Rb = Epi::PERM ? ((R & ~31) + perm32(R & 31)) : R;
        voffA[i] = (unsigned)(R * K + C) * 2u; voffB[i] = (unsigned)(Rb * K + C) * 2u; }
    const size_t kstep = (size_t)(BK * 2);
    const size_t hstep = (size_t)HALF * K * 2;
    const size_t tstep = 2 * hstep;
    const unsigned ldsw = (unsigned)wid * 1024u;
    const int aoff = lds_byte(wr * 64 + fr, fq * 8), boff = lds_byte(wc * 32 + fr, fq * 8);
#define PG8_SA(b, h) (((b) * 2 + (h)) * HTB)
#define PG8_SB(b, h) ((4 + (b) * 2 + (h)) * HTB)
#define PG8_STAGE(bufoff, gbase, voff) do { _Pragma("unroll") for (int _i = 0; _i < 2; ++_i) \
        __builtin_amdgcn_global_load_lds((const unsigned*)((const char*)(gbase) + (voff)[_i]), (PG8_LAS unsigned*)(lds + (bufoff) + ldsw + _i * 8192), 16, 0, 0); } while (0)
#define PG8_LDA(dst, b, h) do { _Pragma("unroll") for (int m = 0; m < 4; ++m) _Pragma("unroll") for (int k = 0; k < 2; ++k) dst[m][k] = *(const PG8_LAS bf16x8*)(lds + PG8_SA(b, h) + aoff + m * 2048 + k * 1024); } while (0)
#define PG8_LDB(dst, b, h) do { _Pragma("unroll") for (int n = 0; n < 2; ++n) _Pragma("unroll") for (int k = 0; k < 2; ++k) dst[n][k] = *(const PG8_LAS bf16x8*)(lds + PG8_SB(b, h) + boff + n * 2048 + k * 1024); } while (0)
#define PG8_MMA(ai, bj, At, Bt) do { __builtin_amdgcn_s_setprio(1); _Pragma("unroll") for (int m = 0; m < 4; ++m) _Pragma("unroll") for (int n = 0; n < 2; ++n) _Pragma("unroll") for (int k = 0; k < 2; ++k) \
        acc[ai][bj][m][n] = __builtin_amdgcn_mfma_f32_16x16x32_bf16(Bt[n][k], At[m][k], acc[ai][bj][m][n], 0, 0, 0); __builtin_amdgcn_s_setprio(0); } while (0)
#define PG8_WAIT_V(n) asm volatile("s_waitcnt vmcnt(" #n ")" ::: "memory")
#define PG8_WAIT_L(n) asm volatile("s_waitcnt lgkmcnt(" #n ")" ::: "memory")
#define PG8_BAR __builtin_amdgcn_s_barrier()
#define PG8_SCHED __builtin_amdgcn_sched_barrier(0)
    Unit cur, nxt; int ui = 0;
    if (!S.next(0, cur)) return;
    f32x4 acc[2][2][4][2];
#pragma unroll
    for (int a = 0; a < 2; ++a)
#pragma unroll
        for (int b = 0; b < 2; ++b)
#pragma unroll
            for (int m = 0; m < 4; ++m)
#pragma unroll
                for (int n = 0; n < 2; ++n) acc[a][b][m][n] = (f32x4){0.f, 0.f, 0.f, 0.f};
    bf16x8 At[4][2], B0[2][2], B1[2][2];
    const char* cA = (const char*)g.A + (size_t)cur.pm * tstep; const char* cB = (const char*)g.Bt + (size_t)cur.pn * tstep;
    S.a_ready(cur);
    if constexpr (SP2) {
        PG8_STAGE(PG8_SB(0, 0), cB, voffB); PG8_STAGE(PG8_SB(0, 1), cB + hstep, voffB); PG8_STAGE(PG8_SA(0, 0), cA, voffA); PG8_STAGE(PG8_SA(0, 1), cA + hstep, voffA);
        if (wr == 1) PG8_BAR;
        PG8_WAIT_V(2); PG8_BAR;
        PG8_STAGE(PG8_SB(1, 0), cB + kstep, voffB); PG8_STAGE(PG8_SA(1, 0), cA + kstep, voffA); PG8_STAGE(PG8_SB(1, 1), cB + hstep + kstep, voffB);
        PG8_WAIT_V(6); PG8_BAR;
    } else {
        PG8_STAGE(PG8_SB(0, 0), cB, voffB); PG8_STAGE(PG8_SA(0, 0), cA, voffA); PG8_STAGE(PG8_SB(0, 1), cB + hstep, voffB); PG8_STAGE(PG8_SA(0, 1), cA + hstep, voffA);
        if (wr == 1) PG8_BAR;
        PG8_WAIT_V(4); PG8_BAR;
        PG8_STAGE(PG8_SB(1, 0), cB + kstep, voffB); PG8_STAGE(PG8_SA(1, 0), cA + kstep, voffA); PG8_STAGE(PG8_SB(1, 1), cB + hstep + kstep, voffB);
        PG8_WAIT_V(6); PG8_BAR;
    }
    for (;;) {
        const bool has_next = S.next(ui + 1, nxt);
        const char* nA = has_next ? (const char*)g.A + (size_t)nxt.pm * tstep : cA; const char* nB = has_next ? (const char*)g.Bt + (size_t)nxt.pn * tstep : cB;
        for (int t = 0; t < nt; t += 2) {
            const bool last = (t == nt - 2);
            const char* a1 = cA + (size_t)(t + 1) * kstep;
            const char* a2 = last ? nA : cA + (size_t)(t + 2) * kstep; const char* b2 = last ? nB : cB + (size_t)(t + 2) * kstep;
            const char* a3 = a2 + kstep; const char* b3 = b2 + kstep;
            if (last && has_next) S.a_ready(nxt);
            if constexpr (SP2) {
            PG8_LDB(B0, 0, 0); PG8_LDB(B1, 0, 1); PG8_SCHED; PG8_LDA(At, 0, 0); PG8_STAGE(PG8_SA(1, 1), a1 + hstep, voffA);
            PG8_WAIT_V(8); PG8_WAIT_L(0); PG8_BAR; PG8_MMA(0, 0, At, B0); PG8_MMA(0, 1, At, B1); PG8_BAR; PG8_SCHED;
            PG8_LDA(At, 0, 1); PG8_STAGE(PG8_SB(0, 0), b2, voffB); PG8_STAGE(PG8_SB(0, 1), b2 + hstep, voffB); PG8_STAGE(PG8_SA(0, 0), a2, voffA);
            PG8_WAIT_V(8); PG8_WAIT_L(0); PG8_BAR; PG8_MMA(1, 0, At, B0); PG8_MMA(1, 1, At, B1); PG8_BAR; PG8_SCHED;
            PG8_LDB(B0, 1, 0); PG8_LDB(B1, 1, 1); PG8_SCHED; PG8_LDA(At, 1, 0); PG8_STAGE(PG8_SA(0, 1), a2 + hstep, voffA);
            PG8_WAIT_V(8); PG8_WAIT_L(0); PG8_BAR; PG8_MMA(0, 0, At, B0); PG8_MMA(0, 1, At, B1); PG8_BAR; PG8_SCHED;
            PG8_LDA(At, 1, 1); PG8_STAGE(PG8_SB(1, 0), b3, voffB); PG8_STAGE(PG8_SB(1, 1), b3 + hstep, voffB); PG8_STAGE(PG8_SA(1, 0), a3, voffA);
            PG8_WAIT_V(8); PG8_WAIT_L(0); PG8_BAR; PG8_MMA(1, 0, At, B0); PG8_MMA(1, 1, At, B1); PG8_BAR; PG8_SCHED;
            } else {
            PG8_LDB(B0, 0, 0); PG8_SCHED; PG8_LDA(At, 0, 0); PG8_STAGE(PG8_SA(1, 1), a1 + hstep, voffA);
            PG8_WAIT_L(8); PG8_BAR; PG8_WAIT_L(0); PG8_MMA(0, 0, At, B0); PG8_BAR; PG8_SCHED;
            PG8_LDB(B1, 0, 1); PG8_STAGE(PG8_SB(0, 0), b2, voffB);
            PG8_BAR; PG8_WAIT_L(0); PG8_MMA(0, 1, At, B1); PG8_BAR;
            PG8_LDA(At, 0, 1); PG8_STAGE(PG8_SA(0, 0), a2, voffA);
            PG8_BAR; PG8_WAIT_L(0); PG8_MMA(1, 0, At, B0); PG8_BAR; PG8_SCHED;
            PG8_STAGE(PG8_SB(0, 1), b2 + hstep, voffB);
            PG8_WAIT_V(6); PG8_BAR; PG8_MMA(1, 1, At, B1); PG8_BAR;
            PG8_LDB(B0, 1, 0); PG8_SCHED; PG8_LDA(At, 1, 0); PG8_STAGE(PG8_SA(0, 1), a2 + hstep, voffA);
            PG8_WAIT_L(8); PG8_BAR; PG8_WAIT_L(0); PG8_MMA(0, 0, At, B0); PG8_BAR; PG8_SCHED;
            PG8_LDB(B1, 1, 1); PG8_STAGE(PG8_SB(1, 0), b3, voffB);
            PG8_BAR; PG8_WAIT_L(0); PG8_MMA(0, 1, At, B1); PG8_BAR;
            PG8_LDA(At, 1, 1); PG8_STAGE(PG8_SA(1, 0), a3, voffA);
            PG8_BAR; PG8_WAIT_L(0); PG8_MMA(1, 0, At, B0); PG8_BAR; PG8_SCHED;
            PG8_STAGE(PG8_SB(1, 1), b3 + hstep, voffB);
            PG8_WAIT_V(6); PG8_BAR; PG8_MMA(1, 1, At, B1); PG8_BAR;
            }
        }
        if constexpr (ALIGN_EPI) { if (wr == 0) PG8_BAR; }
        if constexpr (!Epi::AFTER_DRAIN) { E(acc, cur, wr, wc, fr, fq); S.done(cur); }
        if (!has_next) break;
#pragma unroll
        for (int a = 0; a < 2; ++a)
#pragma unroll
            for (int b = 0; b < 2; ++b)
#pragma unroll
                for (int m = 0; m < 4; ++m)
#pragma unroll
                    for (int n = 0; n < 2; ++n) acc[a][b][m][n] = (f32x4){0.f, 0.f, 0.f, 0.f};
        cur = nxt; cA = nA; cB = nB; ++ui;
        if constexpr (ALIGN_EPI) { if (wr == 1) PG8_BAR; }
    }
    PG8_WAIT_V(0);
    if constexpr (!ALIGN_EPI) { if (wr == 0) PG8_BAR; }
    PG8_BAR;
#undef PG8_SA
#undef PG8_SB
#undef PG8_STAGE
#undef PG8_LDA
#undef PG8_LDB
#undef PG8_MMA
#undef PG8_WAIT_V
#undef PG8_WAIT_L
#undef PG8_BAR
#undef PG8_SCHED
}
}

struct Params {
    const float* in[31];
    float* out;
    unsigned char* ws;
};
typedef const __attribute__((address_space(4))) Params* KP;
enum { I_X = 0, I_POS, I_LN_MIX_PRE, I_LN_MIX_POST, I_LN_MLP_PRE, I_LN_MLP_POST, I_W_IN, I_W_OUT, I_LAM_RE, I_LAM_IM, I_B_RE, I_B_IM, I_C_RE, I_C_IM,
       I_SSM_D, I_LOG_DT, I_W_GLU, I_CONV, I_B_I, I_B_F, I_PE_K, I_W1_K, I_W2_K, I_PE_V, I_W1_V, I_W2_V, I_GN_SSM, I_GN_MLSTM, I_GN_NSA, I_MLP_W1, I_MLP_W2 };

constexpr int LDS_BYTES = 147456;
constexpr int MISC_OFF = 131072 + 8192;

__device__ __forceinline__ int win_src_col(int n) {
    if (n < 1280) return n;
    if (n < 2560) return n + 8;
    if (n < 2568) return n - 2560 + 1280;
    if (n < 2592) return n;
    return -1;
}
__device__ __forceinline__ void conv_item(const float* W, int K, int N, bf16_t* WT, int mode, int nblk, LAS float* scr, int item, int lane) {
    const int kb = item / nblk, nb = item % nblk, k0 = 64 * kb, n0 = 32 * nb;
    const int nn = n0 + (lane & 31);
    const int sc = mode ? win_src_col(nn) : nn;
#pragma unroll 8
    for (int i = 0; i < 32; ++i) { const int kk = 2 * i + (lane >> 5); scr[kk * 33 + (lane & 31)] = (sc >= 0) ? W[(size_t)(k0 + kk) * N + sc] : 0.f; }
    asm volatile("s_waitcnt lgkmcnt(0)" ::: "memory");
    const int c = lane & 7;
#pragma unroll
    for (int j = 0; j < 4; ++j) { const int n = (lane >> 3) + 8 * j; const LAS float* s = scr + (8 * c) * 33 + n;
        u32x4 o; o.x = cvt_pk_bf16(s[0 * 33], s[1 * 33]); o.y = cvt_pk_bf16(s[2 * 33], s[3 * 33]); o.z = cvt_pk_bf16(s[4 * 33], s[5 * 33]); o.w = cvt_pk_bf16(s[6 * 33], s[7 * 33]);
        *(u32x4*)(WT + (size_t)(n0 + n) * K + k0 + 8 * c) = o; }
    asm volatile("s_waitcnt lgkmcnt(0)" ::: "memory");
}

__device__ __forceinline__ void convert_layer(KP P, int l, ldsp lds, int gw, int NGW, int wave, int lane) {
    LAS float* scr = (LAS float*)(lds + wave * 16384);
    unsigned char* ws = P->ws;
    constexpr int I0 = 16 * 88, I1 = 16 * 32, I2 = 16 * 128, I3 = 64 * 32, I4 = 4 * 8, I5 = 32 * 8, I6 = 32 * 8, I7 = 4 * 2, I8 = 4 * 2, I9 = 128;
    constexpr int NIT = I0 + I1 + I2 + I3 + I4 + I5 + I6 + I7 + I8 + I9;
    for (int it = gw; it < NIT; it += NGW) {
        int r = it;
        if (r < I0) { conv_item(P->in[I_W_IN] + (size_t)l * DM * DIN, DM, DIN, (bf16_t*)(ws + WS_WIN), 1, 88, scr, r, lane); continue; } r -= I0;
        if (r < I1) { conv_item(P->in[I_W_OUT] + (size_t)l * DM * DM, DM, DM, (bf16_t*)(ws + WS_WOUT), 0, 32, scr, r, lane); continue; } r -= I1;
        if (r < I2) { conv_item(P->in[I_MLP_W1] + (size_t)l * DM * DFF, DM, DFF, (bf16_t*)(ws + WS_W1), 0, 128, scr, r, lane); continue; } r -= I2;
        if (r < I3) { conv_item(P->in[I_MLP_W2] + (size_t)l * DFF * DM, DFF, DM, (bf16_t*)(ws + WS_W2), 0, 32, scr, r, lane); continue; } r -= I3;
        if (r < I4) { conv_item(P->in[I_W_GLU] + (size_t)l * 256 * 256, 256, 256, (bf16_t*)(ws + WS_WGLU), 0, 8, scr, r, lane); continue; } r -= I4;
        if (r < I5) { conv_item(P->in[I_W1_K] + (size_t)l * 2048 * 256, 2048, 256, (bf16_t*)(ws + WS_CW1K), 0, 8, scr, r, lane); continue; } r -= I5;
        if (r < I6) { conv_item(P->in[I_W1_V] + (size_t)l * 2048 * 256, 2048, 256, (bf16_t*)(ws + WS_CW1V), 0, 8, scr, r, lane); continue; } r -= I6;
        if (r < I7) { conv_item(P->in[I_W2_K] + (size_t)l * 256 * 64, 256, 64, (bf16_t*)(ws + WS_CW2K), 0, 2, scr, r, lane); continue; } r -= I7;
        if (r < I8) { conv_item(P->in[I_W2_V] + (size_t)l * 256 * 64, 256, 64, (bf16_t*)(ws + WS_CW2V), 0, 2, scr, r, lane); continue; } r -= I8;
        {
            const int kv = r >> 6, hid = ((r >> 4) & 3) * 64 + lane, kc = r & 15;
            const float* pe = P->in[kv ? I_PE_V : I_PE_K] + (size_t)l * 2048 + kc * 128;
            const float* w1 = P->in[kv ? I_W1_V : I_W1_K] + (size_t)l * 2048 * 256 + (size_t)kc * 128 * 256;
            float a0 = 0.f, a1 = 0.f, a2 = 0.f, a3 = 0.f;
#pragma unroll 4
            for (int k = 0; k < 128; k += 4) {
                a0 += pe[k] * w1[(size_t)k * 256 + hid]; a1 += pe[k + 1] * w1[(size_t)(k + 1) * 256 + hid];
                a2 += pe[k + 2] * w1[(size_t)(k + 2) * 256 + hid]; a3 += pe[k + 3] * w1[(size_t)(k + 3) * 256 + hid];
            }
            ((float*)(ws + WS_CB1))[kc * 512 + kv * 256 + hid] = (a0 + a1) + (a2 + a3);
        }
    }
}

__device__ __forceinline__ void norm_pass(const float* xin, const bf16_t* f, const float* gpost, const float* gpre, float* h, bf16_t* u, int gw, int NGW, int lane) {
    for (int m = gw; m < MTOK; m += NGW) {
        f32x4 hv[4];
        if (f == nullptr) {
#pragma unroll
            for (int j = 0; j < 4; ++j) hv[j] = *(const f32x4*)(xin + (size_t)m * DM + 4 * lane + 256 * j);
        } else {
            f32x4 fv[4]; float ss = 0.f;
#pragma unroll
            for (int j = 0; j < 4; ++j) {
                hv[j] = *(const f32x4*)(h + (size_t)m * DM + 4 * lane + 256 * j);
                const u32x2 w = *(const u32x2*)(f + (size_t)m * DM + 4 * lane + 256 * j);
                fv[j][0] = __uint_as_float(w.x << 16); fv[j][1] = __uint_as_float(w.x & 0xffff0000u); fv[j][2] = __uint_as_float(w.y << 16); fv[j][3] = __uint_as_float(w.y & 0xffff0000u);
                ss += fv[j][0] * fv[j][0] + fv[j][1] * fv[j][1] + fv[j][2] * fv[j][2] + fv[j][3] * fv[j][3];
            }
            ss = wave_sum(ss, lane);
            const float rs = rsqrtf(ss * (1.0f / DM) + EPS);
#pragma unroll
            for (int j = 0; j < 4; ++j) { const f32x4 g = *(const f32x4*)(gpost + 4 * lane + 256 * j); hv[j] += fv[j] * rs * g; }
        }
#pragma unroll
        for (int j = 0; j < 4; ++j) *(f32x4*)(h + (size_t)m * DM + 4 * lane + 256 * j) = hv[j];
        if (gpre) {
            float ss = 0.f;
#pragma unroll
            for (int j = 0; j < 4; ++j) ss += hv[j][0] * hv[j][0] + hv[j][1] * hv[j][1] + hv[j][2] * hv[j][2] + hv[j][3] * hv[j][3];
            ss = wave_sum(ss, lane);
            const float rs = rsqrtf(ss * (1.0f / DM) + EPS);
#pragma unroll
            for (int j = 0; j < 4; ++j) { const f32x4 g = *(const f32x4*)(gpre + 4 * lane + 256 * j); const f32x4 o = hv[j] * rs * g;
                u32x2 w; w.x = cvt_pk_bf16(o[0], o[1]); w.y = cvt_pk_bf16(o[2], o[3]); *(u32x2*)(u + (size_t)m * DM + 4 * lane + 256 * j) = w; }
        }
    }
}

struct S5P { float ar, ai; float bbr[16], bbi[16]; };
__device__ __forceinline__ void s5_setup(KP P, int l, int g, int p, S5P& s) {
    const float dt = expf(P->in[I_LOG_DT][l * 16 + g]);
    const float lr = P->in[I_LAM_RE][(l * 16 + g) * 64 + p], li = P->in[I_LAM_IM][(l * 16 + g) * 64 + p];
    const float mag = expf(lr * dt), ang = li * dt;
    s.ar = mag * cosf(ang); s.ai = mag * sinf(ang);
    const float den = lr * lr + li * li;
    const float gr = ((s.ar - 1.0f) * lr + s.ai * li) / den, gi = (s.ai * lr - (s.ar - 1.0f) * li) / den;
    const float* br = P->in[I_B_RE] + ((size_t)(l * 16 + g) * 64 + p) * 16;
    const float* bi = P->in[I_B_IM] + ((size_t)(l * 16 + g) * 64 + p) * 16;
#pragma unroll
    for (int q = 0; q < 4; ++q) { const f32x4 a = *(const f32x4*)(br + 4 * q), b = *(const f32x4*)(bi + 4 * q);
#pragma unroll
        for (int e = 0; e < 4; ++e) { s.bbr[4 * q + e] = gr * a[e] - gi * b[e]; s.bbi[4 * q + e] = gr * b[e] + gi * a[e]; } }
}
__device__ __forceinline__ void s5_stage_u(const bf16_t* z, int m0, int g, LAS float* us, int lane) {
    const bf16_t* src = z + (size_t)(m0 + lane) * ZLD + ZC_SU + g * 16;
    const u32x4 w0 = *(const u32x4*)src, w1 = *(const u32x4*)(src + 8);
    float v[16]; unpack8(w0, v); unpack8(w1, v + 8);
#pragma unroll
    for (int q = 0; q < 4; ++q) *(LAS f32x4*)(us + lane * 16 + 4 * q) = (f32x4){v[4 * q], v[4 * q + 1], v[4 * q + 2], v[4 * q + 3]};
}
__device__ __forceinline__ void s5_step(const S5P& s, const LAS float* ut, float& xr, float& xi) {
    float bur = 0.f, bui = 0.f;
#pragma unroll
    for (int q = 0; q < 4; ++q) { const f32x4 u4 = *(const LAS f32x4*)(ut + 4 * q);
#pragma unroll
        for (int e = 0; e < 4; ++e) { bur += s.bbr[4 * q + e] * u4[e]; bui += s.bbi[4 * q + e] * u4[e]; } }
    const float nr = s.ar * xr - s.ai * xi + bur, ni = s.ar * xi + s.ai * xr + bui;
    xr = nr; xi = ni;
}

__device__ __forceinline__ void s5_stage1(KP P, int l, int bitem, ldsp lds, int wave, int lane) {
    const int wi = bitem * 8 + wave;
    const int c = wi & 31, g = (wi >> 5) & 15, b = wi >> 9;
    const bf16_t* z = (const bf16_t*)(P->ws + WS_Z);
    LAS float* us = (LAS float*)(lds + wave * 4096);
    S5P s; s5_setup(P, l, g, lane, s);
    s5_stage_u(z, b * SEQ + c * 64, g, us, lane);
    float xr = 0.f, xi = 0.f;
#pragma unroll 4
    for (int t = 0; t < 64; ++t) s5_step(s, us + t * 16, xr, xi);
    float* E = (float*)(P->ws + WS_S5E) + (size_t)wi * 128;
    E[lane] = xr; E[64 + lane] = xi;
}

__device__ __forceinline__ void s5_stage2(KP P, int l, int bitem, ldsp lds, int wave, int lane) {
    const int c = bitem & 31, b = bitem >> 5;
    const bf16_t* z = (const bf16_t*)(P->ws + WS_Z);
    constexpr int YLD = 264;
    const int Y_OFF = 0, US_OFF = 34816 + wave * 4096, XS_OFF = 34816 + 32768 + wave * 4352;
    LAS float* us = (LAS float*)(lds + US_OFF);
    const int r16 = lane & 15, g4 = lane >> 4;
    const int m0 = b * SEQ + c * 64;
    for (int gi = 0; gi < 2; ++gi) {
        const int g = 2 * wave + gi;
        S5P s; s5_setup(P, l, g, lane, s);
        bf16x8 Cf[4];
        {
            const float* cre = P->in[I_C_RE] + ((size_t)(l * 16 + g) * 16 + r16) * 64;
            const float* cim = P->in[I_C_IM] + ((size_t)(l * 16 + g) * 16 + r16) * 64;
#pragma unroll
            for (int ks = 0; ks < 4; ++ks) {
                const float* src = (ks < 2 ? cre : cim) + 32 * (ks & 1) + 8 * g4;
                const f32x4 a = *(const f32x4*)src, bq = *(const f32x4*)(src + 4);
                const float sg = ks < 2 ? 1.f : -1.f;
                float v[8] = {a[0] * sg, a[1] * sg, a[2] * sg, a[3] * sg, bq[0] * sg, bq[1] * sg, bq[2] * sg, bq[3] * sg};
                Cf[ks] = pack8(v);
            }
        }
        const float dsk = P->in[I_SSM_D][l * 256 + g * 16 + r16];
        s5_stage_u(z, m0, g, us, lane);
        float xr = 0.f, xi = 0.f;
        {
            float pr = s.ar, pi = s.ai;
#pragma unroll
            for (int q = 0; q < 6; ++q) { const float nr = pr * pr - pi * pi, ni = 2.f * pr * pi; pr = nr; pi = ni; }
            const float* E = (const float*)(P->ws + WS_S5E) + (size_t)((b * 16 + g) * 32) * 128;
            for (int c0 = 0; c0 < c; c0 += 8) {
                float er[8], ei[8];
#pragma unroll
                for (int i = 0; i < 8; ++i) { const int cc = (c0 + i < c) ? c0 + i : c - 1; er[i] = E[cc * 128 + lane]; ei[i] = E[cc * 128 + 64 + lane]; }
#pragma unroll
                for (int i = 0; i < 8; ++i) if (c0 + i < c) { const float nr = pr * xr - pi * xi + er[i], ni = pr * xi + pi * xr + ei[i]; xr = nr; xi = ni; }
            }
        }
        for (int tb = 0; tb < 4; ++tb) {
#pragma unroll 4
            for (int tt = 0; tt < 16; ++tt) {
                s5_step(s, us + (tb * 16 + tt) * 16, xr, xi);
                *(LAS bf16_t*)(lds + XS_OFF + (tt * 136 + lane) * 2) = f2bf(xr);
                *(LAS bf16_t*)(lds + XS_OFF + (tt * 136 + 64 + lane) * 2) = f2bf(xi);
            }
            f32x4 acc = (f32x4){0.f, 0.f, 0.f, 0.f};
#pragma unroll
            for (int ks = 0; ks < 4; ++ks) acc = mfma16(lds_frag(lds, XS_OFF + (r16 * 136 + 32 * ks + 8 * g4) * 2), Cf[ks], acc);
#pragma unroll
            for (int rg = 0; rg < 4; ++rg) {
                const int tok = tb * 16 + 4 * g4 + rg;
                float y = acc[rg] + dsk * us[tok * 16 + r16];
                y = gelu_tanh(y);
                *(LAS bf16_t*)(lds + Y_OFF + (tok * YLD + g * 16 + r16) * 2) = f2bf(y);
            }
        }
    }
    {
        const bf16_t* wg = (const bf16_t*)(P->ws + WS_WGLU);
        bf16x8 bfr[8][2];
#pragma unroll
        for (int ks = 0; ks < 8; ++ks)
#pragma unroll
            for (int nf = 0; nf < 2; ++nf) bfr[ks][nf] = *(const bf16x8*)(wg + (size_t)(32 * wave + 16 * nf + r16) * 256 + 32 * ks + 8 * g4);
        __syncthreads();
        f32x4 acc[4][2];
#pragma unroll
        for (int mf = 0; mf < 4; ++mf) { acc[mf][0] = (f32x4){0.f, 0.f, 0.f, 0.f}; acc[mf][1] = (f32x4){0.f, 0.f, 0.f, 0.f}; }
#pragma unroll
        for (int ks = 0; ks < 8; ++ks) {
#pragma unroll
            for (int mf = 0; mf < 4; ++mf) { const bf16x8 af = lds_frag(lds, Y_OFF + ((16 * mf + r16) * YLD + 32 * ks + 8 * g4) * 2);
                acc[mf][0] = mfma16(af, bfr[ks][0], acc[mf][0]); acc[mf][1] = mfma16(af, bfr[ks][1], acc[mf][1]); }
        }
        bf16_t* yo = (bf16_t*)(P->ws + WS_Y);
#pragma unroll
        for (int nf = 0; nf < 2; ++nf) {
            const int n = 32 * wave + 16 * nf + r16;
            const float gn = P->in[I_GN_SSM][l * 256 + n];
#pragma unroll
            for (int mf = 0; mf < 4; ++mf)
#pragma unroll
                for (int rg = 0; rg < 4; ++rg) {
                    const int tok = 16 * mf + 4 * g4 + rg;
                    const float yv = bf2f(*(const LAS bf16_t*)(lds + Y_OFF + (tok * YLD + n) * 2));
                    const float o = yv * sigmoidf_(acc[mf][nf][rg]);
                    float ss = o * o;
                    ss += SHX(ss, 1); ss += SHX(ss, 2); ss += SHX(ss, 4); ss += SHX(ss, 8);
                    const float rs = rsqrtf(ss * (1.0f / 16.0f) + EPS);
                    yo[(size_t)(m0 + tok) * DM + n] = f2bf(o * rs * gn);
                }
        }
    }
}

__device__ __forceinline__ float log_sigmoid(float x) { return x > 0.f ? -log1pf(expf(-x)) : x - log1pf(expf(x)); }

__device__ __forceinline__ void conv_silu16(const bf16_t* z, const float* convw  , int b, int t, int zcol, int ch0, float* out) {
#pragma unroll
    for (int i = 0; i < 16; ++i) out[i] = 0.f;
#pragma unroll
    for (int j = 0; j < 4; ++j) {
        const int ts = t - 3 + j;
        if (ts >= 0) {
            const bf16_t* src = z + (size_t)(b * SEQ + ts) * ZLD + zcol;
            const u32x4 w0 = *(const u32x4*)src, w1 = *(const u32x4*)(src + 8);
            float v[16]; unpack8(w0, v); unpack8(w1, v + 8);
            const float* cw = convw + j * 512 + ch0;
#pragma unroll
            for (int q = 0; q < 4; ++q) { const f32x4 c4 = *(const f32x4*)(cw + 4 * q);
#pragma unroll
                for (int e = 0; e < 4; ++e) out[4 * q + e] += v[4 * q + e] * c4[e]; }
        }
    }
#pragma unroll
    for (int i = 0; i < 16; ++i) out[i] = out[i] * sigmoidf_(out[i]);
}

__device__ __forceinline__ float wave_scan_add(float v, int lane) {
#pragma unroll
    for (int o = 1; o < 64; o <<= 1) { const float t = SHUP(v, o); if (lane >= o) v += t; }
    return v;
}
__device__ __forceinline__ float wave_scan_max(float v, int lane) {
#pragma unroll
    for (int o = 1; o < 64; o <<= 1) { const float t = SHUP(v, o); if (lane >= o) v = fmaxf(v, t); }
    return v;
}
__device__ __forceinline__ void mlstm_gates_w0(KP P, int l, int b, int hh, int c, LAS float* G, int lane) {
    const float* gate = (const float*)(P->ws + WS_GATE);
    const int s0 = 2 * lane;
    const size_t m0 = (size_t)b * SEQ + c * 128 + s0;
    const float bi = P->in[I_B_I][l * 4 + hh], bfv = P->in[I_B_F][l * 4 + hh];
    const float ig0 = gate[m0 * 32 + hh] + bi, ig1 = gate[(m0 + 1) * 32 + hh] + bi;
    const float lf0 = log_sigmoid(gate[m0 * 32 + 4 + hh] + bfv), lf1 = log_sigmoid(gate[(m0 + 1) * 32 + 4 + hh] + bfv);
    const float sm = lf0 + lf1, incl = wave_scan_add(sm, lane), excl = incl - sm;
    const float b0 = excl + lf0, b1 = incl;
    const float d0 = ig0 - b0, d1 = ig1 - b1;
    const float inclm = wave_scan_max(fmaxf(d0, d1), lane);
    float exclm = SHUP(inclm, 1); if (lane == 0) exclm = NEGF;
    const float maxd = SHIDX(inclm, 63);
    G[s0] = ig0; G[s0 + 1] = ig1; G[128 + s0] = b0; G[128 + s0 + 1] = b1;
    G[256 + s0] = fmaxf(exclm, d0); G[256 + s0 + 1] = inclm;
    G[384 + s0] = __expf(d0 - maxd); G[384 + s0 + 1] = __expf(d1 - maxd);
    if (lane == 63) { G[512] = b1; G[513] = b1 + maxd; }
}

__device__ __forceinline__ void mlstm_stage1(KP P, int l, int item, ldsp lds, int tid, int wave, int lane) {
    const int c = item & 15, hh = (item >> 4) & 3, b = item >> 6;
    const bf16_t* z = (const bf16_t*)(P->ws + WS_Z);
    constexpr int KW_OFF = 0, VT_OFF = 17408, G_OFF = 34816, LD = 136;
    LAS float* G = (LAS float*)(lds + G_OFF);
    if (wave == 0) mlstm_gates_w0(P, l, b, hh, c, G, lane);
    __syncthreads();
    {
        const int s = tid >> 2, q4 = tid & 3, t = c * 128 + s;
        float kv[16];
        conv_silu16(z, P->in[I_CONV] + (size_t)l * 2048, b, t, ZC_MK + hh * 64 + 16 * q4, 256 + hh * 64 + 16 * q4, kv);
        const float wk = G[384 + s] * 0.125f;
#pragma unroll
        for (int i = 0; i < 16; ++i) *(LAS bf16_t*)(lds + KW_OFF + ((16 * q4 + i) * LD + s) * 2) = f2bf(kv[i] * wk);
        const bf16_t* vs = z + (size_t)(b * SEQ + t) * ZLD + ZC_MV + hh * 64 + 16 * q4;
        const u32x4 w0 = *(const u32x4*)vs, w1 = *(const u32x4*)(vs + 8);
        const unsigned ww[8] = {w0.x, w0.y, w0.z, w0.w, w1.x, w1.y, w1.z, w1.w};
#pragma unroll
        for (int i = 0; i < 8; ++i) {
            *(LAS bf16_t*)(lds + VT_OFF + ((16 * q4 + 2 * i) * LD + s) * 2) = (bf16_t)(ww[i] & 0xffffu);
            *(LAS bf16_t*)(lds + VT_OFF + ((16 * q4 + 2 * i + 1) * LD + s) * 2) = (bf16_t)(ww[i] >> 16);
        }
    }
    __syncthreads();
    float* out = (float*)(P->ws + WS_MLC) + (size_t)item * MLC_STRIDE;
    {
        const int r16 = lane & 15, g4 = lane >> 4, mf = wave >> 1, nf0 = (wave & 1) * 2;
        f32x4 acc[2] = {(f32x4){0.f, 0.f, 0.f, 0.f}, (f32x4){0.f, 0.f, 0.f, 0.f}};
#pragma unroll
        for (int ks = 0; ks < 4; ++ks) {
            const bf16x8 af = lds_frag(lds, KW_OFF + ((16 * mf + r16) * LD + 32 * ks + 8 * g4) * 2);
#pragma unroll
            for (int nfi = 0; nfi < 2; ++nfi) acc[nfi] = mfma16(af, lds_frag(lds, VT_OFF + ((16 * (nf0 + nfi) + r16) * LD + 32 * ks + 8 * g4) * 2), acc[nfi]);
        }
#pragma unroll
        for (int nfi = 0; nfi < 2; ++nfi)
#pragma unroll
            for (int rg = 0; rg < 4; ++rg) out[(16 * mf + 4 * g4 + rg) * 64 + 16 * (nf0 + nfi) + r16] = acc[nfi][rg];
    }
    if (tid < 64) { float a = 0.f; for (int s = 0; s < 128; ++s) a += bf2f(*(const LAS bf16_t*)(lds + KW_OFF + (tid * LD + s) * 2)); out[4096 + tid] = a; }
    if (tid == 0) { out[4160] = G[512]; out[4161] = G[513]; }
}

__device__ __forceinline__ void mlstm_stage2(KP P, int l, int item, ldsp lds, int tid, int wave, int lane) {
    const int c = item & 15, hh = (item >> 4) & 3, b = item >> 6;
    const bf16_t* z = (const bf16_t*)(P->ws + WS_Z);
    constexpr int Q_OFF = 0, K_OFF = 18432, VT_OFF = 36864, CT_OFF = 58624, P_OFF = 70144, G_OFF = 104960, QLD = 72, VLD = 136;
    LAS float* G = (LAS float*)(lds + G_OFF);
    const float* mlc_base = (const float*)(P->ws + WS_MLC) + (size_t)(item - c) * MLC_STRIDE;
    if (wave == 0) {
        mlstm_gates_w0(P, l, b, hh, c, G, lane);
        const bool valid = lane < c;
        const float bLc = valid ? mlc_base[(size_t)lane * MLC_STRIDE + 4160] : 0.f;
        const float mlc = valid ? mlc_base[(size_t)lane * MLC_STRIDE + 4161] : NEGF;
        float suf = 0.f;
#pragma unroll
        for (int j = 1; j < 16; ++j) { const float v = SHIDX(bLc, j); if (j > lane) suf += v; }
        const float total = SHIDX(suf + bLc, 0);
        float e = valid ? mlc + suf : NEGF;
        float mx = e;
#pragma unroll
        for (int o = 1; o < 64; o <<= 1) mx = fmaxf(mx, SHX(mx, o));
        const float Mq = fmaxf(total, mx);
        if (lane < 16) G[520 + lane] = valid ? __expf(e - Mq) : 0.f;
        if (lane == 0) G[536] = Mq;
    }
    __syncthreads();
    const float Mp = G[536];
    float Cv[8]; float nv = 0.f;
#pragma unroll
    for (int i = 0; i < 8; ++i) Cv[i] = 0.f;
    {
#pragma unroll 4
        for (int cc = 0; cc < c; ++cc) {
            const float* src = mlc_base + (size_t)cc * MLC_STRIDE;
            const float w = G[520 + cc];
            const f32x4 a = *(const f32x4*)(src + tid * 8), bq = *(const f32x4*)(src + tid * 8 + 4);
#pragma unroll
            for (int e = 0; e < 4; ++e) { Cv[e] += w * a[e]; Cv[4 + e] += w * bq[e]; }
            if (tid < 64) nv += w * src[4096 + tid];
        }
    }
    {
        const int dk = tid >> 3, dv0 = (tid & 7) * 8;
#pragma unroll
        for (int i = 0; i < 8; ++i) *(LAS bf16_t*)(lds + CT_OFF + ((dv0 + i) * QLD + dk) * 2) = f2bf(Cv[i]);
        if (tid < 64) *(LAS bf16_t*)(lds + CT_OFF + (64 * QLD + tid) * 2) = f2bf(nv);
        for (int e = tid; e < 15 * 64; e += 512) *(LAS bf16_t*)(lds + CT_OFF + ((65 + e / 64) * QLD + (e & 63)) * 2) = 0;
        for (int e = tid; e < 15 * 128; e += 512) *(LAS bf16_t*)(lds + VT_OFF + ((65 + e / 128) * VLD + (e & 127)) * 2) = 0;
        if (tid < 128) *(LAS bf16_t*)(lds + VT_OFF + (64 * VLD + tid) * 2) = 0x3f80;
    }
    {
        const int s = tid >> 2, q4 = tid & 3, t = c * 128 + s;
        float qv[16], kv[16];
        conv_silu16(z, P->in[I_CONV] + (size_t)l * 2048, b, t, ZC_MQ + hh * 64 + 16 * q4, hh * 64 + 16 * q4, qv);
        conv_silu16(z, P->in[I_CONV] + (size_t)l * 2048, b, t, ZC_MK + hh * 64 + 16 * q4, 256 + hh * 64 + 16 * q4, kv);
#pragma unroll
        for (int i = 0; i < 16; ++i) kv[i] *= 0.125f;
        *(LAS bf16x8*)(lds + Q_OFF + (s * QLD + 16 * q4) * 2) = pack8(qv); *(LAS bf16x8*)(lds + Q_OFF + (s * QLD + 16 * q4 + 8) * 2) = pack8(qv + 8);
        *(LAS bf16x8*)(lds + K_OFF + (s * QLD + 16 * q4) * 2) = pack8(kv); *(LAS bf16x8*)(lds + K_OFF + (s * QLD + 16 * q4 + 8) * 2) = pack8(kv + 8);
        const bf16_t* vs = z + (size_t)(b * SEQ + t) * ZLD + ZC_MV + hh * 64 + 16 * q4;
        const u32x4 w0 = *(const u32x4*)vs, w1 = *(const u32x4*)(vs + 8);
        const unsigned ww[8] = {w0.x, w0.y, w0.z, w0.w, w1.x, w1.y, w1.z, w1.w};
#pragma unroll
        for (int i = 0; i < 8; ++i) {
            *(LAS bf16_t*)(lds + VT_OFF + ((16 * q4 + 2 * i) * VLD + s) * 2) = (bf16_t)(ww[i] & 0xffffu);
            *(LAS bf16_t*)(lds + VT_OFF + ((16 * q4 + 2 * i + 1) * VLD + s) * 2) = (bf16_t)(ww[i] >> 16);
        }
    }
    __syncthreads();
    if (tid < 128) G[384 + tid] = G[128 + tid] + fmaxf(Mp, G[256 + tid]);
    __syncthreads();
    {
        const int r16 = lane & 15, g4 = lane >> 4;
        const int PW = P_OFF + wave * 4352;
        bf16x8 qf[2];
#pragma unroll
        for (int ks = 0; ks < 2; ++ks) qf[ks] = lds_frag(lds, Q_OFF + ((16 * wave + r16) * QLD + 32 * ks + 8 * g4) * 2);
        f32x4 accO[5];
#pragma unroll
        for (int nf = 0; nf < 5; ++nf) { accO[nf] = (f32x4){0.f, 0.f, 0.f, 0.f};
#pragma unroll
            for (int ks = 0; ks < 2; ++ks) accO[nf] = mfma16(qf[ks], lds_frag(lds, CT_OFF + ((16 * nf + r16) * QLD + 32 * ks + 8 * g4) * 2), accO[nf]); }
        float bt[4], mt[4];
#pragma unroll
        for (int rg = 0; rg < 4; ++rg) { const int t = 16 * wave + 4 * g4 + rg; bt[rg] = G[128 + t]; mt[rg] = G[384 + t];
            const float wi = __expf(bt[rg] + Mp - mt[rg]);
#pragma unroll
            for (int nf = 0; nf < 5; ++nf) accO[nf][rg] *= wi; }
        const int nfmax = (wave | 1);
        for (int nf = 0; nf <= nfmax; ++nf) {
            f32x4 sacc = (f32x4){0.f, 0.f, 0.f, 0.f};
            if (nf <= wave) {
#pragma unroll
                for (int ks = 0; ks < 2; ++ks) sacc = mfma16(qf[ks], lds_frag(lds, K_OFF + ((16 * nf + r16) * QLD + 32 * ks + 8 * g4) * 2), sacc);
            }
            const int s = 16 * nf + r16;
            const float ds = G[s] - G[128 + s];
#pragma unroll
            for (int rg = 0; rg < 4; ++rg) {
                const int t = 16 * wave + 4 * g4 + rg;
                const float p = (s <= t) ? sacc[rg] * __expf(bt[rg] + ds - mt[rg]) : 0.f;
                *(LAS bf16_t*)(lds + PW + ((4 * g4 + rg) * VLD + s) * 2) = f2bf(p);
            }
        }
        for (int ks = 0; ks <= (wave >> 1); ++ks) {
            const bf16x8 pf = lds_frag(lds, PW + (r16 * VLD + 32 * ks + 8 * g4) * 2);
#pragma unroll
            for (int nf = 0; nf < 5; ++nf) accO[nf] = mfma16(pf, lds_frag(lds, VT_OFF + ((16 * nf + r16) * VLD + 32 * ks + 8 * g4) * 2), accO[nf]);
        }
        bf16_t* yo = (bf16_t*)(P->ws + WS_Y);
#pragma unroll
        for (int rg = 0; rg < 4; ++rg) {
            const int t = 16 * wave + 4 * g4 + rg;
            const size_t m = (size_t)b * SEQ + c * 128 + t;
            const float den = SHIDX(accO[4][rg], lane & 48);
            const float dn = fmaxf(fabsf(den), __expf(-mt[rg]));
            float o[4]; float ss = 0.f;
#pragma unroll
            for (int nf = 0; nf < 4; ++nf) {
                const float op = bf2f(z[m * ZLD + ZC_MO + hh * 64 + 16 * nf + r16]);
                o[nf] = sigmoidf_(op) * (accO[nf][rg] / dn);
                ss += o[nf] * o[nf];
            }
            ss += SHX(ss, 1); ss += SHX(ss, 2); ss += SHX(ss, 4); ss += SHX(ss, 8);
            const float rs = rsqrtf(ss * (1.0f / 64.0f) + EPS);
#pragma unroll
            for (int nf = 0; nf < 4; ++nf) yo[m * DM + 256 + hh * 64 + 16 * nf + r16] = f2bf(o[nf] * rs * P->in[I_GN_MLSTM][l * 256 + hh * 64 + 16 * nf + r16]);
        }
    }
}

__device__ __forceinline__ void compress_item(KP P, int l, int item, ldsp lds, int tid, int wave, int lane) {
    const int nt = item & 3, bg = (item >> 2) & 15, kv = item >> 6;
    const int b = bg >> 1, g = bg & 1, n0 = 32 * nt;
    const bf16_t* z = (const bf16_t*)(P->ws + WS_Z);
    constexpr int CK_OFF = 0, CLD = 72, H_OFF = 76032, HLD = 264;
    const float* rc = (const float*)(P->ws + WS_ROPE);
    for (int e = tid; e < 528 * 4; e += 512) {
        const int tk = e >> 2, q4 = e & 3, t = 16 * n0 + tk;
        float v[16];
        if (t < SEQ) {
            const size_t m = (size_t)b * SEQ + t;
            const bf16_t* src = z + m * ZLD + (kv ? ZC_CV : ZC_CK) + g * 64 + 16 * q4;
            const u32x4 w0 = *(const u32x4*)src, w1 = *(const u32x4*)(src + 8);
            unpack8(w0, v); unpack8(w1, v + 8);
            if (kv == 0 && q4 == 0) {
#pragma unroll
                for (int i = 0; i < 8; ++i) { const float cs = rc[m * 8 + i], sn = rc[(size_t)MTOK * 8 + m * 8 + i];
                    const float x1 = v[i], x2 = v[8 + i]; v[i] = bf2f(f2bf(x1 * cs - x2 * sn)); v[8 + i] = bf2f(f2bf(x2 * cs + x1 * sn)); }
            }
        } else {
#pragma unroll
            for (int i = 0; i < 16; ++i) v[i] = 0.f;
        }
        *(LAS bf16x8*)(lds + CK_OFF + (tk * CLD + 16 * q4) * 2) = pack8(v); *(LAS bf16x8*)(lds + CK_OFF + (tk * CLD + 16 * q4 + 8) * 2) = pack8(v + 8);
    }
    __syncthreads();
    const int r16 = lane & 15, g4 = lane >> 4;
    {
        const bf16_t* w1t = (const bf16_t*)(P->ws + (kv ? WS_CW1V : WS_CW1K));
        f32x4 acc[2][2];
#pragma unroll
        for (int a = 0; a < 2; ++a) { acc[a][0] = (f32x4){0.f, 0.f, 0.f, 0.f}; acc[a][1] = (f32x4){0.f, 0.f, 0.f, 0.f}; }
#pragma unroll 4
        for (int ks = 0; ks < 64; ++ks) {
            const int tt = ks >> 1, dd = 32 * (ks & 1) + 8 * g4;
            bf16x8 bf[2], af[2];
#pragma unroll
            for (int nfi = 0; nfi < 2; ++nfi) bf[nfi] = *(const bf16x8*)(w1t + (size_t)(32 * wave + 16 * nfi + r16) * 2048 + 32 * ks + 8 * g4);
#pragma unroll
            for (int mf = 0; mf < 2; ++mf) af[mf] = lds_frag(lds, CK_OFF + ((16 * (16 * mf + r16) + tt) * CLD + dd) * 2);
#pragma unroll
            for (int mf = 0; mf < 2; ++mf)
#pragma unroll
                for (int nfi = 0; nfi < 2; ++nfi) acc[mf][nfi] = mfma16(af[mf], bf[nfi], acc[mf][nfi]);
        }
        const float* cb1 = (const float*)(P->ws + WS_CB1) + kv * 256;
#pragma unroll
        for (int nfi = 0; nfi < 2; ++nfi) { const int hid = 32 * wave + 16 * nfi + r16; float bb = 0.f;
#pragma unroll
            for (int kc = 0; kc < 16; ++kc) bb += cb1[kc * 512 + hid];
#pragma unroll
            for (int mf = 0; mf < 2; ++mf)
#pragma unroll
                for (int rg = 0; rg < 4; ++rg) *(LAS bf16_t*)(lds + H_OFF + ((16 * mf + 4 * g4 + rg) * HLD + hid) * 2) = f2bf(gelu_tanh(acc[mf][nfi][rg] + bb)); }
    }
    __syncthreads();
    {
        const bf16_t* w2t = (const bf16_t*)(P->ws + (kv ? WS_CW2V : WS_CW2K));
        const int mf = wave >> 2, nf = wave & 3;
        f32x4 acc = (f32x4){0.f, 0.f, 0.f, 0.f};
#pragma unroll
        for (int ks = 0; ks < 8; ++ks)
            acc = mfma16(lds_frag(lds, H_OFF + ((16 * mf + r16) * HLD + 32 * ks + 8 * g4) * 2), *(const bf16x8*)(w2t + (size_t)(16 * nf + r16) * 256 + 32 * ks + 8 * g4), acc);
        bf16_t* dst = (bf16_t*)(P->ws + (kv ? WS_VCMP : WS_KCMP)) + (size_t)bg * 128 * 64;
#pragma unroll
        for (int rg = 0; rg < 4; ++rg) { const int n = n0 + 16 * mf + 4 * g4 + rg; dst[n * 64 + 16 * nf + r16] = (n < 127) ? f2bf(acc[rg]) : (bf16_t)0; }
    }
}

__device__ __forceinline__ void rope_item(KP P, int item, int tid) {
    bf16_t* z = (bf16_t*)(P->ws + WS_Z);
    const float* rc = (const float*)(P->ws + WS_ROPE);
    for (int e = item * 4096 + tid; e < item * 4096 + 4096; e += 512) {
        const int m = e / 12, hsel = e % 12;
        const int col = hsel < 8 ? ZC_AQ + hsel * 64 : (hsel < 10 ? ZC_SK + (hsel - 8) * 64 : ZC_WK + (hsel - 10) * 64);
        bf16_t* src = z + (size_t)m * ZLD + col;
        const u32x4 w0 = *(const u32x4*)src, w1 = *(const u32x4*)(src + 8);
        float v[16]; unpack8(w0, v); unpack8(w1, v + 8);
        const f32x4 c0 = *(const f32x4*)(rc + (size_t)m * 8), c1 = *(const f32x4*)(rc + (size_t)m * 8 + 4);
        const f32x4 s0 = *(const f32x4*)(rc + (size_t)MTOK * 8 + (size_t)m * 8), s1 = *(const f32x4*)(rc + (size_t)MTOK * 8 + (size_t)m * 8 + 4);
        const float cs[8] = {c0[0], c0[1], c0[2], c0[3], c1[0], c1[1], c1[2], c1[3]}, sn[8] = {s0[0], s0[1], s0[2], s0[3], s1[0], s1[1], s1[2], s1[3]};
        float o[16];
#pragma unroll
        for (int i = 0; i < 8; ++i) { o[i] = v[i] * cs[i] - v[8 + i] * sn[i]; o[8 + i] = v[8 + i] * cs[i] + v[i] * sn[i]; }
        *(bf16x8*)src = pack8(o); *(bf16x8*)(src + 8) = pack8(o + 8);
    }
}

struct NsaCtx { int tq; unsigned selm; };
__device__ __forceinline__ float xmax16_32(float v) {
    auto a = __builtin_amdgcn_permlane16_swap(__float_as_uint(v), __float_as_uint(v), false, false);
    v = fmaxf(__uint_as_float(a[0]), __uint_as_float(a[1]));
    auto b = __builtin_amdgcn_permlane32_swap(__float_as_uint(v), __float_as_uint(v), false, false);
    return fmaxf(__uint_as_float(b[0]), __uint_as_float(b[1]));
}
__device__ __forceinline__ float xsum16_32(float v) {
    auto a = __builtin_amdgcn_permlane16_swap(__float_as_uint(v), __float_as_uint(v), false, false);
    v = __uint_as_float(a[0]) + __uint_as_float(a[1]);
    auto b = __builtin_amdgcn_permlane32_swap(__float_as_uint(v), __float_as_uint(v), false, false);
    return __uint_as_float(b[0]) + __uint_as_float(b[1]);
}
__device__ __forceinline__ void nsa_tile(ldsp lds, int ks_off, int vt_off, int vld, int mmode, const bf16x8 (&Qf)[2][2], f32x4 (&OB)[4][2], float (&mrun)[2], float (&lrun)[2], int tql, bool selbit, int r16, int g4) {
    constexpr int KLD = 72;
    bf16x8 va[2][4];
#pragma unroll
    for (int k2 = 0; k2 < 2; ++k2)
#pragma unroll
        for (int df = 0; df < 4; ++df) {
            const bf16x4 lo = *(const LAS bf16x4*)(lds + vt_off + ((16 * df + r16) * vld + 32 * k2 + 4 * g4) * 2);
            const bf16x4 hi = *(const LAS bf16x4*)(lds + vt_off + ((16 * df + r16) * vld + 32 * k2 + 16 + 4 * g4) * 2);
            va[k2][df] = __builtin_shufflevector(lo, hi, 0, 1, 2, 3, 4, 5, 6, 7);
        }
    bf16x8 kf[4][2];
#pragma unroll
    for (int kfi = 0; kfi < 4; ++kfi)
#pragma unroll
        for (int ks = 0; ks < 2; ++ks) kf[kfi][ks] = lds_frag(lds, ks_off + ((16 * kfi + r16) * KLD + 32 * ks + 8 * g4) * 2);
#pragma unroll
    for (int f = 0; f < 2; ++f) {
        __builtin_amdgcn_sched_barrier(0);
        f32x4 S[4];
#pragma unroll
        for (int kfi = 0; kfi < 4; ++kfi) { S[kfi] = (f32x4){0.f, 0.f, 0.f, 0.f};
#pragma unroll
            for (int ks = 0; ks < 2; ++ks) S[kfi] = mfma16(kf[kfi][ks], Qf[f][ks], S[kfi]); }
        if (mmode == 1) {
#pragma unroll
            for (int kfi = 0; kfi < 4; ++kfi)
#pragma unroll
                for (int rg = 0; rg < 4; ++rg) S[kfi][rg] = (16 * kfi + 4 * g4 + rg <= tql) ? S[kfi][rg] : NEGF;
        } else if (mmode == 2) {
#pragma unroll
            for (int kfi = 0; kfi < 4; ++kfi)
#pragma unroll
                for (int rg = 0; rg < 4; ++rg) S[kfi][rg] = (16 * kfi + 4 * g4 + rg > tql) ? S[kfi][rg] : NEGF;
        }
        float mx = fmaxf(fmaxf(S[0][0], S[0][1]), fmaxf(S[0][2], S[0][3]));
#pragma unroll
        for (int kfi = 1; kfi < 4; ++kfi) mx = fmaxf(mx, fmaxf(fmaxf(S[kfi][0], S[kfi][1]), fmaxf(S[kfi][2], S[kfi][3])));
        mx = selbit ? mx : NEGF;
        mx = xmax16_32(mx);
        const float mn = fmaxf(mrun[f], mx);
        const float alpha = __builtin_amdgcn_exp2f(mrun[f] - mn);
        const float msub = selbit ? fmaxf(mn, -1e28f) : 1e30f;
        float ls = 0.f;
#pragma unroll
        for (int kfi = 0; kfi < 4; ++kfi)
#pragma unroll
            for (int rg = 0; rg < 4; ++rg) { const float p = __builtin_amdgcn_exp2f(S[kfi][rg] - msub); S[kfi][rg] = p; ls += p; }
        lrun[f] = lrun[f] * alpha + ls; mrun[f] = mn;
        if (__builtin_amdgcn_ballot_w64(alpha != 1.0f) != 0ull) {
#pragma unroll
            for (int df = 0; df < 4; ++df) OB[df][f] *= alpha;
        }
#pragma unroll
        for (int k2 = 0; k2 < 2; ++k2) {
            const float pv[8] = {S[2 * k2][0], S[2 * k2][1], S[2 * k2][2], S[2 * k2][3], S[2 * k2 + 1][0], S[2 * k2 + 1][1], S[2 * k2 + 1][2], S[2 * k2 + 1][3]};
            const bf16x8 pb = pack8(pv);
#pragma unroll
            for (int df = 0; df < 4; ++df) OB[df][f] = mfma16(va[k2][df], pb, OB[df][f]);
        }
    }
}

__device__ __forceinline__ void nsa_load_tile(ldsp lds, const bf16_t* kbase, const bf16_t* vbase, size_t ld, int keyoff, int tid) {
    constexpr int KS_OFF = 0, VT_OFF = 18432, KLD = 72, VLD = 136;
    const int key = tid >> 3, dc = tid & 7;
    const u32x4 kw = *(const u32x4*)(kbase + (size_t)key * ld + 8 * dc);
    const u32x4 vw = *(const u32x4*)(vbase + (size_t)key * ld + 8 * dc);
    *(LAS u32x4*)(lds + KS_OFF + ((keyoff + key) * KLD + 8 * dc) * 2) = kw;
    const unsigned ww[4] = {vw.x, vw.y, vw.z, vw.w};
#pragma unroll
    for (int i = 0; i < 4; ++i) {
        *(LAS bf16_t*)(lds + VT_OFF + ((8 * dc + 2 * i) * VLD + keyoff + key) * 2) = (bf16_t)(ww[i] & 0xffffu);
        *(LAS bf16_t*)(lds + VT_OFF + ((8 * dc + 2 * i + 1) * VLD + keyoff + key) * 2) = (bf16_t)(ww[i] >> 16);
    }
}

__device__ __forceinline__ void nsa_item(KP P, int l, int item, ldsp lds, int tid, int wave, int lane) {
    const int qt = 31 - (item >> 4), bg = item & 15, b = bg >> 1, g = bg & 1;
    const int T0 = 64 * qt;
    const bf16_t* z = (const bf16_t*)(P->ws + WS_Z);
    const float* gate = (const float*)(P->ws + WS_GATE);
    constexpr int KS_OFF = 0, VT_OFF = 18432, KLD = 72, VLD = 136, IMP_OFF = 35840, SEL_OFF = 52224, OR_OFF = 52480;
    constexpr float SC2 = 0.125f * 1.4426950408889634f;
    const int r16 = lane & 15, g4 = lane >> 4;
    const int tq = T0 + 8 * wave + (r16 & 7);
    const size_t mq = (size_t)b * SEQ + tq;
    int hd[2]; hd[0] = 4 * g + (r16 >> 3); hd[1] = 4 * g + 2 + (r16 >> 3);
    bf16x8 Qf[2][2];
#pragma unroll
    for (int f = 0; f < 2; ++f)
#pragma unroll
        for (int ks = 0; ks < 2; ++ks) { const u32x4 qw = *(const u32x4*)(z + mq * ZLD + ZC_AQ + hd[f] * 64 + 32 * ks + 8 * g4);
            float qv[8]; unpack8(qw, qv);
#pragma unroll
            for (int e = 0; e < 8; ++e) qv[e] *= SC2;
            Qf[f][ks] = pack8(qv); }
    float gt[2][3];
#pragma unroll
    for (int f = 0; f < 2; ++f)
#pragma unroll
        for (int br = 0; br < 3; ++br) gt[f][br] = sigmoidf_(gate[mq * 32 + 8 + hd[f] * 3 + br]);
    f32x4 OF[4][2], OB[4][2];
    if (tid == 0) *(LAS unsigned*)(lds + OR_OFF) = 0u;
    {
        const bf16_t* kc = (const bf16_t*)(P->ws + WS_KCMP) + (size_t)bg * 128 * 64;
        const bf16_t* vc = (const bf16_t*)(P->ws + WS_VCMP) + (size_t)bg * 128 * 64;
        nsa_load_tile(lds, kc, vc, 64, 0, tid);
        nsa_load_tile(lds, kc + 64 * 64, vc + 64 * 64, 64, 64, tid);
        __syncthreads();
        f32x4 ps[8];
#pragma unroll
        for (int kf = 0; kf < 8; ++kf) ps[kf] = (f32x4){0.f, 0.f, 0.f, 0.f};
#pragma unroll
        for (int f = 0; f < 2; ++f) {
            __builtin_amdgcn_sched_barrier(0);
            f32x4 S[8];
#pragma unroll
            for (int kf = 0; kf < 8; ++kf) { S[kf] = (f32x4){0.f, 0.f, 0.f, 0.f};
#pragma unroll
                for (int ks = 0; ks < 2; ++ks) S[kf] = mfma16(lds_frag(lds, KS_OFF + ((16 * kf + r16) * KLD + 32 * ks + 8 * g4) * 2), Qf[f][ks], S[kf]); }
            float mx = NEGF;
#pragma unroll
            for (int kf = 0; kf < 8; ++kf)
#pragma unroll
                for (int rg = 0; rg < 4; ++rg) { const int n = 16 * kf + 4 * g4 + rg; const bool v = (16 * n + 31 <= tq); const float s = v ? S[kf][rg] : NEGF; S[kf][rg] = s; mx = fmaxf(mx, s); }
            mx = fmaxf(mx, SHX(mx, 16)); mx = fmaxf(mx, SHX(mx, 32));
            float ls = 0.f;
#pragma unroll
            for (int kf = 0; kf < 8; ++kf)
#pragma unroll
                for (int rg = 0; rg < 4; ++rg) { const int n = 16 * kf + 4 * g4 + rg; const bool v = (16 * n + 31 <= tq); const float p = v ? __builtin_amdgcn_exp2f(S[kf][rg] - mx) : 0.f; S[kf][rg] = p; ls += p; }
            ls += SHX(ls, 16); ls += SHX(ls, 32);
            const float inv = ls > 0.f ? 1.0f / ls : 0.f;
#pragma unroll
            for (int kf = 0; kf < 8; ++kf) { S[kf] *= inv; ps[kf] += S[kf]; }
#pragma unroll
            for (int df = 0; df < 4; ++df) OB[df][f] = (f32x4){0.f, 0.f, 0.f, 0.f};
#pragma unroll
            for (int k2 = 0; k2 < 4; ++k2) {
                const float pv[8] = {S[2 * k2][0], S[2 * k2][1], S[2 * k2][2], S[2 * k2][3], S[2 * k2 + 1][0], S[2 * k2 + 1][1], S[2 * k2 + 1][2], S[2 * k2 + 1][3]};
                const bf16x8 pb = pack8(pv);
#pragma unroll
                for (int df = 0; df < 4; ++df) {
                    const bf16x4 lo = *(const LAS bf16x4*)(lds + VT_OFF + ((16 * df + r16) * VLD + 32 * k2 + 4 * g4) * 2);
                    const bf16x4 hi = *(const LAS bf16x4*)(lds + VT_OFF + ((16 * df + r16) * VLD + 32 * k2 + 16 + 4 * g4) * 2);
                    OB[df][f] = mfma16(__builtin_shufflevector(lo, hi, 0, 1, 2, 3, 4, 5, 6, 7), pb, OB[df][f]);
                }
            }
#pragma unroll
            for (int df = 0; df < 4; ++df) OF[df][f] = OB[df][f] * gt[f][0];
        }
        LAS float* impA = (LAS float*)(lds + IMP_OFF + wave * 2048);
        LAS float* impB = impA + 256;
#pragma unroll
        for (int kf = 0; kf < 8; ++kf) {
            f32x4 v = ps[kf];
#pragma unroll
            for (int e = 0; e < 4; ++e) v[e] += SHX(v[e], 8);
            if (r16 < 8) {
                const int j = 4 * kf + g4;
                impA[r16 * 32 + j] = 2.0f * (v[0] + v[1] + v[2]) + v[3];
                if (j < 31) impB[r16 * 32 + j + 1] = v[3];
                if (j == 0) impB[r16 * 32] = 0.f;
            }
        }
        {
            const int tk = lane & 7, jg = lane >> 3;
            const int tt = T0 + 8 * wave + tk, jcur = tt >> 6;
            float myv[4];
#pragma unroll
            for (int i = 0; i < 4; ++i) { const int j = 4 * jg + i; float v = impA[tk * 32 + j] + impB[tk * 32 + j];
                if (j == 0 || j == jcur) v = 1e4f; else if (j > jcur) v = -1e4f; myv[i] = v; }
            asm volatile("s_waitcnt lgkmcnt(0)" ::: "memory");
#pragma unroll
            for (int i = 0; i < 4; ++i) impA[tk * 32 + 4 * jg + i] = myv[i];
            asm volatile("s_waitcnt lgkmcnt(0)" ::: "memory");
            int cnt[4] = {0, 0, 0, 0};
            for (int j2 = 0; j2 < 32; ++j2) { const float v2 = impA[tk * 32 + j2];
#pragma unroll
                for (int i = 0; i < 4; ++i) { const int j = 4 * jg + i; cnt[i] += (v2 > myv[i] || (v2 == myv[i] && j2 < j)) ? 1 : 0; } }
            unsigned bits = 0u;
#pragma unroll
            for (int i = 0; i < 4; ++i) { const int j = 4 * jg + i; if (cnt[i] < 8 && j <= jcur) bits |= (1u << j); }
            bits |= SHX(bits, 8); bits |= SHX(bits, 16); bits |= SHX(bits, 32);
            if (lane < 8) { *(LAS unsigned*)(lds + SEL_OFF + (wave * 8 + lane) * 4) = bits; __hip_atomic_fetch_or((LAS unsigned*)(lds + OR_OFF), bits, __ATOMIC_RELAXED, __HIP_MEMORY_SCOPE_WORKGROUP); }
        }
    }
    __syncthreads();
    const unsigned selm = *(const LAS unsigned*)(lds + SEL_OFF + (wave * 8 + (r16 & 7)) * 4);
    {
        constexpr int TL_OFF = 52736, TILE_OFF = 53248, TKLD = 72;
        const unsigned selor = *(const LAS unsigned*)(lds + OR_OFF) & (qt >= 31 ? 0xffffffffu : ((2u << qt) - 1u));
        const int nsel = __builtin_popcount(selor), wj0 = (qt >= 4 ? qt - 4 : 0), nwin = qt - wj0 + 1, ntl = nsel + nwin;
        if (tid < 32) { if ((selor >> tid) & 1u) *(LAS unsigned*)(lds + TL_OFF + __builtin_popcount(selor & ((1u << tid) - 1u)) * 4) = 0x100u | (unsigned)tid; }
        else if (tid < 32 + nwin) *(LAS unsigned*)(lds + TL_OFF + (nsel + tid - 32) * 4) = 0x200u | (unsigned)(wj0 + tid - 32);
        __syncthreads();
        const int key = tid >> 3, dc = tid & 7;
        const bf16_t* zrow = z + ((size_t)b * SEQ + key) * ZLD + g * 64 + 8 * dc;
        u32x4 kw, vw;
#define NSA_TILE_LOAD(ti) do { const unsigned d_ = *(const LAS unsigned*)(lds + TL_OFF + (ti) * 4); const bf16_t* p_ = zrow + (size_t)(64 * (int)(d_ & 0xffu)) * ZLD + ((d_ >> 8) == 1u ? ZC_SK : ZC_WK); \
        kw = *(const u32x4*)p_; vw = *(const u32x4*)(p_ + 128); } while (0)
#define NSA_TILE_WRITE(bufi) do { const int ko_ = TILE_OFF + (bufi) * 18432; *(LAS u32x4*)(lds + ko_ + (key * TKLD + 8 * dc) * 2) = kw; const unsigned ww_[4] = {vw.x, vw.y, vw.z, vw.w}; \
        _Pragma("unroll") for (int i_ = 0; i_ < 4; ++i_) { *(LAS bf16_t*)(lds + ko_ + 9216 + ((8 * dc + 2 * i_) * TKLD + key) * 2) = (bf16_t)(ww_[i_] & 0xffffu); \
            *(LAS bf16_t*)(lds + ko_ + 9216 + ((8 * dc + 2 * i_ + 1) * TKLD + key) * 2) = (bf16_t)(ww_[i_] >> 16); } } while (0)
        NSA_TILE_LOAD(0);
        NSA_TILE_WRITE(0);
        if (ntl > 1) NSA_TILE_LOAD(1);
        __syncthreads();
        float mrun[2] = {NEGF, NEGF}, lrun[2] = {0.f, 0.f};
#pragma unroll
        for (int f = 0; f < 2; ++f)
#pragma unroll
            for (int df = 0; df < 4; ++df) OB[df][f] = (f32x4){0.f, 0.f, 0.f, 0.f};
        unsigned pmode = 1u;
        for (int i = 0; i < ntl; ++i) {
            if (i + 1 < ntl) NSA_TILE_WRITE((i + 1) & 1);
            if (i + 2 < ntl) NSA_TILE_LOAD(i + 2);
            const unsigned d = *(const LAS unsigned*)(lds + TL_OFF + i * 4);
            const unsigned mode = d >> 8; const int j = (int)(d & 0xffu);
            if (mode != pmode) {
#pragma unroll
                for (int f = 0; f < 2; ++f) { const float sc = gt[f][1] / xsum16_32(lrun[f]);
#pragma unroll
                    for (int df = 0; df < 4; ++df) { OF[df][f] += OB[df][f] * sc; OB[df][f] = (f32x4){0.f, 0.f, 0.f, 0.f}; }
                    mrun[f] = NEGF; lrun[f] = 0.f; }
                pmode = mode;
            }
            const int ko = TILE_OFF + (i & 1) * 18432;
            const int mmode = (j == qt) ? 1 : ((mode == 2u && j == qt - 4) ? 2 : 0);
            nsa_tile(lds, ko, ko + 9216, TKLD, mmode, Qf, OB, mrun, lrun, tq - T0, mode == 1u ? (((selm >> j) & 1u) != 0u) : true, r16, g4);
            __syncthreads();
        }
#pragma unroll
        for (int f = 0; f < 2; ++f) { const float sc = gt[f][2] / xsum16_32(lrun[f]);
#pragma unroll
            for (int df = 0; df < 4; ++df) OF[df][f] += OB[df][f] * sc; }
#undef NSA_TILE_LOAD
#undef NSA_TILE_WRITE
    }
    {
        bf16_t* yo = (bf16_t*)(P->ws + WS_Y);
#pragma unroll
        for (int f = 0; f < 2; ++f) {
            float ss = 0.f;
#pragma unroll
            for (int df = 0; df < 4; ++df)
#pragma unroll
                for (int rg = 0; rg < 4; ++rg) ss += OF[df][f][rg] * OF[df][f][rg];
            ss += SHX(ss, 16); ss += SHX(ss, 32);
            const float rs = rsqrtf(ss * (1.0f / 64.0f) + EPS);
#pragma unroll
            for (int df = 0; df < 4; ++df) {
                const f32x4 gn = *(const f32x4*)(P->in[I_GN_NSA] + l * 512 + hd[f] * 64 + 16 * df + 4 * g4);
                const f32x4 o = OF[df][f] * rs * gn;
                u32x2 w; w.x = cvt_pk_bf16(o[0], o[1]); w.y = cvt_pk_bf16(o[2], o[3]);
                *(u32x2*)(yo + mq * DM + 512 + hd[f] * 64 + 16 * df + 4 * g4) = w;
            }
        }
    }
}

#define XB_TMO      128
#define XB_XCNT(j)  (256  + 64 * (j))
#define XB_XSUB(j)  (1280 + 64 * (j))
#define XB_XGEN(j)  (2304 + 64 * (j))
#define XB_TOP      3328
#define XB_TOPGEN   3392
#define XCD_BAR_WORDS 3456
#define XB_SPIN_CAP (1u << 22)
__device__ __forceinline__ unsigned xb_ld(unsigned* p)              { return __hip_atomic_load(p, __ATOMIC_RELAXED, __HIP_MEMORY_SCOPE_AGENT); }
__device__ __forceinline__ unsigned xb_add(unsigned* p, unsigned v) { return __hip_atomic_fetch_add(p, v, __ATOMIC_RELAXED, __HIP_MEMORY_SCOPE_AGENT); }
__device__ __forceinline__ unsigned xb_xcc_id() { return (unsigned)__builtin_amdgcn_s_getreg((3 << 11) | 20) & 0xFu; }
#define XB_SPIN(cond, bar) do { unsigned _sp = 0; while (cond) { __builtin_amdgcn_s_sleep(1); \
    if ((++_sp & 255u) == 0u) { if (xb_ld(&(bar)[XB_TMO])) break; if (_sp > XB_SPIN_CAP) { atomicAdd(&(bar)[XB_TMO], 1u); break; } } } } while (0)
struct XcdBarrier { unsigned* bar; unsigned x; volatile LAS unsigned* st; };
__device__ __forceinline__ XcdBarrier xcd_barrier_post(unsigned* bar, volatile LAS unsigned* st) {
    XcdBarrier b; b.bar = bar; b.x = xb_xcc_id(); b.st = st;
    if (threadIdx.x == 0) (void)xb_add(&bar[XB_XCNT(b.x)], 1u);
    return b;
}
__device__ __forceinline__ void xcd_barrier_complete(unsigned* bar, unsigned x, unsigned& nloc, unsigned& nx) {
    const unsigned G = gridDim.x * gridDim.y * gridDim.z;
    unsigned sum, cnt, mine, sp = 0u;
    for (;;) {
        sum = 0u; cnt = 0u; mine = 0u;
#pragma unroll
        for (unsigned j = 0; j < 16; ++j) { const unsigned c = xb_ld(&bar[XB_XCNT(j)]); sum += c; cnt += (c > 0u) ? 1u : 0u; mine = (j == x) ? c : mine; }
        if (sum == G) break;
        __builtin_amdgcn_s_sleep(1);
        if ((++sp & 255u) == 0u) { if (xb_ld(&bar[XB_TMO])) break; if (sp > XB_SPIN_CAP) { atomicAdd(&bar[XB_TMO], 1u); break; } }
    }
    nloc = mine > 0u ? mine : 1u; nx = cnt > 0u ? cnt : 1u;
}
__device__ __forceinline__ void xcd_barrier(const XcdBarrier& b) {
    asm volatile("s_waitcnt vmcnt(0)" ::: "memory");
    __syncthreads();
    if (threadIdx.x == 0) {
        unsigned* bar = b.bar;
        __builtin_amdgcn_s_waitcnt(0);
        unsigned nloc = b.st[0], nx = b.st[1];
        if (nloc == 0u) { xcd_barrier_complete(bar, b.x, nloc, nx); b.st[0] = nloc; b.st[1] = nx; }
        const unsigned old = xb_add(&bar[XB_XSUB(b.x)], 1u);
        const unsigned gen = old / nloc;
        if (old + 1u == (gen + 1u) * nloc) {
            __builtin_amdgcn_fence(__ATOMIC_RELEASE, "agent");
            asm volatile("s_waitcnt vmcnt(0)" ::: "memory");
            const unsigned og = xb_add(&bar[XB_TOP], 1u);
            const unsigned tg = og / nx;
            if (og + 1u == (tg + 1u) * nx) xb_add(&bar[XB_TOPGEN], 1u);
            else XB_SPIN(xb_ld(&bar[XB_TOPGEN]) == tg, bar);
            __builtin_amdgcn_fence(__ATOMIC_ACQUIRE, "agent");
            xb_add(&bar[XB_XGEN(b.x)], 1u);
            asm volatile("s_waitcnt vmcnt(0)" ::: "memory");
        } else {
            XB_SPIN(xb_ld(&bar[XB_XGEN(b.x)]) == gen, bar);
            __builtin_amdgcn_fence(__ATOMIC_ACQUIRE, "agent");
            asm volatile("s_waitcnt vmcnt(0)" ::: "memory");
        }
    }
    __syncthreads();
}

#ifndef EN_MASK
#define EN_MASK 0xFFFF
#endif
#define EN(b) (((EN_MASK) >> (b)) & 1)
#ifndef DUP
#define DUP 0
#endif
#define NREP(k) ((DUP) == (k) ? 2 : 1)
__global__ void __launch_bounds__(512, 2) hybrid_fwd(Params P_unused) {
    KP P = (KP)__builtin_amdgcn_kernarg_segment_ptr();
    extern __shared__ __attribute__((aligned(16))) unsigned char lds_raw[];
    ldsp lds = (ldsp)lds_raw;
    cg::grid_group grid = cg::this_grid();
    const int tid0 = threadIdx.x;
    volatile LAS unsigned* misc = (volatile LAS unsigned*)(lds + MISC_OFF);
    if (tid0 < 16) misc[tid0] = 0u;
    __syncthreads();
    (void)xcd_barrier_post((unsigned*)(P->ws + WS_CTL) + 4096, misc + 8);
#define GRID_SYNC() do { asm volatile("" : "+s"(P)); XcdBarrier xb_; xb_.bar = (unsigned*)(P->ws + WS_CTL) + 4096; xb_.x = xb_xcc_id(); xb_.st = (volatile LAS unsigned*)(lds + MISC_OFF) + 8; xcd_barrier(xb_); } while (0)
#define PHASE_BEGIN() asm volatile("" : "+s"(P)); int tid = tid0; asm volatile("" : "+v"(tid)); const int lane = tid & 63, wave = __builtin_amdgcn_readfirstlane(tid >> 6); \
    const int G = gridDim.x, gw = blockIdx.x * 8 + wave, NGW = G * 8; unsigned char* ws = P->ws; (void)lane; (void)gw; (void)NGW; (void)ws; (void)G

    {
        PHASE_BEGIN();
        if (EN(0)) norm_pass(P->in[I_X], nullptr, nullptr, P->in[I_LN_MIX_PRE], P->out, (bf16_t*)(ws + WS_U), gw, NGW, lane);
        if (EN(1)) {
            const int* pos = (const int*)P->in[I_POS];
            float* rc = (float*)(ws + WS_ROPE);
            for (int e = blockIdx.x * 512 + tid; e < MTOK * 8; e += G * 512) {
                const int m = e >> 3, j = e & 7;
                const float inv = powf(500000.0f, -(float)j * 0.125f);
                const float ang = (float)pos[m] * inv;
                rc[e] = cosf(ang); rc[(size_t)MTOK * 8 + e] = sinf(ang);
            }
        }
        if (EN(2)) convert_layer(P, 0, lds, gw, NGW, wave, lane);
    }
    grid.sync();

    for (int l = 0; l < DEPTH; ++l) {
        for (int rep = 0; rep < NREP(1); ++rep) {
            PHASE_BEGIN();
            pg8::Gemm g{(const bf16_t*)(ws + WS_U), (const bf16_t*)(ws + WS_WIN), MTOK, ZLD, DM}; pg8::StaticOrder S; S.init(MTOK, ZLD, G, (int)blockIdx.x);
            pg8::EpiBf16<0> E{(bf16_t*)(ws + WS_Z), ZLD, (float*)(ws + WS_GATE), 10};
            pg8::gemm_phase<pg8::EpiBf16<0>, pg8::StaticOrder, true, true>(lds, g, S, E, tid);
            GRID_SYNC();
        }
        for (int rep = 0; rep < ((DUP) / 10 == 2 || (DUP) == 2 ? 2 : 1); ++rep) {
            constexpr int N_CMP = 128, N_ML = 512, N_S5 = 512, N_ROPE = 48, NTOT = N_CMP + N_ML + N_S5 + N_ROPE;
            for (;;) {
                __syncthreads();
                if (tid0 == 0) misc[0] = atomicAdd((unsigned*)(P->ws + WS_CTL) + 64 * (2 * l) + 1024 * rep, 1u);
                __syncthreads();
                int item = (int)misc[0];
                PHASE_BEGIN();
                if (item >= NTOT) break;
                if (item < N_CMP) { if (EN(4) && (rep == 0 || DUP == 2 || DUP == 21)) compress_item(P, l, item, lds, tid, wave, lane); continue; } item -= N_CMP;
                if (item < N_ML) { if (EN(5) && (rep == 0 || DUP == 2 || DUP == 22)) mlstm_stage1(P, l, item, lds, tid, wave, lane); continue; } item -= N_ML;
                if (item < N_S5) { if (EN(6) && (rep == 0 || DUP == 2 || DUP == 23)) s5_stage1(P, l, item, lds, wave, lane); continue; } item -= N_S5;
                if (EN(7) && rep == 0) rope_item(P, item, tid);
            }
            GRID_SYNC();
        }
        for (int rep = 0; rep < ((DUP) / 10 == 3 || (DUP) == 3 ? 2 : 1); ++rep) {
            constexpr int N_NSA = 512, N_ML = 512, N_S5 = 256, NTOT = N_NSA + N_ML + N_S5;
            for (;;) {
                __syncthreads();
                if (tid0 == 0) misc[0] = atomicAdd((unsigned*)(P->ws + WS_CTL) + 64 * (2 * l + 1) + 1024 * rep, 1u);
                __syncthreads();
                int item = (int)misc[0];
                PHASE_BEGIN();
                if (item >= NTOT) break;
                if (item < N_NSA) { if (EN(8) && (rep == 0 || DUP == 3 || DUP == 31)) nsa_item(P, l, item, lds, tid, wave, lane); continue; } item -= N_NSA;
                if (item < N_ML) { if (EN(9) && (rep == 0 || DUP == 3 || DUP == 32)) mlstm_stage2(P, l, item, lds, tid, wave, lane); continue; } item -= N_ML;
                if (EN(10) && (rep == 0 || DUP == 3 || DUP == 33)) s5_stage2(P, l, item, lds, wave, lane);
            }
            GRID_SYNC();
        }
        for (int rep = 0; rep < NREP(4); ++rep) {
            PHASE_BEGIN();
            pg8::Gemm g{(const bf16_t*)(ws + WS_Y), (const bf16_t*)(ws + WS_WOUT), MTOK, DM, DM}; pg8::StaticOrder S; S.init(MTOK, DM, G, (int)blockIdx.x);
            pg8::EpiBf16<0> E{(bf16_t*)(ws + WS_Z), DM, nullptr, -1};
            pg8::gemm_phase<pg8::EpiBf16<0>, pg8::StaticOrder, true, true>(lds, g, S, E, tid);
            GRID_SYNC();
        }
        if (EN(12)) {
            PHASE_BEGIN();
            norm_pass(nullptr, (const bf16_t*)(ws + WS_Z), P->in[I_LN_MIX_POST] + l * DM, P->in[I_LN_MLP_PRE] + l * DM, P->out, (bf16_t*)(ws + WS_U), gw, NGW, lane);
        }
        GRID_SYNC();
        for (int rep = 0; rep < NREP(6); ++rep) {
            PHASE_BEGIN();
            pg8::Gemm g{(const bf16_t*)(ws + WS_U), (const bf16_t*)(ws + WS_W1), MTOK, DFF, DM}; pg8::StaticOrder S; S.init(MTOK, DFF, G, (int)blockIdx.x);
            pg8::EpiBf16<2> E{(bf16_t*)(ws + WS_Z), DFF, nullptr, -1};
            pg8::gemm_phase<pg8::EpiBf16<2>, pg8::StaticOrder, true, true>(lds, g, S, E, tid);
            GRID_SYNC();
        }
        for (int rep = 0; rep < NREP(7); ++rep) {
            PHASE_BEGIN();
            pg8::Gemm g{(const bf16_t*)(ws + WS_Z), (const bf16_t*)(ws + WS_W2), MTOK, DM, DFF}; pg8::StaticOrder S; S.init(MTOK, DM, G, (int)blockIdx.x);
            pg8::EpiBf16<0> E{(bf16_t*)(ws + WS_Y), DM, nullptr, -1};
            pg8::gemm_phase<pg8::EpiBf16<0>, pg8::StaticOrder, true, true>(lds, g, S, E, tid);
            GRID_SYNC();
        }
        {
            PHASE_BEGIN();
            if (EN(15)) norm_pass(nullptr, (const bf16_t*)(ws + WS_Y), P->in[I_LN_MLP_POST] + l * DM, (l + 1 < DEPTH) ? P->in[I_LN_MIX_PRE] + (l + 1) * DM : nullptr, P->out, (bf16_t*)(ws + WS_U), gw, NGW, lane);
            if (l + 1 < DEPTH) { for (int rep = 0; rep < NREP(8); ++rep) convert_layer(P, l + 1, lds, gw, NGW, wave, lane); }
        }
        if (l + 1 < DEPTH) GRID_SYNC();
    }
}

extern "C" void kernel_launch(void* const* d_in, const int* in_sizes, int n_in, void* d_out, int out_size, void* d_ws, size_t ws_size, hipStream_t stream) {
    static int grid = 0;
    if (grid == 0) {
        if (n_in != 31 || out_size != MTOK * DM || ws_size < WS_END) { fprintf(stderr, "kernel_launch: unexpected shapes (n_in %d out %d ws %zu)\n", n_in, out_size, ws_size); grid = -1; return; }
        int dev = 0, cus = 0, per_cu = 0;
        (void)hipGetDevice(&dev);
        (void)hipDeviceGetAttribute(&cus, hipDeviceAttributeMultiprocessorCount, dev);
        (void)hipFuncSetAttribute((const void*)hybrid_fwd, hipFuncAttributeMaxDynamicSharedMemorySize, LDS_BYTES);
        (void)hipOccupancyMaxActiveBlocksPerMultiprocessor(&per_cu, (const void*)hybrid_fwd, 512, LDS_BYTES);
        if (per_cu < 1) { fprintf(stderr, "kernel_launch: occupancy query says %d blocks/CU\n", per_cu); per_cu = 1; }
        grid = cus * 1;
        (void)hipGetLastError();
    }
    if (grid < 0) return;
    (void)hipMemsetAsync((char*)d_ws + WS_CTL, 0, 65536, stream);
    Params p{};
    for (int i = 0; i < 31; ++i) p.in[i] = (const float*)d_in[i];
    p.out = (float*)d_out; p.ws = (unsigned char*)d_ws;
    void* args[] = {&p};
    hipError_t e = hipLaunchCooperativeKernel((const void*)hybrid_fwd, dim3(grid), dim3(512), args, LDS_BYTES, stream);
    if (e != hipSuccess) fprintf(stderr, "cooperative launch failed: %s (grid %d)\n", hipGetErrorString(e), grid);
}
```

```cpp
#include <hip/hip_runtime.h>
#include <hip/hip_cooperative_groups.h>
#include <cstdio>
#include <cstdint>
namespace cg = cooperative_groups;

#define LAS __attribute__((address_space(3)))
typedef unsigned short __attribute__((may_alias)) bf16_t;
typedef short bf16x8 __attribute__((ext_vector_type(8), may_alias));
typedef short bf16x4 __attribute__((ext_vector_type(4), may_alias));
typedef float f32x4 __attribute__((ext_vector_type(4), may_alias));
typedef float f32x2 __attribute__((ext_vector_type(2), may_alias));
typedef unsigned u32x4 __attribute__((ext_vector_type(4), may_alias));
typedef unsigned u32x2 __attribute__((ext_vector_type(2), may_alias));
typedef float __attribute__((may_alias)) fal_t;
typedef unsigned __attribute__((may_alias)) ual_t;
typedef LAS unsigned char* ldsp;

constexpr int NB = 8, SEQ = 2048, MTOK = NB * SEQ, DM = 1024, DEPTH = 4, DIN = 2592, ZLD = 2816, DFF = 4096;
constexpr int ZC_SU = 0, ZC_MQ = 256, ZC_MK = 512, ZC_MV = 768, ZC_MO = 1024, ZC_AQ = 1280, ZC_CK = 1792, ZC_CV = 1920,
              ZC_SK = 2048, ZC_SV = 2176, ZC_WK = 2304, ZC_WV = 2432, ZC_G = 2560;
constexpr float EPS = 1e-6f;
constexpr float NEGF = -1e30f;

constexpr size_t MiB = 1u << 20;
constexpr size_t WS_CTL = 0;
constexpr size_t WS_WIN = 1 * MiB;
constexpr size_t WS_WOUT = 7 * MiB;
constexpr size_t WS_W1 = 9 * MiB;
constexpr size_t WS_W2 = 17 * MiB;
constexpr size_t WS_WGLU = 25 * MiB;
constexpr size_t WS_CW1K = 25 * MiB + 256 * 1024;
constexpr size_t WS_CW1V = 26 * MiB + 256 * 1024;
constexpr size_t WS_CW2K = 27 * MiB + 256 * 1024;
constexpr size_t WS_CW2V = 27 * MiB + 320 * 1024;
constexpr size_t WS_CB1 = 27 * MiB + 384 * 1024;
constexpr size_t WS_ROPE = 28 * MiB;
constexpr size_t WS_GATE = 29 * MiB;
constexpr size_t WS_S5E = 31 * MiB;
constexpr size_t WS_MLC = 33 * MiB;
constexpr size_t WS_KCMP = 42 * MiB;
constexpr size_t WS_VCMP = 42 * MiB + 512 * 1024;
constexpr size_t WS_S5T = 42 * MiB + 256 * 1024;
constexpr size_t WS_MLG = 41 * MiB + 256 * 1024;
constexpr size_t WS_U = 43 * MiB;
constexpr size_t WS_Y = 75 * MiB;
constexpr size_t WS_Z = 107 * MiB;
constexpr size_t WS_QKC = WS_Z + 88 * MiB;
constexpr size_t WS_END = 235 * MiB;
constexpr size_t WS_H16 = 235 * MiB;
constexpr size_t WS_END_H16 = 267 * MiB;
constexpr int MLC_STRIDE = 4224;

#ifndef PROBE
#define PROBE 0
#endif
#ifndef TIMEK
#define TIMEK 0
#endif
#define REPN(k) ((PROBE) == (k) ? 3 : 1)
__device__ __forceinline__ float bf2f(unsigned short v) { return __uint_as_float(((unsigned)v) << 16); }
__device__ __forceinline__ unsigned cvt_pk_bf16(float lo, float hi) { unsigned r; asm volatile("v_cvt_pk_bf16_f32 %0, %1, %2" : "=v"(r) : "v"(lo), "v"(hi)); return r; }
__device__ __forceinline__ unsigned short f2bf(float f) { return (unsigned short)(cvt_pk_bf16(f, 0.f) & 0xffffu); }
typedef short v4i16_t __attribute__((ext_vector_type(4)));
__device__ __forceinline__ bf16x4 lds_tr16(ldsp lds, int byteoff) { return __builtin_bit_cast(bf16x4, __builtin_amdgcn_ds_read_tr16_b64_v4i16((LAS v4i16_t*)(lds + byteoff))); }
__device__ __forceinline__ float xmax16_32(float v) {
    auto a = __builtin_amdgcn_permlane16_swap(__float_as_uint(v), __float_as_uint(v), false, false);
    v = fmaxf(__uint_as_float(a[0]), __uint_as_float(a[1]));
    auto b = __builtin_amdgcn_permlane32_swap(__float_as_uint(v), __float_as_uint(v), false, false);
    return fmaxf(__uint_as_float(b[0]), __uint_as_float(b[1]));
}
__device__ __forceinline__ float xsum16_32(float v) {
    auto a = __builtin_amdgcn_permlane16_swap(__float_as_uint(v), __float_as_uint(v), false, false);
    v = __uint_as_float(a[0]) + __uint_as_float(a[1]);
    auto b = __builtin_amdgcn_permlane32_swap(__float_as_uint(v), __float_as_uint(v), false, false);
    return __uint_as_float(b[0]) + __uint_as_float(b[1]);
}
template <class T> __device__ __forceinline__ T bperm_(T v, int srclane) { return __builtin_bit_cast(T, __builtin_amdgcn_ds_bpermute(srclane << 2, __builtin_bit_cast(int, v))); }
#define SHX(v, o) bperm_((v), lane ^ (o))
#define SHUP(v, o) bperm_((v), (lane >= (o)) ? lane - (o) : lane)
#define SHIDX(v, src) bperm_((v), (src))
__device__ __forceinline__ float wave_sum(float v, int lane) {
#pragma unroll
    for (int o = 1; o < 64; o <<= 1) v += SHX(v, o);
    return v;
}
__device__ __forceinline__ float sigmoidf_(float x) { return 1.0f / (1.0f + __expf(-x)); }
__device__ __forceinline__ float gelu_tanh(float x) {
    const float a = 0.7978845608028654f * (x + 0.044715f * x * x * x);
    const float e = __expf(2.0f * a);
    const float t = 1.0f - 2.0f / (e + 1.0f);
    return 0.5f * x * (1.0f + t);
}
__device__ __forceinline__ f32x4 mfma16(bf16x8 a, bf16x8 b, f32x4 c) { return __builtin_amdgcn_mfma_f32_16x16x32_bf16(a, b, c, 0, 0, 0); }
__device__ __forceinline__ bf16x8 lds_frag(ldsp lds, int byteoff) { return *(const LAS bf16x8*)(lds + byteoff); }
__device__ __forceinline__ bf16x8 pack8(const float* v) {
    u32x4 w; w.x = cvt_pk_bf16(v[0], v[1]); w.y = cvt_pk_bf16(v[2], v[3]); w.z = cvt_pk_bf16(v[4], v[5]); w.w = cvt_pk_bf16(v[6], v[7]);
    return __builtin_bit_cast(bf16x8, w);
}
__device__ __forceinline__ void unpack8(u32x4 w, float* v) {
    v[0] = __uint_as_float(w.x << 16); v[1] = __uint_as_float(w.x & 0xffff0000u);
    v[2] = __uint_as_float(w.y << 16); v[3] = __uint_as_float(w.y & 0xffff0000u);
    v[4] = __uint_as_float(w.z << 16); v[5] = __uint_as_float(w.z & 0xffff0000u);
    v[6] = __uint_as_float(w.w << 16); v[7] = __uint_as_float(w.w & 0xffff0000u);
}

namespace pg8 {
#define PG8_LAS __attribute__((address_space(3)))
constexpr int BM = 256, BK = 64, HALF = 128, HTB = HALF * BK * 2, STAGE_BYTES = 8 * HTB, NXCD = 8, WGM = 8;
__host__ __device__ __forceinline__ int lds_byte(int r, int c) { const int st = (r >> 4) * 2 + (c >> 5), rr = r & 15, cc = c & 31, ob = rr * 64 + cc * 2; return st * 1024 + (ob ^ (((ob >> 9) & 1) << 5)); }
__host__ __device__ __forceinline__ void stage_rc(int b, int& R, int& C) { const int st = b / 1024, sb = b % 1024, swz = sb ^ (((sb >> 9) & 1) << 5); R = (st >> 1) * 16 + swz / 64; C = (st & 1) * 32 + (swz % 64) / 2; }
__host__ __device__ __forceinline__ int perm32(int rho) { const int n = rho >> 4, i = rho & 15; return 8 * (i >> 2) + 4 * n + (i & 3); }
struct Unit { int pm, pn; };
struct Gemm { const bf16_t* A; const bf16_t* Bt; int M, N, K; };
struct StaticOrder {
    int nM, nN, nwg, G, c;
    __host__ __device__ void init(int M, int N, int G_, int c_) { nM = M / BM; nN = N / BM; nwg = nM * nN; G = G_; c = c_; }
    __host__ __device__ bool next(int i, Unit& u) const {
        const long L = (long)i * G + c; if (L >= nwg) return false;
        int wgid = (int)L; { const int q = nwg / NXCD, r = nwg % NXCD, xcd = wgid % NXCD, off = wgid / NXCD; wgid = (xcd < r ? xcd * (q + 1) : r * (q + 1) + (xcd - r) * q) + off; }
        const int nig = WGM * nN, gid = wgid / nig, fm = gid * WGM, gsz = (nM - fm) < WGM ? (nM - fm) : WGM;
        u.pm = fm + ((wgid % nig) % gsz); u.pn = (wgid % nig) / gsz; return true;
    }
    __device__ __forceinline__ void a_ready(const Unit&) const {}
    __device__ __forceinline__ void done(const Unit&) const {}
};
template <int ACT  > struct EpiBf16 {
    static constexpr bool PERM = true, AFTER_DRAIN = false;
    bf16_t* O; int ldc; float* gate; int gate_pn;
    __device__ __forceinline__ void operator()(const f32x4 (&acc)[2][2][4][2], const Unit& u, int wr, int wc, int fr, int fq) const {
        const int row0 = u.pm * BM + wr * 64 + fr;
        if (u.pn == gate_pn) {
            if (wc == 0) {
#pragma unroll
                for (int ai = 0; ai < 2; ++ai)
#pragma unroll
                    for (int m = 0; m < 4; ++m) { float* gp = gate + (size_t)(row0 + ai * HALF + m * 16) * 32 + 8 * fq;
                        *(f32x4*)(gp) = acc[ai][0][m][0]; *(f32x4*)(gp + 4) = acc[ai][0][m][1]; }
            }
            return;
        }
        const int col0 = u.pn * BM + wc * 32 + 8 * fq;
#pragma unroll
        for (int ai = 0; ai < 2; ++ai)
#pragma unroll
            for (int m = 0; m < 4; ++m) { bf16_t* rowp = O + (size_t)(row0 + ai * HALF + m * 16) * ldc + col0;
#pragma unroll
                for (int bj = 0; bj < 2; ++bj) { f32x4 v0 = acc[ai][bj][m][0], v1 = acc[ai][bj][m][1];
                    if (ACT == 2) {
#pragma unroll
                        for (int e = 0; e < 4; ++e) { float a = fmaxf(v0[e], 0.f); v0[e] = a * a; float b = fmaxf(v1[e], 0.f); v1[e] = b * b; }
                    }
                    u32x4 w; w.x = cvt_pk_bf16(v0[0], v0[1]); w.y = cvt_pk_bf16(v0[2], v0[3]); w.z = cvt_pk_bf16(v1[0], v1[1]); w.w = cvt_pk_bf16(v1[2], v1[3]);
                    *(u32x4*)(rowp + bj * HALF) = w; } }
    }
};

template <class Epi, class Sched, bool ALIGN_EPI = false, bool SP2 = false>
__device__ __forceinline__ void gemm_phase(PG8_LAS unsigned char* lds, const Gemm g, const Sched& S, const Epi& E, const int tid) {
    const int wid = __builtin_amdgcn_readfirstlane(tid >> 6), lane = tid & 63, wr = wid >> 2, wc = wid & 3, fr = lane & 15, fq = lane >> 4;
    const int K = g.K, nt = K / BK;
    unsigned voffA[2], voffB[2];
#pragma unroll
    for (int i = 0; i < 2; ++i) { int R, C; stage_rc(tid * 16 + i * 8192, R, C); const int Rb = Epi::PERM ? ((R & ~31) + perm32(R & 31)) : R;
        voffA[i] = (unsigned)(R * K + C) * 2u; voffB[i] = (unsigned)(Rb * K + C) * 2u; }
    const size_t kstep = (size_t)(BK * 2);
    const size_t hstep = (size_t)HALF * K * 2;
    const size_t tstep = 2 * hstep;
    const unsigned ldsw = (unsigned)wid * 1024u;
    const int aoff = lds_byte(wr * 64 + fr, fq * 8), boff = lds_byte(wc * 32 + fr, fq * 8);
#define PG8_SA(b, h) (((b) * 2 + (h)) * HTB)
#define PG8_SB(b, h) ((4 + (b) * 2 + (h)) * HTB)
#define PG8_STAGE(bufoff, gbase, voff) do { _Pragma("unroll") for (int _i = 0; _i < 2; ++_i) \
        __builtin_amdgcn_global_load_lds((const unsigned*)((const char*)(gbase) + (voff)[_i]), (PG8_LAS ual_t*)(lds + (bufoff) + ldsw + _i * 8192), 16, 0, 0); } while (0)
#define PG8_LDA(dst, b, h) do { _Pragma("unroll") for (int m = 0; m < 4; ++m) _Pragma("unroll") for (int k = 0; k < 2; ++k) dst[m][k] = *(const PG8_LAS bf16x8*)(lds + PG8_SA(b, h) + aoff + m * 2048 + k * 1024); } while (0)
#define PG8_LDB(dst, b, h) do { _Pragma("unroll") for (int n = 0; n < 2; ++n) _Pragma("unroll") for (int k = 0; k < 2; ++k) dst[n][k] = *(const PG8_LAS bf16x8*)(lds + PG8_SB(b, h) + boff + n * 2048 + k * 1024); } while (0)
#define PG8_MMA(ai, bj, At, Bt) do { __builtin_amdgcn_s_setprio(1); _Pragma("unroll") for (int m = 0; m < 4; ++m) _Pragma("unroll") for (int n = 0; n < 2; ++n) _Pragma("unroll") for (int k = 0; k < 2; ++k) \
        acc[ai][bj][m][n] = __builtin_amdgcn_mfma_f32_16x16x32_bf16(Bt[n][k], At[m][k], acc[ai][bj][m][n], 0, 0, 0); __builtin_amdgcn_s_setprio(0); } while (0)
#define PG8_WAIT_V(n) asm volatile("s_waitcnt vmcnt(" #n ")" ::: "memory")
#define PG8_WAIT_L(n) asm volatile("s_waitcnt lgkmcnt(" #n ")" ::: "memory")
#define PG8_BAR __builtin_amdgcn_s_barrier()
#define PG8_SCHED __builtin_amdgcn_sched_barrier(0)
    Unit cur, nxt; int ui = 0;
    if (!S.next(0, cur)) return;
    f32x4 acc[2][2][4][2];
#pragma unroll
    for (int a = 0; a < 2; ++a)
#pragma unroll
        for (int b = 0; b < 2; ++b)
#pragma unroll
            for (int m = 0; m < 4; ++m)
#pragma unroll
                for (int n = 0; n < 2; ++n) acc[a][b][m][n] = (f32x4){0.f, 0.f, 0.f, 0.f};
    bf16x8 At[4][2], B0[2][2], B1[2][2];
    const char* cA = (const char*)g.A + (size_t)cur.pm * tstep; const char* cB = (const char*)g.Bt + (size_t)cur.pn * tstep;
    S.a_ready(cur);
    if constexpr (SP2) {
        PG8_STAGE(PG8_SB(0, 0), cB, voffB); PG8_STAGE(PG8_SB(0, 1), cB + hstep, voffB); PG8_STAGE(PG8_SA(0, 0), cA, voffA); PG8_STAGE(PG8_SA(0, 1), cA + hstep, voffA);
        if (wr == 1) PG8_BAR;
        PG8_WAIT_V(2); PG8_BAR;
        PG8_STAGE(PG8_SB(1, 0), cB + kstep, voffB); PG8_STAGE(PG8_SA(1, 0), cA + kstep, voffA); PG8_STAGE(PG8_SB(1, 1), cB + hstep + kstep, voffB);
        PG8_WAIT_V(6); PG8_BAR;
    } else {
        PG8_STAGE(PG8_SB(0, 0), cB, voffB); PG8_STAGE(PG8_SA(0, 0), cA, voffA); PG8_STAGE(PG8_SB(0, 1), cB + hstep, voffB); PG8_STAGE(PG8_SA(0, 1), cA + hstep, voffA);
        if (wr == 1) PG8_BAR;
        PG8_WAIT_V(4); PG8_BAR;
        PG8_STAGE(PG8_SB(1, 0), cB + kstep, voffB); PG8_STAGE(PG8_SA(1, 0), cA + kstep, voffA); PG8_STAGE(PG8_SB(1, 1), cB + hstep + kstep, voffB);
        PG8_WAIT_V(6); PG8_BAR;
    }
    for (;;) {
        const bool has_next = S.next(ui + 1, nxt);
        const char* nA = has_next ? (const char*)g.A + (size_t)nxt.pm * tstep : cA; const char* nB = has_next ? (const char*)g.Bt + (size_t)nxt.pn * tstep : cB;
        for (int t = 0; t < nt; t += 2) {
            const bool last = (t == nt - 2);
            const char* a1 = cA + (size_t)(t + 1) * kstep;
            const char* a2 = last ? nA : cA + (size_t)(t + 2) * kstep; const char* b2 = last ? nB : cB + (size_t)(t + 2) * kstep;
            const char* a3 = a2 + kstep; const char* b3 = b2 + kstep;
            if (last && has_next) S.a_ready(nxt);
            if constexpr (SP2) {
            PG8_LDB(B0, 0, 0); PG8_LDB(B1, 0, 1); PG8_SCHED; PG8_LDA(At, 0, 0); PG8_STAGE(PG8_SA(1, 1), a1 + hstep, voffA);
            PG8_WAIT_V(8); PG8_WAIT_L(0); PG8_BAR; PG8_MMA(0, 0, At, B0); PG8_MMA(0, 1, At, B1); PG8_BAR; PG8_SCHED;
            PG8_LDA(At, 0, 1); PG8_STAGE(PG8_SB(0, 0), b2, voffB); PG8_STAGE(PG8_SB(0, 1), b2 + hstep, voffB); PG8_STAGE(PG8_SA(0, 0), a2, voffA);
            PG8_WAIT_V(8); PG8_WAIT_L(0); PG8_BAR; PG8_MMA(1, 0, At, B0); PG8_MMA(1, 1, At, B1); PG8_BAR; PG8_SCHED;
            PG8_LDB(B0, 1, 0); PG8_LDB(B1, 1, 1); PG8_SCHED; PG8_LDA(At, 1, 0); PG8_STAGE(PG8_SA(0, 1), a2 + hstep, voffA);
            PG8_WAIT_V(8); PG8_WAIT_L(0); PG8_BAR; PG8_MMA(0, 0, At, B0); PG8_MMA(0, 1, At, B1); PG8_BAR; PG8_SCHED;
            PG8_LDA(At, 1, 1); PG8_STAGE(PG8_SB(1, 0), b3, voffB); PG8_STAGE(PG8_SB(1, 1), b3 + hstep, voffB); PG8_STAGE(PG8_SA(1, 0), a3, voffA);
            PG8_WAIT_V(8); PG8_WAIT_L(0); PG8_BAR; PG8_MMA(1, 0, At, B0); PG8_MMA(1, 1, At, B1); PG8_BAR; PG8_SCHED;
            } else {
            PG8_LDB(B0, 0, 0); PG8_SCHED; PG8_LDA(At, 0, 0); PG8_STAGE(PG8_SA(1, 1), a1 + hstep, voffA);
            PG8_WAIT_L(8); PG8_BAR; PG8_WAIT_L(0); PG8_MMA(0, 0, At, B0); PG8_BAR; PG8_SCHED;
            PG8_LDB(B1, 0, 1); PG8_STAGE(PG8_SB(0, 0), b2, voffB);
            PG8_BAR; PG8_WAIT_L(0); PG8_MMA(0, 1, At, B1); PG8_BAR;
            PG8_LDA(At, 0, 1); PG8_STAGE(PG8_SA(0, 0), a2, voffA);
            PG8_BAR; PG8_WAIT_L(0); PG8_MMA(1, 0, At, B0); PG8_BAR; PG8_SCHED;
            PG8_STAGE(PG8_SB(0, 1), b2 + hstep, voffB);
            PG8_WAIT_V(6); PG8_BAR; PG8_MMA(1, 1, At, B1); PG8_BAR;
            PG8_LDB(B0, 1, 0); PG8_SCHED; PG8_LDA(At, 1, 0); PG8_STAGE(PG8_SA(0, 1), a2 + hstep, voffA);
            PG8_WAIT_L(8); PG8_BAR; PG8_WAIT_L(0); PG8_MMA(0, 0, At, B0); PG8_BAR; PG8_SCHED;
            PG8_LDB(B1, 1, 1); PG8_STAGE(PG8_SB(1, 0), b3, voffB);
            PG8_BAR; PG8_WAIT_L(0); PG8_MMA(0, 1, At, B1); PG8_BAR;
            PG8_LDA(At, 1, 1); PG8_STAGE(PG8_SA(1, 0), a3, voffA);
            PG8_BAR; PG8_WAIT_L(0); PG8_MMA(1, 0, At, B0); PG8_BAR; PG8_SCHED;
            PG8_STAGE(PG8_SB(1, 1), b3 + hstep, voffB);
            PG8_WAIT_V(6); PG8_BAR; PG8_MMA(1, 1, At, B1); PG8_BAR;
            }
        }
        if constexpr (ALIGN_EPI) { if (wr == 0) PG8_BAR; }
        if constexpr (!Epi::AFTER_DRAIN) { E(acc, cur, wr, wc, fr, fq); S.done(cur); }
        if (!has_next) break;
#pragma unroll
        for (int a = 0; a < 2; ++a)
#pragma unroll
            for (int b = 0; b < 2; ++b)
#pragma unroll
                for (int m = 0; m < 4; ++m)
#pragma unroll
                    for (int n = 0; n < 2; ++n) acc[a][b][m][n] = (f32x4){0.f, 0.f, 0.f, 0.f};
        cur = nxt; cA = nA; cB = nB; ++ui;
        if constexpr (ALIGN_EPI) { if (wr == 1) PG8_BAR; }
    }
    PG8_WAIT_V(0);
    if constexpr (!ALIGN_EPI) { if (wr == 0) PG8_BAR; }
    PG8_BAR;
#undef PG8_SA
#undef PG8_SB
#undef PG8_STAGE
#undef PG8_LDA
#undef PG8_LDB
#undef PG8_MMA
#undef PG8_WAIT_V
#undef PG8_WAIT_L
#undef PG8_BAR
#undef PG8_SCHED
}
}

struct Params {
    const float* in[31];
    float* out;
    unsigned char* ws;
    int hb16;
    int pad;
};
typedef const __attribute__((address_space(4))) Params* KP;
enum { I_X = 0, I_POS, I_LN_MIX_PRE, I_LN_MIX_POST, I_LN_MLP_PRE, I_LN_MLP_POST, I_W_IN, I_W_OUT, I_LAM_RE, I_LAM_IM, I_B_RE, I_B_IM, I_C_RE, I_C_IM,
       I_SSM_D, I_LOG_DT, I_W_GLU, I_CONV, I_B_I, I_B_F, I_PE_K, I_W1_K, I_W2_K, I_PE_V, I_W1_V, I_W2_V, I_GN_SSM, I_GN_MLSTM, I_GN_NSA, I_MLP_W1, I_MLP_W2 };

constexpr int LDS_BYTES = 147456;
constexpr int MISC_OFF = 131072 + 8192;

__device__ __forceinline__ int win_src_col(int n) {
    if (n < 1280) return n;
    if (n < 2560) return n + 8;
    if (n < 2568) return n - 2560 + 1280;
    if (n < 2592) return n;
    return -1;
}
__device__ __forceinline__ void conv_item(const float* W, int K, int N, bf16_t* WT, int mode, int nblk, LAS fal_t* scr, int item, int lane) {
    const int kb = item / nblk, nb = item % nblk, k0 = 64 * kb, n0 = 64 * nb;
    const int nn = n0 + lane;
    const int sc = mode ? win_src_col(nn) : nn;
    const float* src = W + (size_t)k0 * N + (sc >= 0 ? sc : 0);
    float vv[64];
#pragma unroll
    for (int kk = 0; kk < 64; ++kk) vv[kk] = src[(size_t)kk * N];
#pragma unroll
    for (int kk = 0; kk < 64; ++kk) scr[kk * 65 + lane] = (sc >= 0) ? vv[kk] : 0.f;
    asm volatile("s_waitcnt lgkmcnt(0)" ::: "memory");
    const int c = lane & 7;
#pragma unroll
    for (int j = 0; j < 8; ++j) { const int n = (lane >> 3) + 8 * j; const LAS fal_t* sp = scr + (8 * c) * 65 + n;
        u32x4 o; o.x = cvt_pk_bf16(sp[0 * 65], sp[1 * 65]); o.y = cvt_pk_bf16(sp[2 * 65], sp[3 * 65]); o.z = cvt_pk_bf16(sp[4 * 65], sp[5 * 65]); o.w = cvt_pk_bf16(sp[6 * 65], sp[7 * 65]);
        *(u32x4*)(WT + (size_t)(n0 + n) * K + k0 + 8 * c) = o; }
    asm volatile("s_waitcnt lgkmcnt(0)" ::: "memory");
}

__device__ __forceinline__ void convert_layer(KP P, int l, ldsp lds, int gw, int NGW, int wave, int lane) {
    LAS fal_t* scr = (LAS fal_t*)(lds + wave * 16640);
    unsigned char* ws = P->ws;
    constexpr int I0 = 16 * 44, I1 = 16 * 16, I2 = 16 * 64, I3 = 64 * 16, I4 = 4 * 4, I5 = 32 * 4, I6 = 32 * 4, I7 = 4 * 1, I8 = 4 * 1, I9 = 128, I10 = 16;
    constexpr int NIT = I0 + I1 + I2 + I3 + I4 + I5 + I6 + I7 + I8 + I9 + I10;
    for (int it = gw; it < NIT; it += NGW) {
        int r = it;
        if (r < I0) { conv_item(P->in[I_W_IN] + (size_t)l * DM * DIN, DM, DIN, (bf16_t*)(ws + WS_WIN), 1, 44, scr, r, lane); continue; } r -= I0;
        if (r < I1) { conv_item(P->in[I_W_OUT] + (size_t)l * DM * DM, DM, DM, (bf16_t*)(ws + WS_WOUT), 0, 16, scr, r, lane); continue; } r -= I1;
        if (r < I2) { conv_item(P->in[I_MLP_W1] + (size_t)l * DM * DFF, DM, DFF, (bf16_t*)(ws + WS_W1), 0, 64, scr, r, lane); continue; } r -= I2;
        if (r < I3) { conv_item(P->in[I_MLP_W2] + (size_t)l * DFF * DM, DFF, DM, (bf16_t*)(ws + WS_W2), 0, 16, scr, r, lane); continue; } r -= I3;
        if (r < I4) { conv_item(P->in[I_W_GLU] + (size_t)l * 256 * 256, 256, 256, (bf16_t*)(ws + WS_WGLU), 0, 4, scr, r, lane); continue; } r -= I4;
        if (r < I5) { conv_item(P->in[I_W1_K] + (size_t)l * 2048 * 256, 2048, 256, (bf16_t*)(ws + WS_CW1K), 0, 4, scr, r, lane); continue; } r -= I5;
        if (r < I6) { conv_item(P->in[I_W1_V] + (size_t)l * 2048 * 256, 2048, 256, (bf16_t*)(ws + WS_CW1V), 0, 4, scr, r, lane); continue; } r -= I6;
        if (r < I7) { conv_item(P->in[I_W2_K] + (size_t)l * 256 * 64, 256, 64, (bf16_t*)(ws + WS_CW2K), 0, 1, scr, r, lane); continue; } r -= I7;
        if (r < I8) { conv_item(P->in[I_W2_V] + (size_t)l * 256 * 64, 256, 64, (bf16_t*)(ws + WS_CW2V), 0, 1, scr, r, lane); continue; } r -= I8;
        if (r >= I9) {
            const int g = r - I9, p = lane;
            const float dt = expf(P->in[I_LOG_DT][l * 16 + g]);
            const float lr = P->in[I_LAM_RE][(l * 16 + g) * 64 + p], li = P->in[I_LAM_IM][(l * 16 + g) * 64 + p];
            const float mag = expf(lr * dt), ang = li * dt;
            const float ar = mag * cosf(ang), ai = mag * sinf(ang);
            const float den = lr * lr + li * li;
            const float gr = ((ar - 1.0f) * lr + ai * li) / den, gi = (ai * lr - (ar - 1.0f) * li) / den;
            float pr = ar, pi = ai;
#pragma unroll
            for (int q = 0; q < 4; ++q) { const float nr = pr * pr - pi * pi, ni = 2.f * pr * pi; pr = nr; pi = ni; }
            const float p16r = pr, p16i = pi;
#pragma unroll
            for (int q = 0; q < 2; ++q) { const float nr = pr * pr - pi * pi, ni = 2.f * pr * pi; pr = nr; pi = ni; }
            float* tf = (float*)(ws + WS_S5T) + (size_t)(g * 64 + p) * 8;
            *(f32x4*)tf = (f32x4){ar, ai, p16r, p16i}; *(f32x4*)(tf + 4) = (f32x4){pr, pi, 0.f, 0.f};
            const float* br = P->in[I_B_RE] + ((size_t)(l * 16 + g) * 64 + p) * 16;
            const float* bi = P->in[I_B_IM] + ((size_t)(l * 16 + g) * 64 + p) * 16;
            float vr[16], vi[16];
#pragma unroll
            for (int q = 0; q < 4; ++q) { const f32x4 a = *(const f32x4*)(br + 4 * q), b = *(const f32x4*)(bi + 4 * q);
#pragma unroll
                for (int e = 0; e < 4; ++e) { vr[4 * q + e] = gr * a[e] - gi * b[e]; vi[4 * q + e] = gr * b[e] + gi * a[e]; } }
            bf16_t* tb = (bf16_t*)(ws + WS_S5T + 32768) + (size_t)(g * 64 + p) * 32;
            *(bf16x8*)tb = pack8(vr); *(bf16x8*)(tb + 8) = pack8(vr + 8); *(bf16x8*)(tb + 16) = pack8(vi); *(bf16x8*)(tb + 24) = pack8(vi + 8);
            continue;
        }
        {
            const int kv = r >> 6, hid = ((r >> 4) & 3) * 64 + lane, kc = r & 15;
            const float* pe = P->in[kv ? I_PE_V : I_PE_K] + (size_t)l * 2048 + kc * 128;
            const float* w1 = P->in[kv ? I_W1_V : I_W1_K] + (size_t)l * 2048 * 256 + (size_t)kc * 128 * 256;
            float a0 = 0.f, a1 = 0.f, a2 = 0.f, a3 = 0.f;
#pragma unroll 4
            for (int k = 0; k < 128; k += 4) {
                a0 += pe[k] * w1[(size_t)k * 256 + hid]; a1 += pe[k + 1] * w1[(size_t)(k + 1) * 256 + hid];
                a2 += pe[k + 2] * w1[(size_t)(k + 2) * 256 + hid]; a3 += pe[k + 3] * w1[(size_t)(k + 3) * 256 + hid];
            }
            ((float*)(ws + WS_CB1))[kc * 512 + kv * 256 + hid] = (a0 + a1) + (a2 + a3);
        }
    }
}

__device__ __forceinline__ void norm_pass(const float* xin, const bf16_t* f, const float* gpost, const float* gpre, float* h32, bf16_t* hb, float* out32, bf16_t* u, int gw, int NGW, int lane) {
    for (int m = gw; m < MTOK; m += NGW) {
        f32x4 hv[4];
        const size_t off = (size_t)m * DM + 4 * lane;
        if (f == nullptr) {
#pragma unroll
            for (int j = 0; j < 4; ++j) hv[j] = *(const f32x4*)(xin + off + 256 * j);
        } else {
            f32x4 fv[4]; float ss = 0.f;
#pragma unroll
            for (int j = 0; j < 4; ++j) {
                if (hb) { const u32x2 hw = *(const u32x2*)(hb + off + 256 * j);
                    hv[j] = (f32x4){__uint_as_float(hw.x << 16), __uint_as_float(hw.x & 0xffff0000u), __uint_as_float(hw.y << 16), __uint_as_float(hw.y & 0xffff0000u)}; }
                else hv[j] = *(const f32x4*)(h32 + off + 256 * j);
                const u32x2 w = *(const u32x2*)(f + off + 256 * j);
                fv[j][0] = __uint_as_float(w.x << 16); fv[j][1] = __uint_as_float(w.x & 0xffff0000u); fv[j][2] = __uint_as_float(w.y << 16); fv[j][3] = __uint_as_float(w.y & 0xffff0000u);
                ss += fv[j][0] * fv[j][0] + fv[j][1] * fv[j][1] + fv[j][2] * fv[j][2] + fv[j][3] * fv[j][3];
            }
            ss = wave_sum(ss, lane);
            const float rs = rsqrtf(ss * (1.0f / DM) + EPS);
#pragma unroll
            for (int j = 0; j < 4; ++j) { const f32x4 g = *(const f32x4*)(gpost + 4 * lane + 256 * j); hv[j] += fv[j] * rs * g; }
        }
        if (out32) {
#pragma unroll
            for (int j = 0; j < 4; ++j) *(f32x4*)(out32 + off + 256 * j) = hv[j];
        }
        if (hb && gpre) {
#pragma unroll
            for (int j = 0; j < 4; ++j) { u32x2 w; w.x = cvt_pk_bf16(hv[j][0], hv[j][1]); w.y = cvt_pk_bf16(hv[j][2], hv[j][3]); *(u32x2*)(hb + off + 256 * j) = w; }
        }
        if (gpre) {
            float ss = 0.f;
#pragma unroll
            for (int j = 0; j < 4; ++j) ss += hv[j][0] * hv[j][0] + hv[j][1] * hv[j][1] + hv[j][2] * hv[j][2] + hv[j][3] * hv[j][3];
            ss = wave_sum(ss, lane);
            const float rs = rsqrtf(ss * (1.0f / DM) + EPS);
#pragma unroll
            for (int j = 0; j < 4; ++j) { const f32x4 g = *(const f32x4*)(gpre + 4 * lane + 256 * j); const f32x4 o = hv[j] * rs * g;
                u32x2 w; w.x = cvt_pk_bf16(o[0], o[1]); w.y = cvt_pk_bf16(o[2], o[3]); *(u32x2*)(u + off + 256 * j) = w; }
        }
    }
}

struct S5H { float ar[2], ai[2], p16r[2], p16i[2]; bf16x8 Bf[4]; };
__device__ __forceinline__ void s5h_setup(KP P, int l, int g, int r16, int g4, int half, S5H& s) {
    const float* tf = (const float*)(P->ws + WS_S5T);
    const bf16_t* tb = (const bf16_t*)(P->ws + WS_S5T + 32768);
#pragma unroll
    for (int ii = 0; ii < 2; ++ii) {
        const int p = 16 * (2 * half + ii) + r16;
        const f32x4 t0 = *(const f32x4*)(tf + (size_t)(g * 64 + p) * 8);
        s.ar[ii] = t0[0]; s.ai[ii] = t0[1]; s.p16r[ii] = t0[2]; s.p16i[ii] = t0[3];
        u32x4 wr = (u32x4){0u, 0u, 0u, 0u}, wi = (u32x4){0u, 0u, 0u, 0u};
        if (g4 < 2) { wr = *(const u32x4*)(tb + (size_t)(g * 64 + p) * 32 + 8 * g4); wi = *(const u32x4*)(tb + (size_t)(g * 64 + p) * 32 + 16 + 8 * g4); }
        s.Bf[ii] = __builtin_bit_cast(bf16x8, wr); s.Bf[2 + ii] = __builtin_bit_cast(bf16x8, wi);
    }
}
__device__ __forceinline__ void s5_load_u(const bf16_t* z, int m0, int g, bf16x8 (&Af)[4], int r16, int g4) {
#pragma unroll
    for (int mf = 0; mf < 4; ++mf) {
        const int tok = 16 * (r16 >> 2) + 4 * mf + (r16 & 3);
        u32x4 w = (u32x4){0u, 0u, 0u, 0u};
        if (g4 < 2) w = *(const u32x4*)(z + (size_t)(m0 + tok) * ZLD + ZC_SU + g * 16 + 8 * g4);
        Af[mf] = __builtin_bit_cast(bf16x8, w);
    }
}
__device__ __forceinline__ void s5h_bu(const bf16x8 (&Af)[4], const S5H& s, f32x4 (&C)[4][4]) {
#pragma unroll
    for (int mf = 0; mf < 4; ++mf)
#pragma unroll
        for (int j = 0; j < 4; ++j) C[mf][j] = mfma16(Af[mf], s.Bf[j], (f32x4){0.f, 0.f, 0.f, 0.f});
}
#define CMUL_R(ar_, ai_, br_, bi_) ((ar_) * (br_) - (ai_) * (bi_))
#define CMUL_I(ar_, ai_, br_, bi_) ((ar_) * (bi_) + (ai_) * (br_))

__device__ __forceinline__ void s5_stage1(KP P, int l, int bitem, ldsp lds, int wave, int lane) {
    const int wi = bitem * 8 + wave;
    const int c = wi & 31, g = (wi >> 5) & 15, b = wi >> 9;
    const int r16 = lane & 15, g4 = lane >> 4;
    const bf16_t* z = (const bf16_t*)(P->ws + WS_Z);
    bf16x8 Af[4]; s5_load_u(z, b * SEQ + c * 64, g, Af, r16, g4);
    float* E = (float*)(P->ws + WS_S5E) + (size_t)wi * 128;
#pragma nounroll
    for (int half = 0; half < 2; ++half) {
        S5H s; s5h_setup(P, l, g, r16, g4, half, s);
        f32x4 C[4][4];
        s5h_bu(Af, s, C);
#pragma unroll
        for (int ii = 0; ii < 2; ++ii) {
            const float ar = s.ar[ii], ai = s.ai[ii];
            float xr = 0.f, xi = 0.f;
#pragma unroll
            for (int k = 0; k < 16; ++k) { const float bur = C[k >> 2][ii][k & 3], bui = C[k >> 2][2 + ii][k & 3];
                const float nr = ar * xr - ai * xi + bur, ni = ar * xi + ai * xr + bui; xr = nr; xi = ni; }
            const float pr = s.p16r[ii], pi = s.p16i[ii];
            const float p2r = CMUL_R(pr, pi, pr, pi), p2i = CMUL_I(pr, pi, pr, pi), p3r = CMUL_R(p2r, p2i, pr, pi), p3i = CMUL_I(p2r, p2i, pr, pi);
            const float wr = g4 == 3 ? 1.f : (g4 == 2 ? pr : (g4 == 1 ? p2r : p3r)), wim = g4 == 3 ? 0.f : (g4 == 2 ? pi : (g4 == 1 ? p2i : p3i));
            const float er = xsum16_32(CMUL_R(wr, wim, xr, xi)), ei = xsum16_32(CMUL_I(wr, wim, xr, xi));
            const int p = 16 * (2 * half + ii) + r16;
            if (g4 == 0) { __hip_atomic_store(&E[p], er, __ATOMIC_RELAXED, __HIP_MEMORY_SCOPE_AGENT); __hip_atomic_store(&E[64 + p], ei, __ATOMIC_RELAXED, __HIP_MEMORY_SCOPE_AGENT); }
        }
    }
    asm volatile("s_waitcnt vmcnt(0)" ::: "memory");
    unsigned old = 0u;
    if (lane == 0) old = __hip_atomic_fetch_add((unsigned*)(P->ws + WS_CTL) + 12288 + (l * 128 + b * 16 + g) * 4, 1u, __ATOMIC_RELAXED, __HIP_MEMORY_SCOPE_AGENT);
    old = (unsigned)__builtin_amdgcn_readfirstlane((int)old);
    if (old == 31u) {
        __builtin_amdgcn_fence(__ATOMIC_ACQUIRE, "agent");
        asm volatile("s_waitcnt vmcnt(0)" ::: "memory");
        float* Er = (float*)(P->ws + WS_S5E) + (size_t)((b * 16 + g) * 32) * 128;
        const f32x4 t1 = *(const f32x4*)((const float*)(P->ws + WS_S5T) + (size_t)(g * 64 + lane) * 8 + 4);
        const float qr = t1[0], qi = t1[1];
        float xr = 0.f, xi = 0.f;
#pragma unroll 1
        for (int c0 = 0; c0 < 32; c0 += 16) {
            float er[16], ei[16];
#pragma unroll
            for (int q = 0; q < 16; ++q) { er[q] = Er[(c0 + q) * 128 + lane]; ei[q] = Er[(c0 + q) * 128 + 64 + lane]; }
#pragma unroll
            for (int q = 0; q < 16; ++q) { Er[(c0 + q) * 128 + lane] = xr; Er[(c0 + q) * 128 + 64 + lane] = xi;
                const float nr = CMUL_R(qr, qi, xr, xi) + er[q], ni = CMUL_I(qr, qi, xr, xi) + ei[q]; xr = nr; xi = ni; }
        }
    }
}

__device__ __forceinline__ void s5_stage2(KP P, int l, int bitem, ldsp lds, int wave, int lane) {
    const int c = bitem & 31, b = bitem >> 5;
    const bf16_t* z = (const bf16_t*)(P->ws + WS_Z);
    constexpr int YLD = 264;
    const int Y_OFF = 0, XS_OFF = 34816 + wave * 4352;
    const int r16 = lane & 15, g4 = lane >> 4;
    const int m0 = b * SEQ + c * 64;
#pragma nounroll
    for (int gi = 0; gi < 2; ++gi) {
        const int g = 2 * wave + gi;
        bf16x8 Af[4]; s5_load_u(z, m0, g, Af, r16, g4);
        const float dsk = P->in[I_SSM_D][l * 256 + g * 16 + r16];
        const float* E = (const float*)(P->ws + WS_S5E) + (size_t)((b * 16 + g) * 32) * 128;
        const float* cre = P->in[I_C_RE] + ((size_t)(l * 16 + g) * 16 + r16) * 64;
        const float* cim = P->in[I_C_IM] + ((size_t)(l * 16 + g) * 16 + r16) * 64;
        f32x4 acc[4];
#pragma unroll
        for (int q = 0; q < 4; ++q) acc[q] = (f32x4){0.f, 0.f, 0.f, 0.f};
#pragma nounroll
        for (int half = 0; half < 2; ++half) {
            S5H s; s5h_setup(P, l, g, r16, g4, half, s);
            bf16x8 Cf[2];
#pragma unroll
            for (int ks = 0; ks < 2; ++ks) {
                const f32x4 a = *(const f32x4*)(cre + 32 * half + 16 * ks + 4 * g4), bq = *(const f32x4*)(cim + 32 * half + 16 * ks + 4 * g4);
                float v[8] = {a[0], -bq[0], a[1], -bq[1], a[2], -bq[2], a[3], -bq[3]};
                Cf[ks] = pack8(v);
            }
            f32x4 C[4][4];
            s5h_bu(Af, s, C);
            float xr[2], xi[2];
#pragma unroll
            for (int ii = 0; ii < 2; ++ii) {
                const float ar = s.ar[ii], ai = s.ai[ii];
                float er = 0.f, ei = 0.f;
#pragma unroll
                for (int k = 0; k < 16; ++k) { const float bur = C[k >> 2][ii][k & 3], bui = C[k >> 2][2 + ii][k & 3];
                    const float nr = ar * er - ai * ei + bur, ni = ar * ei + ai * er + bui; er = nr; ei = ni; }
                const float p16r = s.p16r[ii], p16i = s.p16i[ii];
                const int p = 16 * (2 * half + ii) + r16;
                const float x0r = E[c * 128 + p], x0i = E[c * 128 + 64 + p];
                float cr = x0r, ci = x0i;
#pragma unroll
                for (int gq = 0; gq < 3; ++gq) {
                    const float eqr = SHIDX(er, r16 + 16 * gq), eqi = SHIDX(ei, r16 + 16 * gq);
                    const float nr = CMUL_R(p16r, p16i, cr, ci) + eqr, ni = CMUL_I(p16r, p16i, cr, ci) + eqi;
                    if (g4 > gq) { cr = nr; ci = ni; }
                }
                xr[ii] = cr; xi[ii] = ci;
            }
#pragma unroll
            for (int q = 0; q < 4; ++q) {
#pragma unroll
                for (int ii = 0; ii < 2; ++ii) {
                    const float ar = s.ar[ii], ai = s.ai[ii];
#pragma unroll
                    for (int rg = 0; rg < 4; ++rg) {
                        const float nr = ar * xr[ii] - ai * xi[ii] + C[q][ii][rg], ni = ar * xi[ii] + ai * xr[ii] + C[q][2 + ii][rg];
                        xr[ii] = nr; xi[ii] = ni;
                        *(LAS ual_t*)(lds + XS_OFF + ((4 * g4 + rg) * 136 + 2 * (16 * ii + r16)) * 2) = cvt_pk_bf16(nr, ni);
                    }
                }
#pragma unroll
                for (int ks = 0; ks < 2; ++ks) acc[q] = mfma16(lds_frag(lds, XS_OFF + (r16 * 136 + 32 * ks + 8 * g4) * 2), Cf[ks], acc[q]);
            }
        }
#pragma unroll
        for (int q = 0; q < 4; ++q)
#pragma unroll
            for (int rg = 0; rg < 4; ++rg) {
                const int tok = 16 * g4 + 4 * q + rg;
                float y = acc[q][rg] + dsk * bf2f(z[(size_t)(m0 + tok) * ZLD + ZC_SU + g * 16 + r16]);
                y = gelu_tanh(y);
                *(LAS bf16_t*)(lds + Y_OFF + (tok * YLD + g * 16 + r16) * 2) = f2bf(y);
            }
    }
    {
        const bf16_t* wg = (const bf16_t*)(P->ws + WS_WGLU);
        bf16x8 bfr[8][2];
#pragma unroll
        for (int ks = 0; ks < 8; ++ks)
#pragma unroll
            for (int nf = 0; nf < 2; ++nf) bfr[ks][nf] = *(const bf16x8*)(wg + (size_t)(32 * wave + 16 * nf + r16) * 256 + 32 * ks + 8 * g4);
        __syncthreads();
        for (int rp43 = 0; rp43 < REPN(43); ++rp43) {
        f32x4 acc[4][2];
#pragma unroll
        for (int mf = 0; mf < 4; ++mf) { acc[mf][0] = (f32x4){0.f, 0.f, 0.f, 0.f}; acc[mf][1] = (f32x4){0.f, 0.f, 0.f, 0.f}; }
#pragma unroll
        for (int ks = 0; ks < 8; ++ks) {
#pragma unroll
            for (int mf = 0; mf < 4; ++mf) { const bf16x8 af = lds_frag(lds, Y_OFF + ((16 * mf + r16) * YLD + 32 * ks + 8 * g4) * 2);
                acc[mf][0] = mfma16(af, bfr[ks][0], acc[mf][0]); acc[mf][1] = mfma16(af, bfr[ks][1], acc[mf][1]); }
        }
        bf16_t* yo = (bf16_t*)(P->ws + WS_Y);
#pragma unroll
        for (int nf = 0; nf < 2; ++nf) {
            const int n = 32 * wave + 16 * nf + r16;
            const float gn = P->in[I_GN_SSM][l * 256 + n];
#pragma unroll
            for (int mf = 0; mf < 4; ++mf)
#pragma unroll
                for (int rg = 0; rg < 4; ++rg) {
                    const int tok = 16 * mf + 4 * g4 + rg;
                    const float yv = bf2f(*(const LAS bf16_t*)(lds + Y_OFF + (tok * YLD + n) * 2));
                    const float o = yv * sigmoidf_(acc[mf][nf][rg]);
                    float ss = o * o;
                    ss += SHX(ss, 1); ss += SHX(ss, 2); ss += SHX(ss, 4); ss += SHX(ss, 8);
                    const float rs = rsqrtf(ss * (1.0f / 16.0f) + EPS);
                    yo[(size_t)(m0 + tok) * DM + n] = f2bf(o * rs * gn);
                }
        }
        }
    }
}

__device__ __forceinline__ float log_sigmoid(float x) { return x > 0.f ? -log1pf(expf(-x)) : x - log1pf(expf(x)); }

__device__ __forceinline__ void conv_silu16(const bf16_t* z, const float* convw  , int b, int t, int zcol, int ch0, float* out) {
#pragma unroll
    for (int i = 0; i < 16; ++i) out[i] = 0.f;
#pragma unroll
    for (int j = 0; j < 4; ++j) {
        const int ts = t - 3 + j;
        if (ts >= 0) {
            const bf16_t* src = z + (size_t)(b * SEQ + ts) * ZLD + zcol;
            const u32x4 w0 = *(const u32x4*)src, w1 = *(const u32x4*)(src + 8);
            float v[16]; unpack8(w0, v); unpack8(w1, v + 8);
            const float* cw = convw + j * 512 + ch0;
#pragma unroll
            for (int q = 0; q < 4; ++q) { const f32x4 c4 = *(const f32x4*)(cw + 4 * q);
#pragma unroll
                for (int e = 0; e < 4; ++e) out[4 * q + e] += v[4 * q + e] * c4[e]; }
        }
    }
#pragma unroll
    for (int i = 0; i < 16; ++i) out[i] = out[i] * sigmoidf_(out[i]);
}

__device__ __forceinline__ float wave_scan_add(float v, int lane) {
#pragma unroll
    for (int o = 1; o < 64; o <<= 1) { const float t = SHUP(v, o); if (lane >= o) v += t; }
    return v;
}
__device__ __forceinline__ float wave_scan_max(float v, int lane) {
#pragma unroll
    for (int o = 1; o < 64; o <<= 1) { const float t = SHUP(v, o); if (lane >= o) v = fmaxf(v, t); }
    return v;
}
__device__ __forceinline__ void mlstm_gates_w0(KP P, int l, int b, int hh, int c, LAS fal_t* G, int lane) {
    const float* gate = (const float*)(P->ws + WS_GATE);
    const int s0 = 2 * lane;
    const size_t m0 = (size_t)b * SEQ + c * 128 + s0;
    const float bi = P->in[I_B_I][l * 4 + hh], bfv = P->in[I_B_F][l * 4 + hh];
    const float ig0 = gate[m0 * 32 + hh] + bi, ig1 = gate[(m0 + 1) * 32 + hh] + bi;
    const float lf0 = log_sigmoid(gate[m0 * 32 + 4 + hh] + bfv), lf1 = log_sigmoid(gate[(m0 + 1) * 32 + 4 + hh] + bfv);
    const float sm = lf0 + lf1, incl = wave_scan_add(sm, lane), excl = incl - sm;
    const float b0 = excl + lf0, b1 = incl;
    const float d0 = ig0 - b0, d1 = ig1 - b1;
    const float inclm = wave_scan_max(fmaxf(d0, d1), lane);
    float exclm = SHUP(inclm, 1); if (lane == 0) exclm = NEGF;
    const float maxd = SHIDX(inclm, 63);
    G[s0] = ig0; G[s0 + 1] = ig1; G[128 + s0] = b0; G[128 + s0 + 1] = b1;
    G[256 + s0] = fmaxf(exclm, d0); G[256 + s0 + 1] = inclm;
    G[384 + s0] = __expf(d0 - maxd); G[384 + s0 + 1] = __expf(d1 - maxd);
    if (lane == 63) { G[512] = b1; G[513] = b1 + maxd; }
}

__device__ __forceinline__ void mlstm_stage1(KP P, int l, int item, ldsp lds, int tid, int wave, int lane) {
    const int c = item & 15, hh = (item >> 4) & 3, b = item >> 6;
    const bf16_t* z = (const bf16_t*)(P->ws + WS_Z);
    constexpr int KW_OFF = 0, VT_OFF = 17408, G_OFF = 39168, LD = 136;
    LAS fal_t* G = (LAS fal_t*)(lds + G_OFF);
    {
        const int s = tid >> 2, q4 = tid & 3, t = c * 128 + s;
        float kv[16];
        conv_silu16(z, P->in[I_CONV] + (size_t)l * 2048, b, t, ZC_MK + hh * 64 + 16 * q4, 256 + hh * 64 + 16 * q4, kv);
        const bf16_t* vs = z + (size_t)(b * SEQ + t) * ZLD + ZC_MV + hh * 64 + 16 * q4;
        const u32x4 w0 = *(const u32x4*)vs, w1 = *(const u32x4*)(vs + 8);
        {
            float qv[16];
            conv_silu16(z, P->in[I_CONV] + (size_t)l * 2048, b, t, ZC_MQ + hh * 64 + 16 * q4, hh * 64 + 16 * q4, qv);
            bf16_t* qk = (bf16_t*)(P->ws + WS_QKC) + ((size_t)b * SEQ + t) * 512 + hh * 64 + 16 * q4;
            *(bf16x8*)qk = pack8(qv); *(bf16x8*)(qk + 8) = pack8(qv + 8);
            float ks_[16];
#pragma unroll
            for (int i = 0; i < 16; ++i) ks_[i] = kv[i] * 0.125f;
            *(bf16x8*)(qk + 256) = pack8(ks_); *(bf16x8*)(qk + 256 + 8) = pack8(ks_ + 8);
        }
        for (int e = tid; e < 15 * 128; e += 512) *(LAS bf16_t*)(lds + VT_OFF + ((65 + e / 128) * LD + (e & 127)) * 2) = 0;
        if (tid < 128) *(LAS bf16_t*)(lds + VT_OFF + (64 * LD + tid) * 2) = 0x3f80;
        if (wave == 0) mlstm_gates_w0(P, l, b, hh, c, G, lane);
        __syncthreads();
        const float wk = G[384 + s] * 0.125f;
#pragma unroll
        for (int i = 0; i < 16; ++i) *(LAS bf16_t*)(lds + KW_OFF + ((16 * q4 + i) * LD + s) * 2) = f2bf(kv[i] * wk);
        const unsigned ww[8] = {w0.x, w0.y, w0.z, w0.w, w1.x, w1.y, w1.z, w1.w};
#pragma unroll
        for (int i = 0; i < 8; ++i) {
            *(LAS bf16_t*)(lds + VT_OFF + ((16 * q4 + 2 * i) * LD + s) * 2) = (bf16_t)(ww[i] & 0xffffu);
            *(LAS bf16_t*)(lds + VT_OFF + ((16 * q4 + 2 * i + 1) * LD + s) * 2) = (bf16_t)(ww[i] >> 16);
        }
    }
    __syncthreads();
    float* out = (float*)(P->ws + WS_MLC) + (size_t)item * MLC_STRIDE;
    {
        const int r16 = lane & 15, g4 = lane >> 4, mf = wave >> 1, nf0 = (wave & 1) * 2;
        f32x4 acc[2] = {(f32x4){0.f, 0.f, 0.f, 0.f}, (f32x4){0.f, 0.f, 0.f, 0.f}};
        f32x4 accn = (f32x4){0.f, 0.f, 0.f, 0.f};
#pragma unroll
        for (int ks = 0; ks < 4; ++ks) {
            const bf16x8 af = lds_frag(lds, KW_OFF + ((16 * mf + r16) * LD + 32 * ks + 8 * g4) * 2);
#pragma unroll
            for (int nfi = 0; nfi < 2; ++nfi) acc[nfi] = mfma16(af, lds_frag(lds, VT_OFF + ((16 * (nf0 + nfi) + r16) * LD + 32 * ks + 8 * g4) * 2), acc[nfi]);
            if ((wave & 1) == 0) accn = mfma16(af, lds_frag(lds, VT_OFF + ((64 + r16) * LD + 32 * ks + 8 * g4) * 2), accn);
        }
        if ((wave & 1) == 0 && r16 == 0) {
#pragma unroll
            for (int rg = 0; rg < 4; ++rg) out[4096 + 16 * mf + 4 * g4 + rg] = accn[rg];
        }
#pragma unroll
        for (int nfi = 0; nfi < 2; ++nfi)
#pragma unroll
            for (int rg = 0; rg < 4; ++rg) out[(16 * mf + 4 * g4 + rg) * 64 + 16 * (nf0 + nfi) + r16] = acc[nfi][rg];
    }
    if (tid == 0) { out[4160] = G[512]; out[4161] = G[513]; }
    if (tid < 128) {
        float* mg = (float*)(P->ws + WS_MLG) + (size_t)item * 384;
        mg[tid] = G[tid]; mg[128 + tid] = G[128 + tid]; mg[256 + tid] = G[256 + tid];
    }
}

__device__ __forceinline__ void mlstm_stage2(KP P, int l, int item, ldsp lds, int tid, int wave, int lane) {
    const int c = item & 15, hh = (item >> 4) & 3, b = item >> 6;
    const bf16_t* z = (const bf16_t*)(P->ws + WS_Z);
    constexpr int Q_OFF = 0, K_OFF = 18432, VT_OFF = 36864, CT_OFF = 58624, P_OFF = 70144, G_OFF = 104960, QLD = 72, VLD = 136;
    LAS fal_t* G = (LAS fal_t*)(lds + G_OFF);
    const float* mlc_base = (const float*)(P->ws + WS_MLC) + (size_t)(item - c) * MLC_STRIDE;
    unsigned short opre[4][4];
    {
        const int r16 = lane & 15, g4 = lane >> 4;
#pragma unroll
        for (int rg = 0; rg < 4; ++rg) { const size_t m = (size_t)b * SEQ + c * 128 + 16 * wave + 4 * g4 + rg;
#pragma unroll
            for (int nf = 0; nf < 4; ++nf) opre[rg][nf] = z[m * ZLD + ZC_MO + hh * 64 + 16 * nf + r16]; }
    }
    {
        const int s = tid >> 2, q4 = tid & 3, t = c * 128 + s;
        const bf16_t* qk = (const bf16_t*)(P->ws + WS_QKC) + ((size_t)b * SEQ + t) * 512 + hh * 64 + 16 * q4;
        const u32x4 q0 = *(const u32x4*)qk, q1 = *(const u32x4*)(qk + 8), k0 = *(const u32x4*)(qk + 256), k1 = *(const u32x4*)(qk + 256 + 8);
        *(LAS u32x4*)(lds + Q_OFF + (s * QLD + 16 * q4) * 2) = q0; *(LAS u32x4*)(lds + Q_OFF + (s * QLD + 16 * q4 + 8) * 2) = q1;
        *(LAS u32x4*)(lds + K_OFF + (s * QLD + 16 * q4) * 2) = k0; *(LAS u32x4*)(lds + K_OFF + (s * QLD + 16 * q4 + 8) * 2) = k1;
        const bf16_t* vs = z + (size_t)(b * SEQ + t) * ZLD + ZC_MV + hh * 64 + 16 * q4;
        const u32x4 w0 = *(const u32x4*)vs, w1 = *(const u32x4*)(vs + 8);
        const unsigned ww[8] = {w0.x, w0.y, w0.z, w0.w, w1.x, w1.y, w1.z, w1.w};
#pragma unroll
        for (int i = 0; i < 8; ++i) {
            *(LAS bf16_t*)(lds + VT_OFF + ((16 * q4 + 2 * i) * VLD + s) * 2) = (bf16_t)(ww[i] & 0xffffu);
            *(LAS bf16_t*)(lds + VT_OFF + ((16 * q4 + 2 * i + 1) * VLD + s) * 2) = (bf16_t)(ww[i] >> 16);
        }
        for (int e = tid; e < 15 * 64; e += 512) *(LAS bf16_t*)(lds + CT_OFF + ((65 + e / 64) * QLD + (e & 63)) * 2) = 0;
        for (int e = tid; e < 15 * 128; e += 512) *(LAS bf16_t*)(lds + VT_OFF + ((65 + e / 128) * VLD + (e & 127)) * 2) = 0;
        if (tid < 128) *(LAS bf16_t*)(lds + VT_OFF + (64 * VLD + tid) * 2) = 0x3f80;
    }
    if (tid < 128) {
        const float* mg = (const float*)(P->ws + WS_MLG) + (size_t)item * 384;
        G[tid] = mg[tid]; G[128 + tid] = mg[128 + tid]; G[256 + tid] = mg[256 + tid];
    }
    if (wave == 0) {
        const bool valid = lane < c;
        const float bLc = valid ? mlc_base[(size_t)lane * MLC_STRIDE + 4160] : 0.f;
        const float mlc = valid ? mlc_base[(size_t)lane * MLC_STRIDE + 4161] : NEGF;
        float suf = 0.f;
#pragma unroll
        for (int j = 1; j < 16; ++j) { const float v = SHIDX(bLc, j); if (j > lane) suf += v; }
        const float total = SHIDX(suf + bLc, 0);
        float e = valid ? mlc + suf : NEGF;
        float mx = e;
#pragma unroll
        for (int o = 1; o < 64; o <<= 1) mx = fmaxf(mx, SHX(mx, o));
        const float Mq = fmaxf(total, mx);
        if (lane < 16) G[520 + lane] = valid ? __expf(e - Mq) : 0.f;
        if (lane == 0) G[536] = Mq;
    }
    __syncthreads();
    const float Mp = G[536];
    {
        float Cv[8]; float nv = 0.f;
#pragma unroll
        for (int i = 0; i < 8; ++i) Cv[i] = 0.f;
#pragma unroll 4
        for (int cc = 0; cc < c; ++cc) {
            const float* src = mlc_base + (size_t)cc * MLC_STRIDE;
            const float w = G[520 + cc];
            const f32x4 a = *(const f32x4*)(src + tid * 8), bq = *(const f32x4*)(src + tid * 8 + 4);
#pragma unroll
            for (int e = 0; e < 4; ++e) { Cv[e] += w * a[e]; Cv[4 + e] += w * bq[e]; }
            if (tid < 64) nv += w * src[4096 + tid];
        }
        const int dk = tid >> 3, dv0 = (tid & 7) * 8;
#pragma unroll
        for (int i = 0; i < 8; ++i) *(LAS bf16_t*)(lds + CT_OFF + ((dv0 + i) * QLD + dk) * 2) = f2bf(Cv[i]);
        if (tid < 64) *(LAS bf16_t*)(lds + CT_OFF + (64 * QLD + tid) * 2) = f2bf(nv);
    }
    __syncthreads();
    if (lane < 16) { const int t_ = 16 * wave + lane; G[384 + t_] = G[128 + t_] + fmaxf(Mp, G[256 + t_]); }
    asm volatile("s_waitcnt lgkmcnt(0)" ::: "memory");
    {
        const int r16 = lane & 15, g4 = lane >> 4;
        const int PW = P_OFF + wave * 4352;
        bf16x8 qf[2];
#pragma unroll
        for (int ks = 0; ks < 2; ++ks) qf[ks] = lds_frag(lds, Q_OFF + ((16 * wave + r16) * QLD + 32 * ks + 8 * g4) * 2);
        f32x4 accO[5];
#pragma unroll
        for (int nf = 0; nf < 5; ++nf) { accO[nf] = (f32x4){0.f, 0.f, 0.f, 0.f};
#pragma unroll
            for (int ks = 0; ks < 2; ++ks) accO[nf] = mfma16(qf[ks], lds_frag(lds, CT_OFF + ((16 * nf + r16) * QLD + 32 * ks + 8 * g4) * 2), accO[nf]); }
        float bt[4], mt[4];
#pragma unroll
        for (int rg = 0; rg < 4; ++rg) { const int t = 16 * wave + 4 * g4 + rg; bt[rg] = G[128 + t]; mt[rg] = G[384 + t];
            const float wi = __expf(bt[rg] + Mp - mt[rg]);
#pragma unroll
            for (int nf = 0; nf < 5; ++nf) accO[nf][rg] *= wi; }
        const int nfmax = (wave | 1);
        for (int nf = 0; nf <= nfmax; ++nf) {
            f32x4 sacc = (f32x4){0.f, 0.f, 0.f, 0.f};
            if (nf <= wave) {
#pragma unroll
                for (int ks = 0; ks < 2; ++ks) sacc = mfma16(qf[ks], lds_frag(lds, K_OFF + ((16 * nf + r16) * QLD + 32 * ks + 8 * g4) * 2), sacc);
            }
            const int s = 16 * nf + r16;
            const float ds = G[s] - G[128 + s];
#pragma unroll
            for (int rg = 0; rg < 4; ++rg) {
                const int t = 16 * wave + 4 * g4 + rg;
                const float p = (s <= t) ? sacc[rg] * __expf(bt[rg] + ds - mt[rg]) : 0.f;
                *(LAS bf16_t*)(lds + PW + ((4 * g4 + rg) * VLD + s) * 2) = f2bf(p);
            }
        }
        for (int ks = 0; ks <= (wave >> 1); ++ks) {
            const bf16x8 pf = lds_frag(lds, PW + (r16 * VLD + 32 * ks + 8 * g4) * 2);
#pragma unroll
            for (int nf = 0; nf < 5; ++nf) accO[nf] = mfma16(pf, lds_frag(lds, VT_OFF + ((16 * nf + r16) * VLD + 32 * ks + 8 * g4) * 2), accO[nf]);
        }
        bf16_t* yo = (bf16_t*)(P->ws + WS_Y);
#pragma unroll
        for (int rg = 0; rg < 4; ++rg) {
            const int t = 16 * wave + 4 * g4 + rg;
            const size_t m = (size_t)b * SEQ + c * 128 + t;
            const float den = SHIDX(accO[4][rg], lane & 48);
            const float dn = fmaxf(fabsf(den), __expf(-mt[rg]));
            float o[4]; float ss = 0.f;
#pragma unroll
            for (int nf = 0; nf < 4; ++nf) {
                const float op = bf2f(opre[rg][nf]);
                o[nf] = sigmoidf_(op) * (accO[nf][rg] / dn);
                ss += o[nf] * o[nf];
            }
            ss += SHX(ss, 1); ss += SHX(ss, 2); ss += SHX(ss, 4); ss += SHX(ss, 8);
            const float rs = rsqrtf(ss * (1.0f / 64.0f) + EPS);
#pragma unroll
            for (int nf = 0; nf < 4; ++nf) yo[m * DM + 256 + hh * 64 + 16 * nf + r16] = f2bf(o[nf] * rs * P->in[I_GN_MLSTM][l * 256 + hh * 64 + 16 * nf + r16]);
        }
    }
}

__device__ __forceinline__ void compress_item(KP P, int l, int item, ldsp lds, int tid, int wave, int lane) {
    const int nt = item & 3, bg = (item >> 2) & 15, kv = item >> 6;
    const int b = bg >> 1, g = bg & 1, n0 = 32 * nt;
    const bf16_t* z = (const bf16_t*)(P->ws + WS_Z);
    constexpr int CK_OFF = 0, CLD = 72, H_OFF = 77824, HLD = 264;
#define CK_ADDR(tk_) (CK_OFF + (tk_) * (CLD * 2) + ((((tk_) >> 4) & 15) << 4) + (((tk_) >> 8) << 8))
    const float* rc = (const float*)(P->ws + WS_ROPE);
    {
        u32x4 w0[5], w1[5];
#pragma unroll
        for (int it = 0; it < 5; ++it) {
            const int e = tid + 512 * it, tk = e >> 2, q4 = e & 3, t = 16 * n0 + tk;
            w0[it] = (u32x4){0u, 0u, 0u, 0u}; w1[it] = (u32x4){0u, 0u, 0u, 0u};
            if (e < 528 * 4 && t < SEQ) {
                const bf16_t* src = z + ((size_t)b * SEQ + t) * ZLD + (kv ? ZC_CV : ZC_CK) + g * 64 + 16 * q4;
                w0[it] = *(const u32x4*)src; w1[it] = *(const u32x4*)(src + 8);
            }
        }
#pragma unroll
        for (int it = 0; it < 5; ++it) {
            const int e = tid + 512 * it, tk = e >> 2, q4 = e & 3;
            if (e < 528 * 4) { *(LAS u32x4*)(lds + CK_ADDR(tk) + 32 * q4) = w0[it]; *(LAS u32x4*)(lds + CK_ADDR(tk) + 32 * q4 + 16) = w1[it]; }
        }
    }
    if (kv == 0) {
        __syncthreads();
        for (int tk = tid; tk < 528; tk += 512) {
            const int t = 16 * n0 + tk;
            if (t < SEQ) {
                const size_t m = (size_t)b * SEQ + t;
                const f32x4 c0 = *(const f32x4*)(rc + m * 8), c1 = *(const f32x4*)(rc + m * 8 + 4);
                const f32x4 s0 = *(const f32x4*)(rc + (size_t)MTOK * 8 + m * 8), s1 = *(const f32x4*)(rc + (size_t)MTOK * 8 + m * 8 + 4);
                const u32x4 a0 = *(const LAS u32x4*)(lds + CK_ADDR(tk)), a1 = *(const LAS u32x4*)(lds + CK_ADDR(tk) + 16);
                float v[16]; unpack8(a0, v); unpack8(a1, v + 8);
                const float cs[8] = {c0[0], c0[1], c0[2], c0[3], c1[0], c1[1], c1[2], c1[3]}, sn[8] = {s0[0], s0[1], s0[2], s0[3], s1[0], s1[1], s1[2], s1[3]};
                float o[16];
#pragma unroll
                for (int i = 0; i < 8; ++i) { o[i] = v[i] * cs[i] - v[8 + i] * sn[i]; o[8 + i] = v[8 + i] * cs[i] + v[i] * sn[i]; }
                *(LAS bf16x8*)(lds + CK_ADDR(tk)) = pack8(o); *(LAS bf16x8*)(lds + CK_ADDR(tk) + 16) = pack8(o + 8);
            }
        }
    }
    const int r16 = lane & 15, g4 = lane >> 4;
    float bb[2];
    {
        const float* cb1 = (const float*)(P->ws + WS_CB1) + kv * 256;
#pragma unroll
        for (int nfi = 0; nfi < 2; ++nfi) { const int hid = 32 * wave + 16 * nfi + r16; float a = 0.f;
#pragma unroll
            for (int kc = 0; kc < 16; ++kc) a += cb1[kc * 512 + hid];
            bb[nfi] = a; }
    }
    __syncthreads();
    {
        const bf16_t* w1t = (const bf16_t*)(P->ws + (kv ? WS_CW1V : WS_CW1K));
        const bf16_t* wrow = w1t + (size_t)(32 * wave + r16) * 2048 + 8 * g4;
        f32x4 acc[2][2];
#pragma unroll
        for (int a = 0; a < 2; ++a) { acc[a][0] = (f32x4){0.f, 0.f, 0.f, 0.f}; acc[a][1] = (f32x4){0.f, 0.f, 0.f, 0.f}; }
        for (int k8 = 0; k8 < 8; ++k8) {
            bf16x8 bfr[8][2];
#pragma unroll
            for (int kk = 0; kk < 8; ++kk)
#pragma unroll
                for (int nfi = 0; nfi < 2; ++nfi) bfr[kk][nfi] = *(const bf16x8*)(wrow + (size_t)nfi * 16 * 2048 + 32 * (8 * k8 + kk));
#pragma unroll
            for (int kk = 0; kk < 8; ++kk) {
                const int ks = 8 * k8 + kk, tt = ks >> 1, dd = 32 * (ks & 1) + 8 * g4;
                bf16x8 af[2];
#pragma unroll
                for (int mf = 0; mf < 2; ++mf) { const int tk_ = 16 * (16 * mf + r16) + tt; af[mf] = lds_frag(lds, CK_ADDR(tk_) + dd * 2); }
#pragma unroll
                for (int mf = 0; mf < 2; ++mf)
#pragma unroll
                    for (int nfi = 0; nfi < 2; ++nfi) acc[mf][nfi] = mfma16(af[mf], bfr[kk][nfi], acc[mf][nfi]);
            }
        }
#pragma unroll
        for (int nfi = 0; nfi < 2; ++nfi) { const int hid = 32 * wave + 16 * nfi + r16;
#pragma unroll
            for (int mf = 0; mf < 2; ++mf)
#pragma unroll
                for (int rg = 0; rg < 4; ++rg) *(LAS bf16_t*)(lds + H_OFF + ((16 * mf + 4 * g4 + rg) * HLD + hid) * 2) = f2bf(gelu_tanh(acc[mf][nfi][rg] + bb[nfi])); }
    }
    __syncthreads();
    {
        const bf16_t* w2t = (const bf16_t*)(P->ws + (kv ? WS_CW2V : WS_CW2K));
        const int mf = wave >> 2, nf = wave & 3;
        f32x4 acc = (f32x4){0.f, 0.f, 0.f, 0.f};
#pragma unroll
        for (int ks = 0; ks < 8; ++ks)
            acc = mfma16(lds_frag(lds, H_OFF + ((16 * mf + r16) * HLD + 32 * ks + 8 * g4) * 2), *(const bf16x8*)(w2t + (size_t)(16 * nf + r16) * 256 + 32 * ks + 8 * g4), acc);
        bf16_t* dst = (bf16_t*)(P->ws + (kv ? WS_VCMP : WS_KCMP)) + (size_t)bg * 128 * 64;
#pragma unroll
        for (int rg = 0; rg < 4; ++rg) { const int n = n0 + 16 * mf + 4 * g4 + rg; dst[n * 64 + 16 * nf + r16] = (n < 127) ? f2bf(acc[rg]) : (bf16_t)0; }
    }
#undef CK_ADDR
}

__device__ __forceinline__ void rope_item(KP P, int item, int tid) {
    bf16_t* z = (bf16_t*)(P->ws + WS_Z);
    const float* rc = (const float*)(P->ws + WS_ROPE);
    for (int e = item * 4096 + tid; e < item * 4096 + 4096; e += 512) {
        const int m = e / 12, hsel = e % 12;
        const int col = hsel < 8 ? ZC_AQ + hsel * 64 : (hsel < 10 ? ZC_SK + (hsel - 8) * 64 : ZC_WK + (hsel - 10) * 64);
        bf16_t* src = z + (size_t)m * ZLD + col;
        const u32x4 w0 = *(const u32x4*)src, w1 = *(const u32x4*)(src + 8);
        float v[16]; unpack8(w0, v); unpack8(w1, v + 8);
        const f32x4 c0 = *(const f32x4*)(rc + (size_t)m * 8), c1 = *(const f32x4*)(rc + (size_t)m * 8 + 4);
        const f32x4 s0 = *(const f32x4*)(rc + (size_t)MTOK * 8 + (size_t)m * 8), s1 = *(const f32x4*)(rc + (size_t)MTOK * 8 + (size_t)m * 8 + 4);
        const float cs[8] = {c0[0], c0[1], c0[2], c0[3], c1[0], c1[1], c1[2], c1[3]}, sn[8] = {s0[0], s0[1], s0[2], s0[3], s1[0], s1[1], s1[2], s1[3]};
        float o[16];
#pragma unroll
        for (int i = 0; i < 8; ++i) { o[i] = v[i] * cs[i] - v[8 + i] * sn[i]; o[8 + i] = v[8 + i] * cs[i] + v[i] * sn[i]; }
        *(bf16x8*)src = pack8(o); *(bf16x8*)(src + 8) = pack8(o + 8);
    }
}

struct NsaCtx { int tq; unsigned selm; };
__device__ __forceinline__ void nsa_tile(ldsp lds, int ks_off, int vt_off, const int MMODE, const bf16x8 (&Qf)[2][2], f32x4 (&OB)[4][2], float (&mrun)[2], float (&lrun)[2], int tql, bool selbit, int r16, int g4) {
    constexpr int KLD = 72, VLD = 72;
    const int kbase = ks_off + (r16 * KLD + 8 * g4) * 2, vbase = vt_off + ((4 * g4 + (r16 >> 2)) * VLD + 4 * (r16 & 3)) * 2;
    f32x4 S[2][4];
#pragma unroll
    for (int kfi = 0; kfi < 4; ++kfi) {
        const bf16x8 k0 = lds_frag(lds, kbase + 16 * kfi * KLD * 2), k1 = lds_frag(lds, kbase + 16 * kfi * KLD * 2 + 64);
#pragma unroll
        for (int f = 0; f < 2; ++f) S[f][kfi] = mfma16(k1, Qf[f][1], mfma16(k0, Qf[f][0], (f32x4){0.f, 0.f, 0.f, 0.f}));
    }
    bf16x8 pb[2][2];
#pragma unroll
    for (int f = 0; f < 2; ++f) {
        if (MMODE == 1) {
#pragma unroll
            for (int kfi = 0; kfi < 4; ++kfi)
#pragma unroll
                for (int rg = 0; rg < 4; ++rg) S[f][kfi][rg] = (16 * kfi + 4 * g4 + rg <= tql) ? S[f][kfi][rg] : NEGF;
        } else if (MMODE == 2) {
#pragma unroll
            for (int kfi = 0; kfi < 4; ++kfi)
#pragma unroll
                for (int rg = 0; rg < 4; ++rg) S[f][kfi][rg] = (16 * kfi + 4 * g4 + rg > tql) ? S[f][kfi][rg] : NEGF;
        }
        float mx = fmaxf(fmaxf(S[f][0][0], S[f][0][1]), fmaxf(S[f][0][2], S[f][0][3]));
#pragma unroll
        for (int kfi = 1; kfi < 4; ++kfi) mx = fmaxf(mx, fmaxf(fmaxf(S[f][kfi][0], S[f][kfi][1]), fmaxf(S[f][kfi][2], S[f][kfi][3])));
        mx = selbit ? mx : NEGF;
        mx = xmax16_32(mx);
        const float mn = fmaxf(mrun[f], mx);
        const float alpha = __builtin_amdgcn_exp2f(mrun[f] - mn);
        const float msub = selbit ? fmaxf(mn, -1e28f) : 1e30f;
        float ls = 0.f;
#pragma unroll
        for (int kfi = 0; kfi < 4; ++kfi)
#pragma unroll
            for (int rg = 0; rg < 4; ++rg) { const float p = __builtin_amdgcn_exp2f(S[f][kfi][rg] - msub); S[f][kfi][rg] = p; ls += p; }
        lrun[f] = lrun[f] * alpha + ls; mrun[f] = mn;
        if (__builtin_amdgcn_ballot_w64(alpha != 1.0f) != 0ull) {
#pragma unroll
            for (int df = 0; df < 4; ++df) OB[df][f] *= alpha;
        }
#pragma unroll
        for (int k2 = 0; k2 < 2; ++k2) {
            const float pv[8] = {S[f][2 * k2][0], S[f][2 * k2][1], S[f][2 * k2][2], S[f][2 * k2][3], S[f][2 * k2 + 1][0], S[f][2 * k2 + 1][1], S[f][2 * k2 + 1][2], S[f][2 * k2 + 1][3]};
            pb[f][k2] = pack8(pv);
        }
    }
#pragma unroll
    for (int k2 = 0; k2 < 2; ++k2)
#pragma unroll
        for (int df = 0; df < 4; ++df) {
            const bf16x4 lo = lds_tr16(lds, vbase + 32 * k2 * VLD * 2 + 32 * df);
            const bf16x4 hi = lds_tr16(lds, vbase + (32 * k2 + 16) * VLD * 2 + 32 * df);
            const bf16x8 va = __builtin_shufflevector(lo, hi, 0, 1, 2, 3, 4, 5, 6, 7);
            OB[df][0] = mfma16(va, pb[0][k2], OB[df][0]);
            OB[df][1] = mfma16(va, pb[1][k2], OB[df][1]);
        }
}

__device__ __forceinline__ void nsa_load_tile(ldsp lds, const bf16_t* kbase, const bf16_t* vbase, size_t ld, int keyoff, int tid) {
    constexpr int KS_OFF = 0, VT_OFF = 18432, KLD = 72;
    const int key = tid >> 3, dc = tid & 7;
    const u32x4 kw = *(const u32x4*)(kbase + (size_t)key * ld + 8 * dc);
    const u32x4 vw = *(const u32x4*)(vbase + (size_t)key * ld + 8 * dc);
    *(LAS u32x4*)(lds + KS_OFF + ((keyoff + key) * KLD + 8 * dc) * 2) = kw;
    *(LAS u32x4*)(lds + VT_OFF + ((keyoff + key) * KLD + 8 * dc) * 2) = vw;
}

__device__ __forceinline__ void nsa_item(KP P, int l, int item, ldsp lds, int tid, int wave, int lane) {
    const int qt = 31 - (item >> 4), bg = item & 15, b = bg >> 1, g = bg & 1;
    const int T0 = 64 * qt;
    const bf16_t* z = (const bf16_t*)(P->ws + WS_Z);
    const float* gate = (const float*)(P->ws + WS_GATE);
    constexpr int KS_OFF = 0, VT_OFF = 18432, KLD = 72, VLD = 72, IMP_OFF = 36864, SEL_OFF = 53248, OR_OFF = 53504;
    constexpr float SC2 = 0.125f * 1.4426950408889634f;
    const int r16 = lane & 15, g4 = lane >> 4;
    const int tq = T0 + 8 * wave + (r16 & 7);
    const size_t mq = (size_t)b * SEQ + tq;
    int hd[2]; hd[0] = 4 * g + (r16 >> 3); hd[1] = 4 * g + 2 + (r16 >> 3);
    bf16x8 Qf[2][2];
#pragma unroll
    for (int f = 0; f < 2; ++f)
#pragma unroll
        for (int ks = 0; ks < 2; ++ks) { const u32x4 qw = *(const u32x4*)(z + mq * ZLD + ZC_AQ + hd[f] * 64 + 32 * ks + 8 * g4);
            float qv[8]; unpack8(qw, qv);
#pragma unroll
            for (int e = 0; e < 8; ++e) qv[e] *= SC2;
            Qf[f][ks] = pack8(qv); }
    float gt[2][3];
#pragma unroll
    for (int f = 0; f < 2; ++f)
#pragma unroll
        for (int br = 0; br < 3; ++br) gt[f][br] = sigmoidf_(gate[mq * 32 + 8 + hd[f] * 3 + br]);
    unsigned long long tt0_ = 0; if (TIMEK >= 8 && TIMEK <= 10) tt0_ = __builtin_amdgcn_s_memrealtime();
#define NSA_TSTAMP(k) do { if (TIMEK >= 8 && TIMEK <= 10) { const unsigned long long n_ = __builtin_amdgcn_s_memrealtime(); if (TIMEK == (k) && tid == 0) atomicAdd((unsigned long long*)(P->ws + WS_CTL) + 1000, n_ - tt0_); tt0_ = n_; } } while (0)
    f32x4 OF[4][2], OB[4][2];
    if (tid == 0) *(LAS ual_t*)(lds + OR_OFF) = 0u;
    {
        const bf16_t* kc = (const bf16_t*)(P->ws + WS_KCMP) + (size_t)bg * 128 * 64;
        const bf16_t* vc = (const bf16_t*)(P->ws + WS_VCMP) + (size_t)bg * 128 * 64;
        nsa_load_tile(lds, kc, vc, 64, 0, tid);
        nsa_load_tile(lds, kc + 64 * 64, vc + 64 * 64, 64, 64, tid);
        __syncthreads();
        float pa[8], pc[8];
#pragma unroll
        for (int kf = 0; kf < 8; ++kf) { pa[kf] = 0.f; pc[kf] = 0.f; }
#pragma unroll
        for (int f = 0; f < 2; ++f) {
            __builtin_amdgcn_sched_barrier(0);
            f32x4 S[8];
#pragma unroll
            for (int kf = 0; kf < 8; ++kf) { S[kf] = (f32x4){0.f, 0.f, 0.f, 0.f};
#pragma unroll
                for (int ks = 0; ks < 2; ++ks) S[kf] = mfma16(lds_frag(lds, KS_OFF + ((16 * kf + r16) * KLD + 32 * ks + 8 * g4) * 2), Qf[f][ks], S[kf]);
                if ((kf & 1) == 1) __builtin_amdgcn_sched_barrier(0); }
            float mx = NEGF;
#pragma unroll
            for (int kf = 0; kf < 8; ++kf)
#pragma unroll
                for (int rg = 0; rg < 4; ++rg) { const int n = 16 * kf + 4 * g4 + rg; const bool v = (16 * n + 31 <= tq); const float s = v ? S[kf][rg] : NEGF; S[kf][rg] = s; mx = fmaxf(mx, s); }
            mx = fmaxf(mx, SHX(mx, 16)); mx = fmaxf(mx, SHX(mx, 32));
            float ls = 0.f;
#pragma unroll
            for (int kf = 0; kf < 8; ++kf)
#pragma unroll
                for (int rg = 0; rg < 4; ++rg) { const int n = 16 * kf + 4 * g4 + rg; const bool v = (16 * n + 31 <= tq); const float p = v ? __builtin_amdgcn_exp2f(S[kf][rg] - mx) : 0.f; S[kf][rg] = p; ls += p; }
            ls += SHX(ls, 16); ls += SHX(ls, 32);
            const float inv = ls > 0.f ? 1.0f / ls : 0.f;
#pragma unroll
            for (int kf = 0; kf < 8; ++kf) { S[kf] *= inv; pa[kf] += 2.0f * (S[kf][0] + S[kf][1] + S[kf][2]) + S[kf][3]; pc[kf] += S[kf][3]; }
            __builtin_amdgcn_sched_barrier(0);
#pragma unroll
            for (int df = 0; df < 4; ++df) OB[df][f] = (f32x4){0.f, 0.f, 0.f, 0.f};
#pragma unroll
            for (int k2 = 0; k2 < 4; ++k2) {
                const float pv[8] = {S[2 * k2][0], S[2 * k2][1], S[2 * k2][2], S[2 * k2][3], S[2 * k2 + 1][0], S[2 * k2 + 1][1], S[2 * k2 + 1][2], S[2 * k2 + 1][3]};
                const bf16x8 pb = pack8(pv);
#pragma unroll
                for (int df = 0; df < 4; ++df) {
                    const int vb_ = VT_OFF + ((4 * g4 + (r16 >> 2)) * VLD + 4 * (r16 & 3)) * 2;
                    const bf16x4 lo = lds_tr16(lds, vb_ + 32 * k2 * VLD * 2 + 32 * df);
                    const bf16x4 hi = lds_tr16(lds, vb_ + (32 * k2 + 16) * VLD * 2 + 32 * df);
                    OB[df][f] = mfma16(__builtin_shufflevector(lo, hi, 0, 1, 2, 3, 4, 5, 6, 7), pb, OB[df][f]);
                }
            }
#pragma unroll
            for (int df = 0; df < 4; ++df) OF[df][f] = OB[df][f] * gt[f][0];
        }
        LAS fal_t* impA = (LAS fal_t*)(lds + IMP_OFF + wave * 2048);
        LAS fal_t* impB = impA + 256;
#pragma unroll
        for (int kf = 0; kf < 8; ++kf) {
            const float va_ = pa[kf] + SHX(pa[kf], 8), vc_ = pc[kf] + SHX(pc[kf], 8);
            if (r16 < 8) {
                const int j = 4 * kf + g4;
                impA[r16 * 32 + j] = va_;
                if (j < 31) impB[r16 * 32 + j + 1] = vc_;
                if (j == 0) impB[r16 * 32] = 0.f;
            }
        }
        {
            const int tk = lane & 7, jg = lane >> 3;
            const int tt = T0 + 8 * wave + tk, jcur = tt >> 6;
            float myv[4];
#pragma unroll
            for (int i = 0; i < 4; ++i) { const int j = 4 * jg + i; float v = impA[tk * 32 + j] + impB[tk * 32 + j];
                if (j == 0 || j == jcur) v = 1e4f; else if (j > jcur) v = -1e4f; myv[i] = v; }
            asm volatile("s_waitcnt lgkmcnt(0)" ::: "memory");
#pragma unroll
            for (int i = 0; i < 4; ++i) impA[tk * 32 + 4 * jg + i] = myv[i];
            asm volatile("s_waitcnt lgkmcnt(0)" ::: "memory");
            int cnt[4] = {0, 0, 0, 0};
            for (int j2 = 0; j2 < 32; ++j2) { const float v2 = impA[tk * 32 + j2];
#pragma unroll
                for (int i = 0; i < 4; ++i) { const int j = 4 * jg + i; cnt[i] += (v2 > myv[i] || (v2 == myv[i] && j2 < j)) ? 1 : 0; } }
            unsigned bits = 0u;
#pragma unroll
            for (int i = 0; i < 4; ++i) { const int j = 4 * jg + i; if (cnt[i] < 8 && j <= jcur) bits |= (1u << j); }
            bits |= SHX(bits, 8); bits |= SHX(bits, 16); bits |= SHX(bits, 32);
            if (lane < 8) { *(LAS ual_t*)(lds + SEL_OFF + (wave * 8 + lane) * 4) = bits; __hip_atomic_fetch_or((LAS ual_t*)(lds + OR_OFF), bits, __ATOMIC_RELAXED, __HIP_MEMORY_SCOPE_WORKGROUP); }
        }
    }
    __syncthreads();
    NSA_TSTAMP(8);
    const unsigned selm = *(const LAS ual_t*)(lds + SEL_OFF + (wave * 8 + (r16 & 7)) * 4);
    {
        constexpr int TL_OFF = 53760, TILE_OFF = 54272, TKLD = 72;
        const unsigned selor = *(const LAS ual_t*)(lds + OR_OFF) & (qt >= 31 ? 0xffffffffu : ((2u << qt) - 1u));
        const int nsel = __builtin_popcount(selor), wj0 = (qt >= 4 ? qt - 4 : 0), nwin = qt - wj0 + 1, ntl = nsel + nwin;
        if (tid < 32) { if ((selor >> tid) & 1u) *(LAS ual_t*)(lds + TL_OFF + __builtin_popcount(selor & ((1u << tid) - 1u)) * 4) = 0x100u | (unsigned)tid; }
        else if (tid < 32 + nwin) *(LAS ual_t*)(lds + TL_OFF + (nsel + tid - 32) * 4) = 0x200u | (unsigned)(wj0 + tid - 32);
        __syncthreads();
        const int key = tid >> 3, dc = tid & 7;
        const bf16_t* zrow = z + ((size_t)b * SEQ + key) * ZLD + g * 64 + 8 * dc;
        u32x4 kw0, vw0, kw1, vw1;
#define NSA_TILE_LOAD(ti, KW, VW) do { const unsigned d_ = *(const LAS ual_t*)(lds + TL_OFF + (ti) * 4); const bf16_t* p_ = zrow + (size_t)(64 * (int)(d_ & 0xffu)) * ZLD + ((d_ >> 8) == 1u ? ZC_SK : ZC_WK); \
        KW = *(const u32x4*)p_; VW = *(const u32x4*)(p_ + 128); } while (0)
#define NSA_TILE_WRITE(bufi, KW, VW) do { const int ko_ = TILE_OFF + (bufi) * 18432; *(LAS u32x4*)(lds + ko_ + (key * TKLD + 8 * dc) * 2) = KW; \
        *(LAS u32x4*)(lds + ko_ + 9216 + (key * TKLD + 8 * dc) * 2) = VW; } while (0)
        NSA_TILE_LOAD(0, kw0, vw0);
        NSA_TILE_WRITE(0, kw0, vw0);
        if (ntl > 1) NSA_TILE_LOAD(1, kw1, vw1);
        if (ntl > 2) NSA_TILE_LOAD(2, kw0, vw0);
        __syncthreads();
        float mrun[2] = {NEGF, NEGF}, lrun[2] = {0.f, 0.f};
#pragma unroll
        for (int f = 0; f < 2; ++f)
#pragma unroll
            for (int df = 0; df < 4; ++df) OB[df][f] = (f32x4){0.f, 0.f, 0.f, 0.f};
        unsigned pmode = 1u;
#define NSA_ITER(i, KW, VW) do { \
            if ((i) + 1 < ntl) NSA_TILE_WRITE(((i) + 1) & 1, KW, VW); \
            if ((i) + 3 < ntl) NSA_TILE_LOAD((i) + 3, KW, VW); \
            const unsigned d = *(const LAS ual_t*)(lds + TL_OFF + (i) * 4); \
            const unsigned mode = d >> 8; const int j = (int)(d & 0xffu); \
            if (mode != pmode) { \
                _Pragma("unroll") for (int f = 0; f < 2; ++f) { const float sc = gt[f][1] / xsum16_32(lrun[f]); \
                    _Pragma("unroll") for (int df = 0; df < 4; ++df) { OF[df][f] += OB[df][f] * sc; OB[df][f] = (f32x4){0.f, 0.f, 0.f, 0.f}; } \
                    mrun[f] = NEGF; lrun[f] = 0.f; } \
                pmode = mode; \
            } \
            const int ko = TILE_OFF + ((i) & 1) * 18432; \
            const int mmode = (j == qt) ? 1 : ((mode == 2u && j == qt - 4) ? 2 : 0); \
            const bool selbit = mode == 1u ? (((selm >> j) & 1u) != 0u) : true; \
            if (__builtin_amdgcn_ballot_w64(selbit) != 0ull) nsa_tile(lds, ko, ko + 9216, mmode, Qf, OB, mrun, lrun, tq - T0, selbit, r16, g4); \
            __syncthreads(); } while (0)
        for (int i = 0; i < ntl; i += 2) {
            NSA_ITER(i, kw1, vw1);
            if (i + 1 < ntl) NSA_ITER(i + 1, kw0, vw0);
        }
#pragma unroll
        for (int f = 0; f < 2; ++f) { const float sc = gt[f][2] / xsum16_32(lrun[f]);
#pragma unroll
            for (int df = 0; df < 4; ++df) OF[df][f] += OB[df][f] * sc; }
#undef NSA_ITER
#undef NSA_TILE_LOAD
#undef NSA_TILE_WRITE
    }
    NSA_TSTAMP(9);
    {
        bf16_t* yo = (bf16_t*)(P->ws + WS_Y);
#pragma unroll
        for (int f = 0; f < 2; ++f) {
            float ss = 0.f;
#pragma unroll
            for (int df = 0; df < 4; ++df)
#pragma unroll
                for (int rg = 0; rg < 4; ++rg) ss += OF[df][f][rg] * OF[df][f][rg];
            ss += SHX(ss, 16); ss += SHX(ss, 32);
            const float rs = rsqrtf(ss * (1.0f / 64.0f) + EPS);
#pragma unroll
            for (int df = 0; df < 4; ++df) {
                const f32x4 gn = *(const f32x4*)(P->in[I_GN_NSA] + l * 512 + hd[f] * 64 + 16 * df + 4 * g4);
                const f32x4 o = OF[df][f] * rs * gn;
                u32x2 w; w.x = cvt_pk_bf16(o[0], o[1]); w.y = cvt_pk_bf16(o[2], o[3]);
                *(u32x2*)(yo + mq * DM + 512 + hd[f] * 64 + 16 * df + 4 * g4) = w;
            }
        }
    }
}

__device__ __forceinline__ int lane_id_hw() { return (int)__builtin_amdgcn_mbcnt_hi(~0u, __builtin_amdgcn_mbcnt_lo(~0u, 0u)); }
#define TID0_EXPR ((wave0_ << 6) | lane_id_hw())
#define XB_TMO      128
#define XB_XCNT(j)  (256  + 64 * (j))
#define XB_XSUB(j)  (1280 + 64 * (j))
#define XB_XGEN(j)  (2304 + 64 * (j))
#define XB_TOP      3328
#define XB_TOPGEN   3392
#define XCD_BAR_WORDS 3456
#define XB_SPIN_CAP (1u << 22)
__device__ __forceinline__ unsigned xb_ld(unsigned* p)              { return __hip_atomic_load(p, __ATOMIC_RELAXED, __HIP_MEMORY_SCOPE_AGENT); }
__device__ __forceinline__ unsigned xb_add(unsigned* p, unsigned v) { return __hip_atomic_fetch_add(p, v, __ATOMIC_RELAXED, __HIP_MEMORY_SCOPE_AGENT); }
__device__ __forceinline__ unsigned xb_xcc_id() { return (unsigned)__builtin_amdgcn_s_getreg((3 << 11) | 20) & 0xFu; }
#define XB_SPIN(cond, bar) do { unsigned _sp = 0; while (cond) { __builtin_amdgcn_s_sleep(1); \
    if ((++_sp & 255u) == 0u) { if (xb_ld(&(bar)[XB_TMO])) break; if (_sp > XB_SPIN_CAP) { atomicAdd(&(bar)[XB_TMO], 1u); break; } } } } while (0)
struct XcdBarrier { unsigned* bar; unsigned x; volatile LAS ual_t* st; };
__device__ __forceinline__ XcdBarrier xcd_barrier_post(unsigned* bar, volatile LAS ual_t* st, const int wave0_) {
    XcdBarrier b; b.bar = bar; b.x = xb_xcc_id(); b.st = st;
    if (TID0_EXPR == 0) (void)xb_add(&bar[XB_XCNT(b.x)], 1u);
    return b;
}
__device__ __forceinline__ void xcd_barrier_complete(unsigned* bar, unsigned x, unsigned& nloc, unsigned& nx) {
    const unsigned G = gridDim.x * gridDim.y * gridDim.z;
    unsigned sum, cnt, mine, sp = 0u;
    for (;;) {
        sum = 0u; cnt = 0u; mine = 0u;
#pragma unroll
        for (unsigned j = 0; j < 16; ++j) { const unsigned c = xb_ld(&bar[XB_XCNT(j)]); sum += c; cnt += (c > 0u) ? 1u : 0u; mine = (j == x) ? c : mine; }
        if (sum == G) break;
        __builtin_amdgcn_s_sleep(1);
        if ((++sp & 255u) == 0u) { if (xb_ld(&bar[XB_TMO])) break; if (sp > XB_SPIN_CAP) { atomicAdd(&bar[XB_TMO], 1u); break; } }
    }
    nloc = mine > 0u ? mine : 1u; nx = cnt > 0u ? cnt : 1u;
}
__device__ __forceinline__ void xcd_barrier(const XcdBarrier& b, const int wave0_) {
    asm volatile("s_waitcnt vmcnt(0)" ::: "memory");
    __syncthreads();
    if (TID0_EXPR == 0) {
        unsigned* bar = b.bar;
        __builtin_amdgcn_s_waitcnt(0);
        unsigned nloc = b.st[0], nx = b.st[1];
        if (nloc == 0u) { xcd_barrier_complete(bar, b.x, nloc, nx); b.st[0] = nloc; b.st[1] = nx; }
        const unsigned old = xb_add(&bar[XB_XSUB(b.x)], 1u);
        const unsigned gen = old / nloc;
        if (old + 1u == (gen + 1u) * nloc) {
            __builtin_amdgcn_fence(__ATOMIC_RELEASE, "agent");
            asm volatile("s_waitcnt vmcnt(0)" ::: "memory");
            const unsigned og = xb_add(&bar[XB_TOP], 1u);
            const unsigned tg = og / nx;
            if (og + 1u == (tg + 1u) * nx) xb_add(&bar[XB_TOPGEN], 1u);
            else XB_SPIN(xb_ld(&bar[XB_TOPGEN]) == tg, bar);
            __builtin_amdgcn_fence(__ATOMIC_ACQUIRE, "agent");
            xb_add(&bar[XB_XGEN(b.x)], 1u);
            asm volatile("s_waitcnt vmcnt(0)" ::: "memory");
        } else {
            XB_SPIN(xb_ld(&bar[XB_XGEN(b.x)]) == gen, bar);
            __builtin_amdgcn_fence(__ATOMIC_ACQUIRE, "agent");
            asm volatile("s_waitcnt vmcnt(0)" ::: "memory");
        }
    }
    __syncthreads();
}

__device__ __forceinline__ int p2_static(int bx, int k) {
    if (bx < 128) { return k == 0 ? bx : (k == 1 ? 128 + bx : (k == 2 ? 640 + bx : -1)); }
    const int j = bx - 128;
    if (k < 3) return 128 + 128 + 3 * j + k;
    if (k < 6) return 640 + 128 + 3 * j + (k - 3);
    if (k == 6 && j < 48) return 1152 + j;
    return -1;
}
__device__ __forceinline__ int p3_static(int bx, int k) {
    switch (k) {
        case 0: return bx;
        case 1: return ((31 - (bx >> 4)) << 4) | (bx & 15);
        case 2: return 512 + bx;
        case 3: return 512 + 256 + bx;
        case 4: return 1024 + bx;
        default: return -1;
    }
}
#ifndef EN_MASK
#define EN_MASK 0xFFFF
#endif
#define EN(b) (((EN_MASK) >> (b)) & 1)
#ifndef DUP
#define DUP 0
#endif
#define NREP(k) ((DUP) == (k) ? 2 : 1)
__global__ void __launch_bounds__(512, 2) hybrid_fwd(Params P_unused) {
    KP P = (KP)__builtin_amdgcn_kernarg_segment_ptr();
    extern __shared__ __attribute__((aligned(16))) unsigned char lds_raw[];
    ldsp lds = (ldsp)lds_raw;
    const int wave0_ = __builtin_amdgcn_readfirstlane((int)threadIdx.x >> 6);
#define tid0 TID0_EXPR
    volatile LAS ual_t* misc = (volatile LAS ual_t*)(lds + MISC_OFF);
    if (tid0 < 16) misc[tid0] = 0u;
    __syncthreads();
    (void)xcd_barrier_post((unsigned*)(P->ws + WS_CTL) + 4096, misc + 8, wave0_);
#define GRID_SYNC() do { asm volatile("" : "+s"(P)); XcdBarrier xb_; xb_.bar = (unsigned*)(P->ws + WS_CTL) + 4096; xb_.x = xb_xcc_id(); xb_.st = (volatile LAS ual_t*)(lds + MISC_OFF) + 8; xcd_barrier(xb_, wave0_); } while (0)
#define PHASE_BEGIN() asm volatile("" : "+s"(P)); int tid = tid0; asm volatile("" : "+v"(tid)); const int lane = tid & 63, wave = __builtin_amdgcn_readfirstlane(tid >> 6); \
    const int G = gridDim.x, gw = blockIdx.x * 8 + wave, NGW = G * 8; unsigned char* ws = P->ws; (void)lane; (void)gw; (void)NGW; (void)ws; (void)G

    {
        PHASE_BEGIN();
        if (EN(0)) { const bool hb = P->hb16 != 0; norm_pass(P->in[I_X], nullptr, nullptr, P->in[I_LN_MIX_PRE], nullptr, hb ? (bf16_t*)(ws + WS_H16) : nullptr, hb ? nullptr : P->out, (bf16_t*)(ws + WS_U), gw, NGW, lane); }
        if (EN(1)) {
            const int* pos = (const int*)P->in[I_POS];
            float* rc = (float*)(ws + WS_ROPE);
            for (int e = blockIdx.x * 512 + tid; e < MTOK * 8; e += G * 512) {
                const int m = e >> 3, j = e & 7;
                const float inv = powf(500000.0f, -(float)j * 0.125f);
                const float ang = (float)pos[m] * inv;
                rc[e] = cosf(ang); rc[(size_t)MTOK * 8 + e] = sinf(ang);
            }
        }
        if (EN(2)) convert_layer(P, 0, lds, gw, NGW, wave, lane);
    }
    GRID_SYNC();

    for (int l = 0; l < DEPTH; ++l) {
        for (int rep = 0; rep < NREP(1); ++rep) {
            PHASE_BEGIN();
            pg8::Gemm g{(const bf16_t*)(ws + WS_U), (const bf16_t*)(ws + WS_WIN), MTOK, ZLD, DM}; pg8::StaticOrder S; S.init(MTOK, ZLD, G, (int)blockIdx.x);
            pg8::EpiBf16<0> E{(bf16_t*)(ws + WS_Z), ZLD, (float*)(ws + WS_GATE), 10};
            pg8::gemm_phase<pg8::EpiBf16<0>, pg8::StaticOrder, true, true>(lds, g, S, E, tid);
            GRID_SYNC();
        }
        for (int rep = 0; rep < ((DUP) / 10 == 2 || (DUP) == 2 ? 2 : 1); ++rep) {
            constexpr int N_CMP = 128, N_ML = 512, N_S5 = 512, N_ROPE = 48, NTOT = N_CMP + N_ML + N_S5 + N_ROPE;
            for (int kstep = 0;; ++kstep) {
                __syncthreads();
                int item;
                if (gridDim.x == 256) item = p2_static((int)blockIdx.x, kstep);
                else { if (tid0 == 0) misc[0] = atomicAdd((unsigned*)(P->ws + WS_CTL) + 64 * (2 * l) + 1024 * rep, 1u); __syncthreads(); item = (int)misc[0]; if (item >= NTOT) item = -1; }
                PHASE_BEGIN();
                if (item < 0) break;
                if (item < N_CMP) { { unsigned long long t0_ = 0; if (TIMEK == 1) t0_ = __builtin_amdgcn_s_memrealtime(); if (EN(4) && (rep == 0 || DUP == 2 || DUP == 21)) compress_item(P, l, item, lds, tid, wave, lane); if (TIMEK == 1) { __syncthreads(); if (tid0 == 0) atomicAdd((unsigned long long*)(P->ws + WS_CTL) + 1000, __builtin_amdgcn_s_memrealtime() - t0_); } } continue; } item -= N_CMP;
                if (item < N_ML) { { unsigned long long t0_ = 0; if (TIMEK == 2) t0_ = __builtin_amdgcn_s_memrealtime(); if (EN(5) && (rep == 0 || DUP == 2 || DUP == 22)) mlstm_stage1(P, l, item, lds, tid, wave, lane); if (TIMEK == 2) { __syncthreads(); if (tid0 == 0) atomicAdd((unsigned long long*)(P->ws + WS_CTL) + 1000, __builtin_amdgcn_s_memrealtime() - t0_); } } continue; } item -= N_ML;
                if (item < N_S5) { { unsigned long long t0_ = 0; if (TIMEK == 3) t0_ = __builtin_amdgcn_s_memrealtime(); if (EN(6) && (rep == 0 || DUP == 2 || DUP == 23)) s5_stage1(P, l, item, lds, wave, lane); if (TIMEK == 3) { __syncthreads(); if (tid0 == 0) atomicAdd((unsigned long long*)(P->ws + WS_CTL) + 1000, __builtin_amdgcn_s_memrealtime() - t0_); } } continue; } item -= N_S5;
                { unsigned long long t0_ = 0; if (TIMEK == 4) t0_ = __builtin_amdgcn_s_memrealtime(); if (EN(7) && rep == 0) rope_item(P, item, tid); if (TIMEK == 4) { __syncthreads(); if (tid0 == 0) atomicAdd((unsigned long long*)(P->ws + WS_CTL) + 1000, __builtin_amdgcn_s_memrealtime() - t0_); } }
            }
            GRID_SYNC();
        }
        for (int rep = 0; rep < ((DUP) / 10 == 3 || (DUP) == 3 ? 2 : 1); ++rep) {
            constexpr int N_NSA = 512, N_ML = 512, N_S5 = 256, NTOT = N_NSA + N_ML + N_S5;
            for (int kstep = 0;; ++kstep) {
                __syncthreads();
                int item;
                if (gridDim.x == 256) item = p3_static((int)blockIdx.x, kstep);
                else { if (tid0 == 0) misc[0] = atomicAdd((unsigned*)(P->ws + WS_CTL) + 64 * (2 * l + 1) + 1024 * rep, 1u); __syncthreads(); item = (int)misc[0]; if (item >= NTOT) item = -1; }
                PHASE_BEGIN();
                if (item < 0) break;
                if (item < N_NSA) { { unsigned long long t0_ = 0; if (TIMEK == 5) t0_ = __builtin_amdgcn_s_memrealtime(); if (EN(8) && (rep == 0 || DUP == 3 || DUP == 31)) nsa_item(P, l, item, lds, tid, wave, lane); if (TIMEK == 5) { __syncthreads(); if (tid0 == 0) atomicAdd((unsigned long long*)(P->ws + WS_CTL) + 1000, __builtin_amdgcn_s_memrealtime() - t0_); } } continue; } item -= N_NSA;
                if (item < N_ML) { { unsigned long long t0_ = 0; if (TIMEK == 6) t0_ = __builtin_amdgcn_s_memrealtime(); if (EN(9) && (rep == 0 || DUP == 3 || DUP == 32)) mlstm_stage2(P, l, item, lds, tid, wave, lane); if (TIMEK == 6) { __syncthreads(); if (tid0 == 0) atomicAdd((unsigned long long*)(P->ws + WS_CTL) + 1000, __builtin_amdgcn_s_memrealtime() - t0_); } } continue; } item -= N_ML;
                { unsigned long long t0_ = 0; if (TIMEK == 7) t0_ = __builtin_amdgcn_s_memrealtime(); if (EN(10) && (rep == 0 || DUP == 3 || DUP == 33)) s5_stage2(P, l, item, lds, wave, lane); if (TIMEK == 7) { __syncthreads(); if (tid0 == 0) atomicAdd((unsigned long long*)(P->ws + WS_CTL) + 1000, __builtin_amdgcn_s_memrealtime() - t0_); } }
            }
            GRID_SYNC();
        }
        for (int rep = 0; rep < NREP(4); ++rep) {
            PHASE_BEGIN();
            pg8::Gemm g{(const bf16_t*)(ws + WS_Y), (const bf16_t*)(ws + WS_WOUT), MTOK, DM, DM}; pg8::StaticOrder S; S.init(MTOK, DM, G, (int)blockIdx.x);
            pg8::EpiBf16<0> E{(bf16_t*)(ws + WS_Z), DM, nullptr, -1};
            pg8::gemm_phase<pg8::EpiBf16<0>, pg8::StaticOrder, true, true>(lds, g, S, E, tid);
            GRID_SYNC();
        }
        if (EN(12)) {
            PHASE_BEGIN();
            const bool hb = P->hb16 != 0;
            norm_pass(nullptr, (const bf16_t*)(ws + WS_Z), P->in[I_LN_MIX_POST] + l * DM, P->in[I_LN_MLP_PRE] + l * DM, P->out, hb ? (bf16_t*)(ws + WS_H16) : nullptr, hb ? nullptr : P->out, (bf16_t*)(ws + WS_U), gw, NGW, lane);
        }
        GRID_SYNC();
        for (int rep = 0; rep < NREP(6); ++rep) {
            PHASE_BEGIN();
            pg8::Gemm g{(const bf16_t*)(ws + WS_U), (const bf16_t*)(ws + WS_W1), MTOK, DFF, DM}; pg8::StaticOrder S; S.init(MTOK, DFF, G, (int)blockIdx.x);
            pg8::EpiBf16<2> E{(bf16_t*)(ws + WS_Z), DFF, nullptr, -1};
            pg8::gemm_phase<pg8::EpiBf16<2>, pg8::StaticOrder, true, true>(lds, g, S, E, tid);
            GRID_SYNC();
        }
        for (int rep = 0; rep < NREP(7); ++rep) {
            PHASE_BEGIN();
            pg8::Gemm g{(const bf16_t*)(ws + WS_Z), (const bf16_t*)(ws + WS_W2), MTOK, DM, DFF}; pg8::StaticOrder S; S.init(MTOK, DM, G, (int)blockIdx.x);
            pg8::EpiBf16<0> E{(bf16_t*)(ws + WS_Y), DM, nullptr, -1};
            pg8::gemm_phase<pg8::EpiBf16<0>, pg8::StaticOrder, true, true>(lds, g, S, E, tid);
            GRID_SYNC();
        }
        {
            PHASE_BEGIN();
            if (EN(15)) { const bool hb = P->hb16 != 0, last = (l + 1 == DEPTH);
                norm_pass(nullptr, (const bf16_t*)(ws + WS_Y), P->in[I_LN_MLP_POST] + l * DM, last ? nullptr : P->in[I_LN_MIX_PRE] + (l + 1) * DM, P->out, hb ? (bf16_t*)(ws + WS_H16) : nullptr, (hb && !last) ? nullptr : P->out, (bf16_t*)(ws + WS_U), gw, NGW, lane); }
            if (l + 1 < DEPTH) { for (int rep = 0; rep < NREP(8); ++rep) convert_layer(P, l + 1, lds, gw, NGW, wave, lane); }
        }
        if (l + 1 < DEPTH) GRID_SYNC();
    }
    if (TIMEK != 0) {
        GRID_SYNC();
        if (blockIdx.x == 0 && tid0 == 0) { const unsigned long long tot = __hip_atomic_load((unsigned long long*)(P->ws + WS_CTL) + 1000, __ATOMIC_RELAXED, __HIP_MEMORY_SCOPE_AGENT) / 256ull;
            const unsigned long long t0_ = __builtin_amdgcn_s_memrealtime(); while (__builtin_amdgcn_s_memrealtime() - t0_ < tot) __builtin_amdgcn_s_sleep(8); }
    }
}

extern "C" void kernel_launch(void* const* d_in, const int* in_sizes, int n_in, void* d_out, int out_size, void* d_ws, size_t ws_size, hipStream_t stream) {
    static int grid = 0;
    if (grid == 0) {
        if (n_in != 31 || out_size != MTOK * DM || ws_size < WS_END) { fprintf(stderr, "kernel_launch: unexpected shapes (n_in %d out %d ws %zu)\n", n_in, out_size, ws_size); grid = -1; return; }
        int dev = 0, cus = 0, per_cu = 0;
        (void)hipGetDevice(&dev);
        (void)hipDeviceGetAttribute(&cus, hipDeviceAttributeMultiprocessorCount, dev);
        (void)hipFuncSetAttribute((const void*)hybrid_fwd, hipFuncAttributeMaxDynamicSharedMemorySize, LDS_BYTES);
        (void)hipOccupancyMaxActiveBlocksPerMultiprocessor(&per_cu, (const void*)hybrid_fwd, 512, LDS_BYTES);
        if (per_cu < 1) { fprintf(stderr, "kernel_launch: occupancy query says %d blocks/CU\n", per_cu); per_cu = 1; }
        grid = cus * 1;
        (void)hipGetLastError();
    }
    if (grid < 0) return;
    (void)hipMemsetAsync((char*)d_ws + WS_CTL, 0, 65536, stream);
    Params p{};
    for (int i = 0; i < 31; ++i) p.in[i] = (const float*)d_in[i];
    p.out = (float*)d_out; p.ws = (unsigned char*)d_ws; p.hb16 = (ws_size >= WS_END_H16) ? 1 : 0;
    void* args[] = {&p};
    hipError_t e = hipLaunchCooperativeKernel((const void*)hybrid_fwd, dim3(grid), dim3(512), args, LDS_BYTES, stream);
    if (e != hipSuccess) fprintf(stderr, "cooperative launch failed: %s (grid %d)\n", hipGetErrorString(e), grid);
}
```

```cpp
#include <hip/hip_runtime.h>
#include <hip/hip_cooperative_groups.h>
#include <cstdio>
#include <cstdint>
namespace cg = cooperative_groups;

#define LAS __attribute__((address_space(3)))
typedef unsigned short __attribute__((may_alias)) bf16_t;
typedef short bf16x8 __attribute__((ext_vector_type(8), may_alias));
typedef short bf16x4 __attribute__((ext_vector_type(4), may_alias));
typedef float f32x4 __attribute__((ext_vector_type(4), may_alias));
typedef float f32x2 __attribute__((ext_vector_type(2), may_alias));
typedef unsigned u32x4 __attribute__((ext_vector_type(4), may_alias));
typedef unsigned u32x2 __attribute__((ext_vector_type(2), may_alias));
typedef float __attribute__((may_alias)) fal_t;
typedef unsigned __attribute__((may_alias)) ual_t;
typedef LAS unsigned char* ldsp;

constexpr int NB = 8, SEQ = 2048, MTOK = NB * SEQ, DM = 1024, DEPTH = 4, DIN = 2592, ZLD = 2816, DFF = 4096;
constexpr int ZC_SU = 0, ZC_MQ = 256, ZC_MK = 512, ZC_MV = 768, ZC_MO = 1024, ZC_AQ = 1280, ZC_CK = 1792, ZC_CV = 1920,
              ZC_SK = 2048, ZC_SV = 2176, ZC_WK = 2304, ZC_WV = 2432, ZC_G = 2560;
constexpr float EPS = 1e-6f;
constexpr float NEGF = -1e30f;

constexpr size_t MiB = 1u << 20;
constexpr size_t WS_CTL = 0;
constexpr size_t WS_WIN = 1 * MiB;
constexpr size_t WS_WOUT = 7 * MiB;
constexpr size_t WS_W1 = 9 * MiB;
constexpr size_t WS_W2 = 17 * MiB;
constexpr size_t WS_WGLU = 25 * MiB;
constexpr size_t WS_CW1K = 25 * MiB + 256 * 1024;
constexpr size_t WS_CW1V = 26 * MiB + 256 * 1024;
constexpr size_t WS_CW2K = 27 * MiB + 256 * 1024;
constexpr size_t WS_CW2V = 27 * MiB + 320 * 1024;
constexpr size_t WS_CB1 = 27 * MiB + 384 * 1024;
constexpr size_t WS_ROPE = 28 * MiB;
constexpr size_t WS_GATE = 29 * MiB;
constexpr size_t WS_S5E = 31 * MiB;
constexpr size_t WS_MLC = 33 * MiB;
constexpr size_t WS_KCMP = 42 * MiB;
constexpr size_t WS_VCMP = 42 * MiB + 512 * 1024;
constexpr size_t WS_S5T = 42 * MiB + 256 * 1024;
constexpr size_t WS_MLG = 41 * MiB + 256 * 1024;
constexpr size_t WS_U = 43 * MiB;
constexpr size_t WS_Y = 75 * MiB;
constexpr size_t WS_Z = 107 * MiB;
constexpr size_t WS_QKC = WS_Z + 88 * MiB;
constexpr size_t WS_END = 235 * MiB;
constexpr size_t WS_H16 = 235 * MiB;
constexpr size_t WS_END_H16 = 267 * MiB;
constexpr int MLC_STRIDE = 4224;

#ifndef PROBE
#define PROBE 0
#endif
#ifndef TIMEK
#define TIMEK 0
#endif
#define REPN(k) ((PROBE) == (k) ? 3 : 1)
__device__ __forceinline__ float bf2f(unsigned short v) { return __uint_as_float(((unsigned)v) << 16); }
__device__ __forceinline__ unsigned cvt_pk_bf16(float lo, float hi) { unsigned r; asm volatile("v_cvt_pk_bf16_f32 %0, %1, %2" : "=v"(r) : "v"(lo), "v"(hi)); return r; }
__device__ __forceinline__ unsigned short f2bf(float f) { return (unsigned short)(cvt_pk_bf16(f, 0.f) & 0xffffu); }
typedef short v4i16_t __attribute__((ext_vector_type(4)));
__device__ __forceinline__ bf16x4 lds_tr16(ldsp lds, int byteoff) { return __builtin_bit_cast(bf16x4, __builtin_amdgcn_ds_read_tr16_b64_v4i16((LAS v4i16_t*)(lds + byteoff))); }
__device__ __forceinline__ float xmax16_32(float v) {
    auto a = __builtin_amdgcn_permlane16_swap(__float_as_uint(v), __float_as_uint(v), false, false);
    v = fmaxf(__uint_as_float(a[0]), __uint_as_float(a[1]));
    auto b = __builtin_amdgcn_permlane32_swap(__float_as_uint(v), __float_as_uint(v), false, false);
    return fmaxf(__uint_as_float(b[0]), __uint_as_float(b[1]));
}
__device__ __forceinline__ float xsum16_32(float v) {
    auto a = __builtin_amdgcn_permlane16_swap(__float_as_uint(v), __float_as_uint(v), false, false);
    v = __uint_as_float(a[0]) + __uint_as_float(a[1]);
    auto b = __builtin_amdgcn_permlane32_swap(__float_as_uint(v), __float_as_uint(v), false, false);
    return __uint_as_float(b[0]) + __uint_as_float(b[1]);
}
template <class T> __device__ __forceinline__ T bperm_(T v, int srclane) { return __builtin_bit_cast(T, __builtin_amdgcn_ds_bpermute(srclane << 2, __builtin_bit_cast(int, v))); }
#define SHX(v, o) bperm_((v), lane ^ (o))
#define SHUP(v, o) bperm_((v), (lane >= (o)) ? lane - (o) : lane)
#define SHIDX(v, src) bperm_((v), (src))
__device__ __forceinline__ float wave_sum(float v, int lane) {
#pragma unroll
    for (int o = 1; o < 64; o <<= 1) v += SHX(v, o);
    return v;
}
__device__ __forceinline__ float sigmoidf_(float x) { return 1.0f / (1.0f + __expf(-x)); }
__device__ __forceinline__ float gelu_tanh(float x) {
    const float a = 0.7978845608028654f * (x + 0.044715f * x * x * x);
    const float e = __expf(2.0f * a);
    const float t = 1.0f - 2.0f / (e + 1.0f);
    return 0.5f * x * (1.0f + t);
}
__device__ __forceinline__ f32x4 mfma16(bf16x8 a, bf16x8 b, f32x4 c) { return __builtin_amdgcn_mfma_f32_16x16x32_bf16(a, b, c, 0, 0, 0); }
__device__ __forceinline__ bf16x8 lds_frag(ldsp lds, int byteoff) { return *(const LAS bf16x8*)(lds + byteoff); }
__device__ __forceinline__ bf16x8 pack8(const float* v) {
    u32x4 w; w.x = cvt_pk_bf16(v[0], v[1]); w.y = cvt_pk_bf16(v[2], v[3]); w.z = cvt_pk_bf16(v[4], v[5]); w.w = cvt_pk_bf16(v[6], v[7]);
    return __builtin_bit_cast(bf16x8, w);
}
__device__ __forceinline__ void unpack8(u32x4 w, float* v) {
    v[0] = __uint_as_float(w.x << 16); v[1] = __uint_as_float(w.x & 0xffff0000u);
    v[2] = __uint_as_float(w.y << 16); v[3] = __uint_as_float(w.y & 0xffff0000u);
    v[4] = __uint_as_float(w.z << 16); v[5] = __uint_as_float(w.z & 0xffff0000u);
    v[6] = __uint_as_float(w.w << 16); v[7] = __uint_as_float(w.w & 0xffff0000u);
}

namespace pg8 {
#define PG8_LAS __attribute__((address_space(3)))
constexpr int BM = 256, BK = 64, HALF = 128, HTB = HALF * BK * 2, STAGE_BYTES = 8 * HTB, NXCD = 8, WGM = 8;
__host__ __device__ __forceinline__ int lds_byte(int r, int c) { const int st = (r >> 4) * 2 + (c >> 5), rr = r & 15, cc = c & 31, ob = rr * 64 + cc * 2; return st * 1024 + (ob ^ (((ob >> 9) & 1) << 5)); }
__host__ __device__ __forceinline__ void stage_rc(int b, int& R, int& C) { const int st = b / 1024, sb = b % 1024, swz = sb ^ (((sb >> 9) & 1) << 5); R = (st >> 1) * 16 + swz / 64; C = (st & 1) * 32 + (swz % 64) / 2; }
__host__ __device__ __forceinline__ int perm32(int rho) { const int n = rho >> 4, i = rho & 15; return 8 * (i >> 2) + 4 * n + (i & 3); }
struct Unit { int pm, pn; };
struct Gemm { const bf16_t* A; const bf16_t* Bt; int M, N, K; };
struct StaticOrder {
    int nM, nN, nwg, G, c;
    __host__ __device__ void init(int M, int N, int G_, int c_) { nM = M / BM; nN = N / BM; nwg = nM * nN; G = G_; c = c_; }
    __host__ __device__ bool next(int i, Unit& u) const {
        const long L = (long)i * G + c; if (L >= nwg) return false;
        int wgid = (int)L; { const int q = nwg / NXCD, r = nwg % NXCD, xcd = wgid % NXCD, off = wgid / NXCD; wgid = (xcd < r ? xcd * (q + 1) : r * (q + 1) + (xcd - r) * q) + off; }
        const int nig = WGM * nN, gid = wgid / nig, fm = gid * WGM, gsz = (nM - fm) < WGM ? (nM - fm) : WGM;
        u.pm = fm + ((wgid % nig) % gsz); u.pn = (wgid % nig) / gsz; return true;
    }
    __device__ __forceinline__ void a_ready(const Unit&) const {}
    __device__ __forceinline__ void done(const Unit&) const {}
};
template <int ACT  > struct EpiBf16 {
    static constexpr bool PERM = true, AFTER_DRAIN = false;
    bf16_t* O; int ldc; float* gate; int gate_pn;
    __device__ __forceinline__ void operator()(const f32x4 (&acc)[2][2][4][2], const Unit& u, int wr, int wc, int fr, int fq) const {
        const int row0 = u.pm * BM + wr * 64 + fr;
        if (u.pn == gate_pn) {
            if (wc == 0) {
#pragma unroll
                for (int ai = 0; ai < 2; ++ai)
#pragma unroll
                    for (int m = 0; m < 4; ++m) { float* gp = gate + (size_t)(row0 + ai * HALF + m * 16) * 32 + 8 * fq;
                        *(f32x4*)(gp) = acc[ai][0][m][0]; *(f32x4*)(gp + 4) = acc[ai][0][m][1]; }
            }
            return;
        }
        const int col0 = u.pn * BM + wc * 32 + 8 * fq;
#pragma unroll
        for (int ai = 0; ai < 2; ++ai)
#pragma unroll
            for (int m = 0; m < 4; ++m) { bf16_t* rowp = O + (size_t)(row0 + ai * HALF + m * 16) * ldc + col0;
#pragma unroll
                for (int bj = 0; bj < 2; ++bj) { f32x4 v0 = acc[ai][bj][m][0], v1 = acc[ai][bj][m][1];
                    if (ACT == 2) {
#pragma unroll
                        for (int e = 0; e < 4; ++e) { float a = fmaxf(v0[e], 0.f); v0[e] = a * a; float b = fmaxf(v1[e], 0.f); v1[e] = b * b; }
                    }
                    u32x4 w; w.x = cvt_pk_bf16(v0[0], v0[1]); w.y = cvt_pk_bf16(v0[2], v0[3]); w.z = cvt_pk_bf16(v1[0], v1[1]); w.w = cvt_pk_bf16(v1[2], v1[3]);
                    *(u32x4*)(rowp + bj * HALF) = w; } }
    }
};

template <class Epi, class Sched, bool ALIGN_EPI = false, bool SP2 = false>
__device__ __forceinline__ void gemm_phase(PG8_LAS unsigned char* lds, const Gemm g, const Sched& S, const Epi& E, const int tid) {
    const int wid = __builtin_amdgcn_readfirstlane(tid >> 6), lane = tid & 63, wr = wid >> 2, wc = wid & 3, fr = lane & 15, fq = lane >> 4;
    const int K = g.K, nt = K / BK;
    unsigned voffA[2], voffB[2];
#pragma unroll
    for (int i = 0; i < 2; ++i) { int R, C; stage_rc(tid * 16 + i * 8192, R, C); const int Rb = Epi::PERM ? ((R & ~31) + perm32(R & 31)) : R;
        voffA[i] = (unsigned)(R * K + C) * 2u; voffB[i] = (unsigned)(Rb * K + C) * 2u; }
    const size_t kstep = (size_t)(BK * 2);
    const size_t hstep = (size_t)HALF * K * 2;
    const size_t tstep = 2 * hstep;
    const unsigned ldsw = (unsigned)wid * 1024u;
    const int aoff = lds_byte(wr * 64 + fr, fq * 8), boff = lds_byte(wc * 32 + fr, fq * 8);
#define PG8_SA(b, h) (((b) * 2 + (h)) * HTB)
#define PG8_SB(b, h) ((4 + (b) * 2 + (h)) * HTB)
#define PG8_STAGE(bufoff, gbase, voff) do { _Pragma("unroll") for (int _i = 0; _i < 2; ++_i) \
        __builtin_amdgcn_global_load_lds((const unsigned*)((const char*)(gbase) + (voff)[_i]), (PG8_LAS ual_t*)(lds + (bufoff) + ldsw + _i * 8192), 16, 0, 0); } while (0)
#define PG8_LDA(dst, b, h) do { _Pragma("unroll") for (int m = 0; m < 4; ++m) _Pragma("unroll") for (int k = 0; k < 2; ++k) dst[m][k] = *(const PG8_LAS bf16x8*)(lds + PG8_SA(b, h) + aoff + m * 2048 + k * 1024); } while (0)
#define PG8_LDB(dst, b, h) do { _Pragma("unroll") for (int n = 0; n < 2; ++n) _Pragma("unroll") for (int k = 0; k < 2; ++k) dst[n][k] = *(const PG8_LAS bf16x8*)(lds + PG8_SB(b, h) + boff + n * 2048 + k * 1024); } while (0)
#define PG8_MMA(ai, bj, At, Bt) do { __builtin_amdgcn_s_setprio(1); _Pragma("unroll") for (int m = 0; m < 4; ++m) _Pragma("unroll") for (int n = 0; n < 2; ++n) _Pragma("unroll") for (int k = 0; k < 2; ++k) \
        acc[ai][bj][m][n] = __builtin_amdgcn_mfma_f32_16x16x32_bf16(Bt[n][k], At[m][k], acc[ai][bj][m][n], 0, 0, 0); __builtin_amdgcn_s_setprio(0); } while (0)
#define PG8_WAIT_V(n) asm volatile("s_waitcnt vmcnt(" #n ")" ::: "memory")
#define PG8_WAIT_L(n) asm volatile("s_waitcnt lgkmcnt(" #n ")" ::: "memory")
#define PG8_BAR __builtin_amdgcn_s_barrier()
#define PG8_SCHED __builtin_amdgcn_sched_barrier(0)
    Unit cur, nxt; int ui = 0;
    if (!S.next(0, cur)) return;
    f32x4 acc[2][2][4][2];
#pragma unroll
    for (int a = 0; a < 2; ++a)
#pragma unroll
        for (int b = 0; b < 2; ++b)
#pragma unroll
            for (int m = 0; m < 4; ++m)
#pragma unroll
                for (int n = 0; n < 2; ++n) acc[a][b][m][n] = (f32x4){0.f, 0.f, 0.f, 0.f};
    bf16x8 At[4][2], B0[2][2], B1[2][2];
    const char* cA = (const char*)g.A + (size_t)cur.pm * tstep; const char* cB = (const char*)g.Bt + (size_t)cur.pn * tstep;
    S.a_ready(cur);
    if constexpr (SP2) {
        PG8_STAGE(PG8_SB(0, 0), cB, voffB); PG8_STAGE(PG8_SB(0, 1), cB + hstep, voffB); PG8_STAGE(PG8_SA(0, 0), cA, voffA); PG8_STAGE(PG8_SA(0, 1), cA + hstep, voffA);
        if (wr == 1) PG8_BAR;
        PG8_WAIT_V(2); PG8_BAR;
        PG8_STAGE(PG8_SB(1, 0), cB + kstep, voffB); PG8_STAGE(PG8_SA(1, 0), cA + kstep, voffA); PG8_STAGE(PG8_SB(1, 1), cB + hstep + kstep, voffB);
        PG8_WAIT_V(6); PG8_BAR;
    } else {
        PG8_STAGE(PG8_SB(0, 0), cB, voffB); PG8_STAGE(PG8_SA(0, 0), cA, voffA); PG8_STAGE(PG8_SB(0, 1), cB + hstep, voffB); PG8_STAGE(PG8_SA(0, 1), cA + hstep, voffA);
        if (wr == 1) PG8_BAR;
        PG8_WAIT_V(4); PG8_BAR;
        PG8_STAGE(PG8_SB(1, 0), cB + kstep, voffB); PG8_STAGE(PG8_SA(1, 0), cA + kstep, voffA); PG8_STAGE(PG8_SB(1, 1), cB + hstep + kstep, voffB);
        PG8_WAIT_V(6); PG8_BAR;
    }
    for (;;) {
        const bool has_next = S.next(ui + 1, nxt);
        const char* nA = has_next ? (const char*)g.A + (size_t)nxt.pm * tstep : cA; const char* nB = has_next ? (const char*)g.Bt + (size_t)nxt.pn * tstep : cB;
        for (int t = 0; t < nt; t += 2) {
            const bool last = (t == nt - 2);
            const char* a1 = cA + (size_t)(t + 1) * kstep;
            const char* a2 = last ? nA : cA + (size_t)(t + 2) * kstep; const char* b2 = last ? nB : cB + (size_t)(t + 2) * kstep;
            const char* a3 = a2 + kstep; const char* b3 = b2 + kstep;
            if (last && has_next) S.a_ready(nxt);
            if constexpr (SP2) {
            PG8_LDB(B0, 0, 0); PG8_LDB(B1, 0, 1); PG8_SCHED; PG8_LDA(At, 0, 0); PG8_STAGE(PG8_SA(1, 1), a1 + hstep, voffA);
            PG8_WAIT_V(8); PG8_WAIT_L(0); PG8_BAR; PG8_MMA(0, 0, At, B0); PG8_MMA(0, 1, At, B1); PG8_BAR; PG8_SCHED;
            PG8_LDA(At, 0, 1); PG8_STAGE(PG8_SB(0, 0), b2, voffB); PG8_STAGE(PG8_SB(0, 1), b2 + hstep, voffB); PG8_STAGE(PG8_SA(0, 0), a2, voffA);
            PG8_WAIT_V(8); PG8_WAIT_L(0); PG8_BAR; PG8_MMA(1, 0, At, B0); PG8_MMA(1, 1, At, B1); PG8_BAR; PG8_SCHED;
            PG8_LDB(B0, 1, 0); PG8_LDB(B1, 1, 1); PG8_SCHED; PG8_LDA(At, 1, 0); PG8_STAGE(PG8_SA(0, 1), a2 + hstep, voffA);
            PG8_WAIT_V(8); PG8_WAIT_L(0); PG8_BAR; PG8_MMA(0, 0, At, B0); PG8_MMA(0, 1, At, B1); PG8_BAR; PG8_SCHED;
            PG8_LDA(At, 1, 1); PG8_STAGE(PG8_SB(1, 0), b3, voffB); PG8_STAGE(PG8_SB(1, 1), b3 + hstep, voffB); PG8_STAGE(PG8_SA(1, 0), a3, voffA);
            PG8_WAIT_V(8); PG8_WAIT_L(0); PG8_BAR; PG8_MMA(1, 0, At, B0); PG8_MMA(1, 1, At, B1); PG8_BAR; PG8_SCHED;
            } else {
            PG8_LDB(B0, 0, 0); PG8_SCHED; PG8_LDA(At, 0, 0); PG8_STAGE(PG8_SA(1, 1), a1 + hstep, voffA);
            PG8_WAIT_L(8); PG8_BAR; PG8_WAIT_L(0); PG8_MMA(0, 0, At, B0); PG8_BAR; PG8_SCHED;
            PG8_LDB(B1, 0, 1); PG8_STAGE(PG8_SB(0, 0), b2, voffB);
            PG8_BAR; PG8_WAIT_L(0); PG8_MMA(0, 1, At, B1); PG8_BAR;
            PG8_LDA(At, 0, 1); PG8_STAGE(PG8_SA(0, 0), a2, voffA);
            PG8_BAR; PG8_WAIT_L(0); PG8_MMA(1, 0, At, B0); PG8_BAR; PG8_SCHED;
            PG8_STAGE(PG8_SB(0, 1), b2 + hstep, voffB);
            PG8_WAIT_V(6); PG8_BAR; PG8_MMA(1, 1, At, B1); PG8_BAR;
            PG8_LDB(B0, 1, 0); PG8_SCHED; PG8_LDA(At, 1, 0); PG8_STAGE(PG8_SA(0, 1), a2 + hstep, voffA);
            PG8_WAIT_L(8); PG8_BAR; PG8_WAIT_L(0); PG8_MMA(0, 0, At, B0); PG8_BAR; PG8_SCHED;
            PG8_LDB(B1, 1, 1); PG8_STAGE(PG8_SB(1, 0), b3, voffB);
            PG8_BAR; PG8_WAIT_L(0); PG8_MMA(0, 1, At, B1); PG8_BAR;
            PG8_LDA(At, 1, 1); PG8_STAGE(PG8_SA(1, 0), a3, voffA);
            PG8_BAR; PG8_WAIT_L(0); PG8_MMA(1, 0, At, B0); PG8_BAR; PG8_SCHED;
            PG8_STAGE(PG8_SB(1, 1), b3 + hstep, voffB);
            PG8_WAIT_V(6); PG8_BAR; PG8_MMA(1, 1, At, B1); PG8_BAR;
            }
        }
        if constexpr (ALIGN_EPI) { if (wr == 0) PG8_BAR; }
        if constexpr (!Epi::AFTER_DRAIN) { E(acc, cur, wr, wc, fr, fq); S.done(cur); }
        if (!has_next) break;
#pragma unroll
        for (int a = 0; a < 2; ++a)
#pragma unroll
            for (int b = 0; b < 2; ++b)
#pragma unroll
                for (int m = 0; m < 4; ++m)
#pragma unroll
                    for (int n = 0; n < 2; ++n) acc[a][b][m][n] = (f32x4){0.f, 0.f, 0.f, 0.f};
        cur = nxt; cA = nA; cB = nB; ++ui;
        if constexpr (ALIGN_EPI) { if (wr == 1) PG8_BAR; }
    }
    PG8_WAIT_V(0);
    if constexpr (!ALIGN_EPI) { if (wr == 0) PG8_BAR; }
    PG8_BAR;
#undef PG8_SA
#undef PG8_SB
#undef PG8_STAGE
#undef PG8_LDA
#undef PG8_LDB
#undef PG8_MMA
#undef PG8_WAIT_V
#undef PG8_WAIT_L
#undef PG8_BAR
#undef PG8_SCHED
}
}

struct Params {
    const float* in[31];
    float* out;
    unsigned char* ws;
    int hb16;
    int pad;
};
typedef const __attribute__((address_space(4))) Params* KP;
enum { I_X = 0, I_POS, I_LN_MIX_PRE, I_LN_MIX_POST, I_LN_MLP_PRE, I_LN_MLP_POST, I_W_IN, I_W_OUT, I_LAM_RE, I_LAM_IM, I_B_RE, I_B_IM, I_C_RE, I_C_IM,
       I_SSM_D, I_LOG_DT, I_W_GLU, I_CONV, I_B_I, I_B_F, I_PE_K, I_W1_K, I_W2_K, I_PE_V, I_W1_V, I_W2_V, I_GN_SSM, I_GN_MLSTM, I_GN_NSA, I_MLP_W1, I_MLP_W2 };

constexpr int LDS_BYTES = 147456;
constexpr int MISC_OFF = 131072 + 8192;

__device__ __forceinline__ int win_src_col(int n) {
    if (n < 1280) return n;
    if (n < 2560) return n + 8;
    if (n < 2568) return n - 2560 + 1280;
    if (n < 2592) return n;
    return -1;
}
__device__ __forceinline__ void conv_item(const float* W, int K, int N, bf16_t* WT, int mode, int nblk, LAS fal_t* scr, int item, int lane) {
    const int kb = item / nblk, nb = item % nblk, k0 = 64 * kb, n0 = 64 * nb;
    const int nn = n0 + lane;
    const int sc = mode ? win_src_col(nn) : nn;
    const float* src = W + (size_t)k0 * N + (sc >= 0 ? sc : 0);
    float vv[64];
#pragma unroll
    for (int kk = 0; kk < 64; ++kk) vv[kk] = src[(size_t)kk * N];
#pragma unroll
    for (int kk = 0; kk < 64; ++kk) scr[kk * 65 + lane] = (sc >= 0) ? vv[kk] : 0.f;
    asm volatile("s_waitcnt lgkmcnt(0)" ::: "memory");
    const int c = lane & 7;
#pragma unroll
    for (int j = 0; j < 8; ++j) { const int n = (lane >> 3) + 8 * j; const LAS fal_t* sp = scr + (8 * c) * 65 + n;
        u32x4 o; o.x = cvt_pk_bf16(sp[0 * 65], sp[1 * 65]); o.y = cvt_pk_bf16(sp[2 * 65], sp[3 * 65]); o.z = cvt_pk_bf16(sp[4 * 65], sp[5 * 65]); o.w = cvt_pk_bf16(sp[6 * 65], sp[7 * 65]);
        *(u32x4*)(WT + (size_t)(n0 + n) * K + k0 + 8 * c) = o; }
    asm volatile("s_waitcnt lgkmcnt(0)" ::: "memory");
}

__device__ __forceinline__ void convert_layer(KP P, int l, ldsp lds, int gw, int NGW, int wave, int lane) {
    LAS fal_t* scr = (LAS fal_t*)(lds + wave * 16640);
    unsigned char* ws = P->ws;
    constexpr int I0 = 16 * 44, I1 = 16 * 16, I2 = 16 * 64, I3 = 64 * 16, I4 = 4 * 4, I5 = 32 * 4, I6 = 32 * 4, I7 = 4 * 1, I8 = 4 * 1, I9 = 128, I10 = 16;
    constexpr int NIT = I0 + I1 + I2 + I3 + I4 + I5 + I6 + I7 + I8 + I9 + I10;
    for (int it = gw; it < NIT; it += NGW) {
        int r = it;
        if (r < I0) { conv_item(P->in[I_W_IN] + (size_t)l * DM * DIN, DM, DIN, (bf16_t*)(ws + WS_WIN), 1, 44, scr, r, lane); continue; } r -= I0;
        if (r < I1) { conv_item(P->in[I_W_OUT] + (size_t)l * DM * DM, DM, DM, (bf16_t*)(ws + WS_WOUT), 0, 16, scr, r, lane); continue; } r -= I1;
        if (r < I2) { conv_item(P->in[I_MLP_W1] + (size_t)l * DM * DFF, DM, DFF, (bf16_t*)(ws + WS_W1), 0, 64, scr, r, lane); continue; } r -= I2;
        if (r < I3) { conv_item(P->in[I_MLP_W2] + (size_t)l * DFF * DM, DFF, DM, (bf16_t*)(ws + WS_W2), 0, 16, scr, r, lane); continue; } r -= I3;
        if (r < I4) { conv_item(P->in[I_W_GLU] + (size_t)l * 256 * 256, 256, 256, (bf16_t*)(ws + WS_WGLU), 0, 4, scr, r, lane); continue; } r -= I4;
        if (r < I5) { conv_item(P->in[I_W1_K] + (size_t)l * 2048 * 256, 2048, 256, (bf16_t*)(ws + WS_CW1K), 0, 4, scr, r, lane); continue; } r -= I5;
        if (r < I6) { conv_item(P->in[I_W1_V] + (size_t)l * 2048 * 256, 2048, 256, (bf16_t*)(ws + WS_CW1V), 0, 4, scr, r, lane); continue; } r -= I6;
        if (r < I7) { conv_item(P->in[I_W2_K] + (size_t)l * 256 * 64, 256, 64, (bf16_t*)(ws + WS_CW2K), 0, 1, scr, r, lane); continue; } r -= I7;
        if (r < I8) { conv_item(P->in[I_W2_V] + (size_t)l * 256 * 64, 256, 64, (bf16_t*)(ws + WS_CW2V), 0, 1, scr, r, lane); continue; } r -= I8;
        if (r >= I9) {
            const int g = r - I9, p = lane;
            const float dt = expf(P->in[I_LOG_DT][l * 16 + g]);
            const float lr = P->in[I_LAM_RE][(l * 16 + g) * 64 + p], li = P->in[I_LAM_IM][(l * 16 + g) * 64 + p];
            const float mag = expf(lr * dt), ang = li * dt;
            const float ar = mag * cosf(ang), ai = mag * sinf(ang);
            const float den = lr * lr + li * li;
            const float gr = ((ar - 1.0f) * lr + ai * li) / den, gi = (ai * lr - (ar - 1.0f) * li) / den;
            float pr = ar, pi = ai;
#pragma unroll
            for (int q = 0; q < 4; ++q) { const float nr = pr * pr - pi * pi, ni = 2.f * pr * pi; pr = nr; pi = ni; }
            const float p16r = pr, p16i = pi;
#pragma unroll
            for (int q = 0; q < 2; ++q) { const float nr = pr * pr - pi * pi, ni = 2.f * pr * pi; pr = nr; pi = ni; }
            float* tf = (float*)(ws + WS_S5T) + (size_t)(g * 64 + p) * 8;
            *(f32x4*)tf = (f32x4){ar, ai, p16r, p16i}; *(f32x4*)(tf + 4) = (f32x4){pr, pi, 0.f, 0.f};
            const float* br = P->in[I_B_RE] + ((size_t)(l * 16 + g) * 64 + p) * 16;
            const float* bi = P->in[I_B_IM] + ((size_t)(l * 16 + g) * 64 + p) * 16;
            float vr[16], vi[16];
#pragma unroll
            for (int q = 0; q < 4; ++q) { const f32x4 a = *(const f32x4*)(br + 4 * q), b = *(const f32x4*)(bi + 4 * q);
#pragma unroll
                for (int e = 0; e < 4; ++e) { vr[4 * q + e] = gr * a[e] - gi * b[e]; vi[4 * q + e] = gr * b[e] + gi * a[e]; } }
            bf16_t* tb = (bf16_t*)(ws + WS_S5T + 32768) + (size_t)(g * 64 + p) * 32;
            *(bf16x8*)tb = pack8(vr); *(bf16x8*)(tb + 8) = pack8(vr + 8); *(bf16x8*)(tb + 16) = pack8(vi); *(bf16x8*)(tb + 24) = pack8(vi + 8);
            continue;
        }
        {
            const int kv = r >> 6, hid = ((r >> 4) & 3) * 64 + lane, kc = r & 15;
            const float* pe = P->in[kv ? I_PE_V : I_PE_K] + (size_t)l * 2048 + kc * 128;
            const float* w1 = P->in[kv ? I_W1_V : I_W1_K] + (size_t)l * 2048 * 256 + (size_t)kc * 128 * 256;
            float a0 = 0.f, a1 = 0.f, a2 = 0.f, a3 = 0.f;
#pragma unroll 1
            for (int k0 = 0; k0 < 128; k0 += 32) {
                float wv[32];
#pragma unroll
                for (int k = 0; k < 32; ++k) wv[k] = w1[(size_t)(k0 + k) * 256 + hid];
#pragma unroll
                for (int k = 0; k < 32; k += 4) { a0 += pe[k0 + k] * wv[k]; a1 += pe[k0 + k + 1] * wv[k + 1]; a2 += pe[k0 + k + 2] * wv[k + 2]; a3 += pe[k0 + k + 3] * wv[k + 3]; }
            }
            ((float*)(ws + WS_CB1))[kc * 512 + kv * 256 + hid] = (a0 + a1) + (a2 + a3);
        }
    }
}

__device__ __forceinline__ void norm_pass(const float* xin, const bf16_t* f, const float* gpost, const float* gpre, float* h32, bf16_t* hb, float* out32, bf16_t* u, int gw, int NGW, int lane) {
    for (int m = gw; m < MTOK; m += NGW) {
        f32x4 hv[4];
        const size_t off = (size_t)m * DM + 4 * lane;
        if (f == nullptr) {
#pragma unroll
            for (int j = 0; j < 4; ++j) hv[j] = *(const f32x4*)(xin + off + 256 * j);
        } else {
            f32x4 fv[4]; float ss = 0.f;
#pragma unroll
            for (int j = 0; j < 4; ++j) {
                if (hb) { const u32x2 hw = *(const u32x2*)(hb + off + 256 * j);
                    hv[j] = (f32x4){__uint_as_float(hw.x << 16), __uint_as_float(hw.x & 0xffff0000u), __uint_as_float(hw.y << 16), __uint_as_float(hw.y & 0xffff0000u)}; }
                else hv[j] = *(const f32x4*)(h32 + off + 256 * j);
                const u32x2 w = *(const u32x2*)(f + off + 256 * j);
                fv[j][0] = __uint_as_float(w.x << 16); fv[j][1] = __uint_as_float(w.x & 0xffff0000u); fv[j][2] = __uint_as_float(w.y << 16); fv[j][3] = __uint_as_float(w.y & 0xffff0000u);
                ss += fv[j][0] * fv[j][0] + fv[j][1] * fv[j][1] + fv[j][2] * fv[j][2] + fv[j][3] * fv[j][3];
            }
            ss = wave_sum(ss, lane);
            const float rs = rsqrtf(ss * (1.0f / DM) + EPS);
#pragma unroll
            for (int j = 0; j < 4; ++j) { const f32x4 g = *(const f32x4*)(gpost + 4 * lane + 256 * j); hv[j] += fv[j] * rs * g; }
        }
        if (out32) {
#pragma unroll
            for (int j = 0; j < 4; ++j) *(f32x4*)(out32 + off + 256 * j) = hv[j];
        }
        if (hb && gpre) {
#pragma unroll
            for (int j = 0; j < 4; ++j) { u32x2 w; w.x = cvt_pk_bf16(hv[j][0], hv[j][1]); w.y = cvt_pk_bf16(hv[j][2], hv[j][3]); *(u32x2*)(hb + off + 256 * j) = w; }
        }
        if (gpre) {
            float ss = 0.f;
#pragma unroll
            for (int j = 0; j < 4; ++j) ss += hv[j][0] * hv[j][0] + hv[j][1] * hv[j][1] + hv[j][2] * hv[j][2] + hv[j][3] * hv[j][3];
            ss = wave_sum(ss, lane);
            const float rs = rsqrtf(ss * (1.0f / DM) + EPS);
#pragma unroll
            for (int j = 0; j < 4; ++j) { const f32x4 g = *(const f32x4*)(gpre + 4 * lane + 256 * j); const f32x4 o = hv[j] * rs * g;
                u32x2 w; w.x = cvt_pk_bf16(o[0], o[1]); w.y = cvt_pk_bf16(o[2], o[3]); *(u32x2*)(u + off + 256 * j) = w; }
        }
    }
}

struct S5H { float ar[2], ai[2], p16r[2], p16i[2]; bf16x8 Bf[4]; };
__device__ __forceinline__ void s5h_setup(KP P, int l, int g, int r16, int g4, int half, S5H& s) {
    const float* tf = (const float*)(P->ws + WS_S5T);
    const bf16_t* tb = (const bf16_t*)(P->ws + WS_S5T + 32768);
#pragma unroll
    for (int ii = 0; ii < 2; ++ii) {
        const int p = 16 * (2 * half + ii) + r16;
        const f32x4 t0 = *(const f32x4*)(tf + (size_t)(g * 64 + p) * 8);
        s.ar[ii] = t0[0]; s.ai[ii] = t0[1]; s.p16r[ii] = t0[2]; s.p16i[ii] = t0[3];
        u32x4 wr = (u32x4){0u, 0u, 0u, 0u}, wi = (u32x4){0u, 0u, 0u, 0u};
        if (g4 < 2) { wr = *(const u32x4*)(tb + (size_t)(g * 64 + p) * 32 + 8 * g4); wi = *(const u32x4*)(tb + (size_t)(g * 64 + p) * 32 + 16 + 8 * g4); }
        s.Bf[ii] = __builtin_bit_cast(bf16x8, wr); s.Bf[2 + ii] = __builtin_bit_cast(bf16x8, wi);
    }
}
__device__ __forceinline__ void s5_load_u(const bf16_t* z, int m0, int g, bf16x8 (&Af)[4], int r16, int g4) {
#pragma unroll
    for (int mf = 0; mf < 4; ++mf) {
        const int tok = 16 * (r16 >> 2) + 4 * mf + (r16 & 3);
        u32x4 w = (u32x4){0u, 0u, 0u, 0u};
        if (g4 < 2) w = *(const u32x4*)(z + (size_t)(m0 + tok) * ZLD + ZC_SU + g * 16 + 8 * g4);
        Af[mf] = __builtin_bit_cast(bf16x8, w);
    }
}
__device__ __forceinline__ void s5h_bu(const bf16x8 (&Af)[4], const S5H& s, f32x4 (&C)[4][4]) {
#pragma unroll
    for (int mf = 0; mf < 4; ++mf)
#pragma unroll
        for (int j = 0; j < 4; ++j) C[mf][j] = mfma16(Af[mf], s.Bf[j], (f32x4){0.f, 0.f, 0.f, 0.f});
}
#define CMUL_R(ar_, ai_, br_, bi_) ((ar_) * (br_) - (ai_) * (bi_))
#define CMUL_I(ar_, ai_, br_, bi_) ((ar_) * (bi_) + (ai_) * (br_))

__device__ __forceinline__ void s5_stage1(KP P, int l, int bitem, ldsp lds, int wave, int lane) {
    const int wi = bitem * 8 + wave;
    const int c = wi & 31, g = (wi >> 5) & 15, b = wi >> 9;
    const int r16 = lane & 15, g4 = lane >> 4;
    const bf16_t* z = (const bf16_t*)(P->ws + WS_Z);
    bf16x8 Af[4]; s5_load_u(z, b * SEQ + c * 64, g, Af, r16, g4);
    float* E = (float*)(P->ws + WS_S5E) + (size_t)wi * 128;
#pragma nounroll
    for (int half = 0; half < 2; ++half) {
        S5H s; s5h_setup(P, l, g, r16, g4, half, s);
        f32x4 C[4][4];
        s5h_bu(Af, s, C);
#pragma unroll
        for (int ii = 0; ii < 2; ++ii) {
            const float ar = s.ar[ii], ai = s.ai[ii];
            float xr = 0.f, xi = 0.f;
#pragma unroll
            for (int k = 0; k < 16; ++k) { const float bur = C[k >> 2][ii][k & 3], bui = C[k >> 2][2 + ii][k & 3];
                const float nr = ar * xr - ai * xi + bur, ni = ar * xi + ai * xr + bui; xr = nr; xi = ni; }
            const float pr = s.p16r[ii], pi = s.p16i[ii];
            const float p2r = CMUL_R(pr, pi, pr, pi), p2i = CMUL_I(pr, pi, pr, pi), p3r = CMUL_R(p2r, p2i, pr, pi), p3i = CMUL_I(p2r, p2i, pr, pi);
            const float wr = g4 == 3 ? 1.f : (g4 == 2 ? pr : (g4 == 1 ? p2r : p3r)), wim = g4 == 3 ? 0.f : (g4 == 2 ? pi : (g4 == 1 ? p2i : p3i));
            const float er = xsum16_32(CMUL_R(wr, wim, xr, xi)), ei = xsum16_32(CMUL_I(wr, wim, xr, xi));
            const int p = 16 * (2 * half + ii) + r16;
            if (g4 == 0) { __hip_atomic_store(&E[p], er, __ATOMIC_RELAXED, __HIP_MEMORY_SCOPE_AGENT); __hip_atomic_store(&E[64 + p], ei, __ATOMIC_RELAXED, __HIP_MEMORY_SCOPE_AGENT); }
        }
    }
    asm volatile("s_waitcnt vmcnt(0)" ::: "memory");
    unsigned old = 0u;
    if (lane == 0) old = __hip_atomic_fetch_add((unsigned*)(P->ws + WS_CTL) + 12288 + (l * 128 + b * 16 + g) * 4, 1u, __ATOMIC_RELAXED, __HIP_MEMORY_SCOPE_AGENT);
    old = (unsigned)__builtin_amdgcn_readfirstlane((int)old);
    if (old == 31u) {
        __builtin_amdgcn_fence(__ATOMIC_ACQUIRE, "agent");
        asm volatile("s_waitcnt vmcnt(0)" ::: "memory");
        float* Er = (float*)(P->ws + WS_S5E) + (size_t)((b * 16 + g) * 32) * 128;
        const f32x4 t1 = *(const f32x4*)((const float*)(P->ws + WS_S5T) + (size_t)(g * 64 + lane) * 8 + 4);
        const float qr = t1[0], qi = t1[1];
        float xr = 0.f, xi = 0.f;
#pragma unroll 1
        for (int c0 = 0; c0 < 32; c0 += 16) {
            float er[16], ei[16];
#pragma unroll
            for (int q = 0; q < 16; ++q) { er[q] = Er[(c0 + q) * 128 + lane]; ei[q] = Er[(c0 + q) * 128 + 64 + lane]; }
#pragma unroll
            for (int q = 0; q < 16; ++q) { Er[(c0 + q) * 128 + lane] = xr; Er[(c0 + q) * 128 + 64 + lane] = xi;
                const float nr = CMUL_R(qr, qi, xr, xi) + er[q], ni = CMUL_I(qr, qi, xr, xi) + ei[q]; xr = nr; xi = ni; }
        }
    }
}

__device__ __forceinline__ void s5_stage2(KP P, int l, int bitem, ldsp lds, int wave, int lane) {
    const int c = bitem & 31, b = bitem >> 5;
    const bf16_t* z = (const bf16_t*)(P->ws + WS_Z);
    constexpr int YLD = 264;
    const int Y_OFF = 0, XS_OFF = 34816 + wave * 4352;
    const int r16 = lane & 15, g4 = lane >> 4;
    const int m0 = b * SEQ + c * 64;
#pragma nounroll
    for (int gi = 0; gi < 2; ++gi) {
        const int g = 2 * wave + gi;
        bf16x8 Af[4]; s5_load_u(z, m0, g, Af, r16, g4);
        const float dsk = P->in[I_SSM_D][l * 256 + g * 16 + r16];
        const float* E = (const float*)(P->ws + WS_S5E) + (size_t)((b * 16 + g) * 32) * 128;
        const float* cre = P->in[I_C_RE] + ((size_t)(l * 16 + g) * 16 + r16) * 64;
        const float* cim = P->in[I_C_IM] + ((size_t)(l * 16 + g) * 16 + r16) * 64;
        f32x4 acc[4];
#pragma unroll
        for (int q = 0; q < 4; ++q) acc[q] = (f32x4){0.f, 0.f, 0.f, 0.f};
#pragma nounroll
        for (int half = 0; half < 2; ++half) {
            S5H s; s5h_setup(P, l, g, r16, g4, half, s);
            bf16x8 Cf[2];
#pragma unroll
            for (int ks = 0; ks < 2; ++ks) {
                const f32x4 a = *(const f32x4*)(cre + 32 * half + 16 * ks + 4 * g4), bq = *(const f32x4*)(cim + 32 * half + 16 * ks + 4 * g4);
                float v[8] = {a[0], -bq[0], a[1], -bq[1], a[2], -bq[2], a[3], -bq[3]};
                Cf[ks] = pack8(v);
            }
            f32x4 C[4][4];
            s5h_bu(Af, s, C);
            float xr[2], xi[2];
#pragma unroll
            for (int ii = 0; ii < 2; ++ii) {
                const float ar = s.ar[ii], ai = s.ai[ii];
                float er = 0.f, ei = 0.f;
#pragma unroll
                for (int k = 0; k < 16; ++k) { const float bur = C[k >> 2][ii][k & 3], bui = C[k >> 2][2 + ii][k & 3];
                    const float nr = ar * er - ai * ei + bur, ni = ar * ei + ai * er + bui; er = nr; ei = ni; }
                const float p16r = s.p16r[ii], p16i = s.p16i[ii];
                const int p = 16 * (2 * half + ii) + r16;
                const float x0r = E[c * 128 + p], x0i = E[c * 128 + 64 + p];
                float cr = x0r, ci = x0i;
#pragma unroll
                for (int gq = 0; gq < 3; ++gq) {
                    const float eqr = SHIDX(er, r16 + 16 * gq), eqi = SHIDX(ei, r16 + 16 * gq);
                    const float nr = CMUL_R(p16r, p16i, cr, ci) + eqr, ni = CMUL_I(p16r, p16i, cr, ci) + eqi;
                    if (g4 > gq) { cr = nr; ci = ni; }
                }
                xr[ii] = cr; xi[ii] = ci;
            }
#pragma unroll
            for (int q = 0; q < 4; ++q) {
#pragma unroll
                for (int ii = 0; ii < 2; ++ii) {
                    const float ar = s.ar[ii], ai = s.ai[ii];
#pragma unroll
                    for (int rg = 0; rg < 4; ++rg) {
                        const float nr = ar * xr[ii] - ai * xi[ii] + C[q][ii][rg], ni = ar * xi[ii] + ai * xr[ii] + C[q][2 + ii][rg];
                        xr[ii] = nr; xi[ii] = ni;
                        *(LAS ual_t*)(lds + XS_OFF + ((4 * g4 + rg) * 136 + 2 * (16 * ii + r16)) * 2) = cvt_pk_bf16(nr, ni);
                    }
                }
#pragma unroll
                for (int ks = 0; ks < 2; ++ks) acc[q] = mfma16(lds_frag(lds, XS_OFF + (r16 * 136 + 32 * ks + 8 * g4) * 2), Cf[ks], acc[q]);
            }
        }
#pragma unroll
        for (int q = 0; q < 4; ++q)
#pragma unroll
            for (int rg = 0; rg < 4; ++rg) {
                const int tok = 16 * g4 + 4 * q + rg;
                float y = acc[q][rg] + dsk * bf2f(z[(size_t)(m0 + tok) * ZLD + ZC_SU + g * 16 + r16]);
                y = gelu_tanh(y);
                *(LAS bf16_t*)(lds + Y_OFF + (tok * YLD + g * 16 + r16) * 2) = f2bf(y);
            }
    }
    {
        const bf16_t* wg = (const bf16_t*)(P->ws + WS_WGLU);
        bf16x8 bfr[8][2];
#pragma unroll
        for (int ks = 0; ks < 8; ++ks)
#pragma unroll
            for (int nf = 0; nf < 2; ++nf) bfr[ks][nf] = *(const bf16x8*)(wg + (size_t)(32 * wave + 16 * nf + r16) * 256 + 32 * ks + 8 * g4);
        __syncthreads();
        for (int rp43 = 0; rp43 < REPN(43); ++rp43) {
        f32x4 acc[4][2];
#pragma unroll
        for (int mf = 0; mf < 4; ++mf) { acc[mf][0] = (f32x4){0.f, 0.f, 0.f, 0.f}; acc[mf][1] = (f32x4){0.f, 0.f, 0.f, 0.f}; }
#pragma unroll
        for (int ks = 0; ks < 8; ++ks) {
#pragma unroll
            for (int mf = 0; mf < 4; ++mf) { const bf16x8 af = lds_frag(lds, Y_OFF + ((16 * mf + r16) * YLD + 32 * ks + 8 * g4) * 2);
                acc[mf][0] = mfma16(af, bfr[ks][0], acc[mf][0]); acc[mf][1] = mfma16(af, bfr[ks][1], acc[mf][1]); }
        }
        bf16_t* yo = (bf16_t*)(P->ws + WS_Y);
#pragma unroll
        for (int nf = 0; nf < 2; ++nf) {
            const int n = 32 * wave + 16 * nf + r16;
            const float gn = P->in[I_GN_SSM][l * 256 + n];
#pragma unroll
            for (int mf = 0; mf < 4; ++mf)
#pragma unroll
                for (int rg = 0; rg < 4; ++rg) {
                    const int tok = 16 * mf + 4 * g4 + rg;
                    const float yv = bf2f(*(const LAS bf16_t*)(lds + Y_OFF + (tok * YLD + n) * 2));
                    const float o = yv * sigmoidf_(acc[mf][nf][rg]);
                    float ss = o * o;
                    ss += SHX(ss, 1); ss += SHX(ss, 2); ss += SHX(ss, 4); ss += SHX(ss, 8);
                    const float rs = rsqrtf(ss * (1.0f / 16.0f) + EPS);
                    yo[(size_t)(m0 + tok) * DM + n] = f2bf(o * rs * gn);
                }
        }
        }
    }
}

__device__ __forceinline__ float log_sigmoid(float x) { return x > 0.f ? -log1pf(expf(-x)) : x - log1pf(expf(x)); }

__device__ __forceinline__ void conv_silu16(const bf16_t* z, const float* convw  , int b, int t, int zcol, int ch0, float* out) {
#pragma unroll
    for (int i = 0; i < 16; ++i) out[i] = 0.f;
#pragma unroll
    for (int j = 0; j < 4; ++j) {
        const int ts = t - 3 + j;
        if (ts >= 0) {
            const bf16_t* src = z + (size_t)(b * SEQ + ts) * ZLD + zcol;
            const u32x4 w0 = *(const u32x4*)src, w1 = *(const u32x4*)(src + 8);
            float v[16]; unpack8(w0, v); unpack8(w1, v + 8);
            const float* cw = convw + j * 512 + ch0;
#pragma unroll
            for (int q = 0; q < 4; ++q) { const f32x4 c4 = *(const f32x4*)(cw + 4 * q);
#pragma unroll
                for (int e = 0; e < 4; ++e) out[4 * q + e] += v[4 * q + e] * c4[e]; }
        }
    }
#pragma unroll
    for (int i = 0; i < 16; ++i) out[i] = out[i] * sigmoidf_(out[i]);
}

__device__ __forceinline__ float wave_scan_add(float v, int lane) {
#pragma unroll
    for (int o = 1; o < 64; o <<= 1) { const float t = SHUP(v, o); if (lane >= o) v += t; }
    return v;
}
__device__ __forceinline__ float wave_scan_max(float v, int lane) {
#pragma unroll
    for (int o = 1; o < 64; o <<= 1) { const float t = SHUP(v, o); if (lane >= o) v = fmaxf(v, t); }
    return v;
}
__device__ __forceinline__ void mlstm_gates_w0(KP P, int l, int b, int hh, int c, LAS fal_t* G, int lane) {
    const float* gate = (const float*)(P->ws + WS_GATE);
    const int s0 = 2 * lane;
    const size_t m0 = (size_t)b * SEQ + c * 128 + s0;
    const float bi = P->in[I_B_I][l * 4 + hh], bfv = P->in[I_B_F][l * 4 + hh];
    const float ig0 = gate[m0 * 32 + hh] + bi, ig1 = gate[(m0 + 1) * 32 + hh] + bi;
    const float lf0 = log_sigmoid(gate[m0 * 32 + 4 + hh] + bfv), lf1 = log_sigmoid(gate[(m0 + 1) * 32 + 4 + hh] + bfv);
    const float sm = lf0 + lf1, incl = wave_scan_add(sm, lane), excl = incl - sm;
    const float b0 = excl + lf0, b1 = incl;
    const float d0 = ig0 - b0, d1 = ig1 - b1;
    const float inclm = wave_scan_max(fmaxf(d0, d1), lane);
    float exclm = SHUP(inclm, 1); if (lane == 0) exclm = NEGF;
    const float maxd = SHIDX(inclm, 63);
    G[s0] = ig0; G[s0 + 1] = ig1; G[128 + s0] = b0; G[128 + s0 + 1] = b1;
    G[256 + s0] = fmaxf(exclm, d0); G[256 + s0 + 1] = inclm;
    G[384 + s0] = __expf(d0 - maxd); G[384 + s0 + 1] = __expf(d1 - maxd);
    if (lane == 63) { G[512] = b1; G[513] = b1 + maxd; }
}

__device__ __forceinline__ void mlstm_stage1(KP P, int l, int item, ldsp lds, int tid, int wave, int lane) {
    const int c = item & 15, hh = (item >> 4) & 3, b = item >> 6;
    const bf16_t* z = (const bf16_t*)(P->ws + WS_Z);
    constexpr int KW_OFF = 0, VT_OFF = 17408, G_OFF = 39168, LD = 136;
    LAS fal_t* G = (LAS fal_t*)(lds + G_OFF);
    {
        const int s = tid >> 2, q4 = tid & 3, t = c * 128 + s;
        float kv[16];
        conv_silu16(z, P->in[I_CONV] + (size_t)l * 2048, b, t, ZC_MK + hh * 64 + 16 * q4, 256 + hh * 64 + 16 * q4, kv);
        const bf16_t* vs = z + (size_t)(b * SEQ + t) * ZLD + ZC_MV + hh * 64 + 16 * q4;
        const u32x4 w0 = *(const u32x4*)vs, w1 = *(const u32x4*)(vs + 8);
        {
            float qv[16];
            conv_silu16(z, P->in[I_CONV] + (size_t)l * 2048, b, t, ZC_MQ + hh * 64 + 16 * q4, hh * 64 + 16 * q4, qv);
            bf16_t* qk = (bf16_t*)(P->ws + WS_QKC) + ((size_t)b * SEQ + t) * 512 + hh * 64 + 16 * q4;
            *(bf16x8*)qk = pack8(qv); *(bf16x8*)(qk + 8) = pack8(qv + 8);
            float ks_[16];
#pragma unroll
            for (int i = 0; i < 16; ++i) ks_[i] = kv[i] * 0.125f;
            *(bf16x8*)(qk + 256) = pack8(ks_); *(bf16x8*)(qk + 256 + 8) = pack8(ks_ + 8);
        }
        for (int e = tid; e < 15 * 128; e += 512) *(LAS bf16_t*)(lds + VT_OFF + ((65 + e / 128) * LD + (e & 127)) * 2) = 0;
        if (tid < 128) *(LAS bf16_t*)(lds + VT_OFF + (64 * LD + tid) * 2) = 0x3f80;
        if (wave == 0) mlstm_gates_w0(P, l, b, hh, c, G, lane);
        __syncthreads();
        const float wk = G[384 + s] * 0.125f;
#pragma unroll
        for (int i = 0; i < 16; ++i) *(LAS bf16_t*)(lds + KW_OFF + ((16 * q4 + i) * LD + s) * 2) = f2bf(kv[i] * wk);
        const unsigned ww[8] = {w0.x, w0.y, w0.z, w0.w, w1.x, w1.y, w1.z, w1.w};
#pragma unroll
        for (int i = 0; i < 8; ++i) {
            *(LAS bf16_t*)(lds + VT_OFF + ((16 * q4 + 2 * i) * LD + s) * 2) = (bf16_t)(ww[i] & 0xffffu);
            *(LAS bf16_t*)(lds + VT_OFF + ((16 * q4 + 2 * i + 1) * LD + s) * 2) = (bf16_t)(ww[i] >> 16);
        }
    }
    __syncthreads();
    float* out = (float*)(P->ws + WS_MLC) + (size_t)item * MLC_STRIDE;
    {
        const int r16 = lane & 15, g4 = lane >> 4, mf = wave >> 1, nf0 = (wave & 1) * 2;
        f32x4 acc[2] = {(f32x4){0.f, 0.f, 0.f, 0.f}, (f32x4){0.f, 0.f, 0.f, 0.f}};
        f32x4 accn = (f32x4){0.f, 0.f, 0.f, 0.f};
#pragma unroll
        for (int ks = 0; ks < 4; ++ks) {
            const bf16x8 af = lds_frag(lds, KW_OFF + ((16 * mf + r16) * LD + 32 * ks + 8 * g4) * 2);
#pragma unroll
            for (int nfi = 0; nfi < 2; ++nfi) acc[nfi] = mfma16(af, lds_frag(lds, VT_OFF + ((16 * (nf0 + nfi) + r16) * LD + 32 * ks + 8 * g4) * 2), acc[nfi]);
            if ((wave & 1) == 0) accn = mfma16(af, lds_frag(lds, VT_OFF + ((64 + r16) * LD + 32 * ks + 8 * g4) * 2), accn);
        }
        if ((wave & 1) == 0 && r16 == 0) {
#pragma unroll
            for (int rg = 0; rg < 4; ++rg) out[4096 + 16 * mf + 4 * g4 + rg] = accn[rg];
        }
#pragma unroll
        for (int nfi = 0; nfi < 2; ++nfi)
#pragma unroll
            for (int rg = 0; rg < 4; ++rg) out[(16 * mf + 4 * g4 + rg) * 64 + 16 * (nf0 + nfi) + r16] = acc[nfi][rg];
    }
    if (tid == 0) { out[4160] = G[512]; out[4161] = G[513]; }
    if (tid < 128) {
        float* mg = (float*)(P->ws + WS_MLG) + (size_t)item * 384;
        mg[tid] = G[tid]; mg[128 + tid] = G[128 + tid]; mg[256 + tid] = G[256 + tid];
    }
}

__device__ __forceinline__ void mlstm_stage2(KP P, int l, int item, ldsp lds, int tid, int wave, int lane) {
    const int c = item & 15, hh = (item >> 4) & 3, b = item >> 6;
    const bf16_t* z = (const bf16_t*)(P->ws + WS_Z);
    constexpr int Q_OFF = 0, K_OFF = 18432, VT_OFF = 36864, CT_OFF = 58624, P_OFF = 70144, G_OFF = 104960, QLD = 72, VLD = 136;
    LAS fal_t* G = (LAS fal_t*)(lds + G_OFF);
    const float* mlc_base = (const float*)(P->ws + WS_MLC) + (size_t)(item - c) * MLC_STRIDE;
    unsigned short opre[4][4];
    {
        const int r16 = lane & 15, g4 = lane >> 4;
#pragma unroll
        for (int rg = 0; rg < 4; ++rg) { const size_t m = (size_t)b * SEQ + c * 128 + 16 * wave + 4 * g4 + rg;
#pragma unroll
            for (int nf = 0; nf < 4; ++nf) opre[rg][nf] = z[m * ZLD + ZC_MO + hh * 64 + 16 * nf + r16]; }
    }
    {
        const int s = tid >> 2, q4 = tid & 3, t = c * 128 + s;
        const bf16_t* qk = (const bf16_t*)(P->ws + WS_QKC) + ((size_t)b * SEQ + t) * 512 + hh * 64 + 16 * q4;
        const u32x4 q0 = *(const u32x4*)qk, q1 = *(const u32x4*)(qk + 8), k0 = *(const u32x4*)(qk + 256), k1 = *(const u32x4*)(qk + 256 + 8);
        *(LAS u32x4*)(lds + Q_OFF + (s * QLD + 16 * q4) * 2) = q0; *(LAS u32x4*)(lds + Q_OFF + (s * QLD + 16 * q4 + 8) * 2) = q1;
        *(LAS u32x4*)(lds + K_OFF + (s * QLD + 16 * q4) * 2) = k0; *(LAS u32x4*)(lds + K_OFF + (s * QLD + 16 * q4 + 8) * 2) = k1;
        const bf16_t* vs = z + (size_t)(b * SEQ + t) * ZLD + ZC_MV + hh * 64 + 16 * q4;
        const u32x4 w0 = *(const u32x4*)vs, w1 = *(const u32x4*)(vs + 8);
        const unsigned ww[8] = {w0.x, w0.y, w0.z, w0.w, w1.x, w1.y, w1.z, w1.w};
#pragma unroll
        for (int i = 0; i < 8; ++i) {
            *(LAS bf16_t*)(lds + VT_OFF + ((16 * q4 + 2 * i) * VLD + s) * 2) = (bf16_t)(ww[i] & 0xffffu);
            *(LAS bf16_t*)(lds + VT_OFF + ((16 * q4 + 2 * i + 1) * VLD + s) * 2) = (bf16_t)(ww[i] >> 16);
        }
        for (int e = tid; e < 15 * 64; e += 512) *(LAS bf16_t*)(lds + CT_OFF + ((65 + e / 64) * QLD + (e & 63)) * 2) = 0;
        for (int e = tid; e < 15 * 128; e += 512) *(LAS bf16_t*)(lds + VT_OFF + ((65 + e / 128) * VLD + (e & 127)) * 2) = 0;
        if (tid < 128) *(LAS bf16_t*)(lds + VT_OFF + (64 * VLD + tid) * 2) = 0x3f80;
    }
    if (tid < 128) {
        const float* mg = (const float*)(P->ws + WS_MLG) + (size_t)item * 384;
        G[tid] = mg[tid]; G[128 + tid] = mg[128 + tid]; G[256 + tid] = mg[256 + tid];
    }
    if (wave == 0) {
        const bool valid = lane < c;
        const float bLc = valid ? mlc_base[(size_t)lane * MLC_STRIDE + 4160] : 0.f;
        const float mlc = valid ? mlc_base[(size_t)lane * MLC_STRIDE + 4161] : NEGF;
        float suf = 0.f;
#pragma unroll
        for (int j = 1; j < 16; ++j) { const float v = SHIDX(bLc, j); if (j > lane) suf += v; }
        const float total = SHIDX(suf + bLc, 0);
        float e = valid ? mlc + suf : NEGF;
        float mx = e;
#pragma unroll
        for (int o = 1; o < 64; o <<= 1) mx = fmaxf(mx, SHX(mx, o));
        const float Mq = fmaxf(total, mx);
        if (lane < 16) G[520 + lane] = valid ? __expf(e - Mq) : 0.f;
        if (lane == 0) G[536] = Mq;
    }
    __syncthreads();
    const float Mp = G[536];
    {
        float Cv[8]; float nv = 0.f;
#pragma unroll
        for (int i = 0; i < 8; ++i) Cv[i] = 0.f;
#pragma unroll 4
        for (int cc = 0; cc < c; ++cc) {
            const float* src = mlc_base + (size_t)cc * MLC_STRIDE;
            const float w = G[520 + cc];
            const f32x4 a = *(const f32x4*)(src + tid * 8), bq = *(const f32x4*)(src + tid * 8 + 4);
#pragma unroll
            for (int e = 0; e < 4; ++e) { Cv[e] += w * a[e]; Cv[4 + e] += w * bq[e]; }
            if (tid < 64) nv += w * src[4096 + tid];
        }
        const int dk = tid >> 3, dv0 = (tid & 7) * 8;
#pragma unroll
        for (int i = 0; i < 8; ++i) *(LAS bf16_t*)(lds + CT_OFF + ((dv0 + i) * QLD + dk) * 2) = f2bf(Cv[i]);
        if (tid < 64) *(LAS bf16_t*)(lds + CT_OFF + (64 * QLD + tid) * 2) = f2bf(nv);
    }
    __syncthreads();
    if (lane < 16) { const int t_ = 16 * wave + lane; G[384 + t_] = G[128 + t_] + fmaxf(Mp, G[256 + t_]); }
    asm volatile("s_waitcnt lgkmcnt(0)" ::: "memory");
    {
        const int r16 = lane & 15, g4 = lane >> 4;
        const int PW = P_OFF + wave * 4352;
        bf16x8 qf[2];
#pragma unroll
        for (int ks = 0; ks < 2; ++ks) qf[ks] = lds_frag(lds, Q_OFF + ((16 * wave + r16) * QLD + 32 * ks + 8 * g4) * 2);
        f32x4 accO[5];
#pragma unroll
        for (int nf = 0; nf < 5; ++nf) { accO[nf] = (f32x4){0.f, 0.f, 0.f, 0.f};
#pragma unroll
            for (int ks = 0; ks < 2; ++ks) accO[nf] = mfma16(qf[ks], lds_frag(lds, CT_OFF + ((16 * nf + r16) * QLD + 32 * ks + 8 * g4) * 2), accO[nf]); }
        float bt[4], mt[4];
#pragma unroll
        for (int rg = 0; rg < 4; ++rg) { const int t = 16 * wave + 4 * g4 + rg; bt[rg] = G[128 + t]; mt[rg] = G[384 + t];
            const float wi = __expf(bt[rg] + Mp - mt[rg]);
#pragma unroll
            for (int nf = 0; nf < 5; ++nf) accO[nf][rg] *= wi; }
        const int nfmax = (wave | 1);
        for (int nf = 0; nf <= nfmax; ++nf) {
            f32x4 sacc = (f32x4){0.f, 0.f, 0.f, 0.f};
            if (nf <= wave) {
#pragma unroll
                for (int ks = 0; ks < 2; ++ks) sacc = mfma16(qf[ks], lds_frag(lds, K_OFF + ((16 * nf + r16) * QLD + 32 * ks + 8 * g4) * 2), sacc);
            }
            const int s = 16 * nf + r16;
            const float ds = G[s] - G[128 + s];
#pragma unroll
            for (int rg = 0; rg < 4; ++rg) {
                const int t = 16 * wave + 4 * g4 + rg;
                const float p = (s <= t) ? sacc[rg] * __expf(bt[rg] + ds - mt[rg]) : 0.f;
                *(LAS bf16_t*)(lds + PW + ((4 * g4 + rg) * VLD + s) * 2) = f2bf(p);
            }
        }
        for (int ks = 0; ks <= (wave >> 1); ++ks) {
            const bf16x8 pf = lds_frag(lds, PW + (r16 * VLD + 32 * ks + 8 * g4) * 2);
#pragma unroll
            for (int nf = 0; nf < 5; ++nf) accO[nf] = mfma16(pf, lds_frag(lds, VT_OFF + ((16 * nf + r16) * VLD + 32 * ks + 8 * g4) * 2), accO[nf]);
        }
        bf16_t* yo = (bf16_t*)(P->ws + WS_Y);
#pragma unroll
        for (int rg = 0; rg < 4; ++rg) {
            const int t = 16 * wave + 4 * g4 + rg;
            const size_t m = (size_t)b * SEQ + c * 128 + t;
            const float den = SHIDX(accO[4][rg], lane & 48);
            const float dn = fmaxf(fabsf(den), __expf(-mt[rg]));
            float o[4]; float ss = 0.f;
#pragma unroll
            for (int nf = 0; nf < 4; ++nf) {
                const float op = bf2f(opre[rg][nf]);
                o[nf] = sigmoidf_(op) * (accO[nf][rg] / dn);
                ss += o[nf] * o[nf];
            }
            ss += SHX(ss, 1); ss += SHX(ss, 2); ss += SHX(ss, 4); ss += SHX(ss, 8);
            const float rs = rsqrtf(ss * (1.0f / 64.0f) + EPS);
#pragma unroll
            for (int nf = 0; nf < 4; ++nf) yo[m * DM + 256 + hh * 64 + 16 * nf + r16] = f2bf(o[nf] * rs * P->in[I_GN_MLSTM][l * 256 + hh * 64 + 16 * nf + r16]);
        }
    }
}

__device__ __forceinline__ void compress_item(KP P, int l, int item, ldsp lds, int tid, int wave, int lane) {
    const int nt = item & 3, bg = (item >> 2) & 15, kv = item >> 6;
    const int b = bg >> 1, g = bg & 1, n0 = 32 * nt;
    const bf16_t* z = (const bf16_t*)(P->ws + WS_Z);
    constexpr int CK_OFF = 0, CLD = 72, H_OFF = 77824, HLD = 264;
#define CK_ADDR(tk_) (CK_OFF + (tk_) * (CLD * 2) + ((((tk_) >> 4) & 15) << 4) + (((tk_) >> 8) << 8))
    const float* rc = (const float*)(P->ws + WS_ROPE);
    {
        u32x4 w0[5], w1[5];
#pragma unroll
        for (int it = 0; it < 5; ++it) {
            const int e = tid + 512 * it, tk = e >> 2, q4 = e & 3, t = 16 * n0 + tk;
            w0[it] = (u32x4){0u, 0u, 0u, 0u}; w1[it] = (u32x4){0u, 0u, 0u, 0u};
            if (e < 528 * 4 && t < SEQ) {
                const bf16_t* src = z + ((size_t)b * SEQ + t) * ZLD + (kv ? ZC_CV : ZC_CK) + g * 64 + 16 * q4;
                w0[it] = *(const u32x4*)src; w1[it] = *(const u32x4*)(src + 8);
            }
        }
#pragma unroll
        for (int it = 0; it < 5; ++it) {
            const int e = tid + 512 * it, tk = e >> 2, q4 = e & 3;
            if (e < 528 * 4) { *(LAS u32x4*)(lds + CK_ADDR(tk) + 32 * q4) = w0[it]; *(LAS u32x4*)(lds + CK_ADDR(tk) + 32 * q4 + 16) = w1[it]; }
        }
    }
    if (kv == 0) {
        __syncthreads();
        for (int tk = tid; tk < 528; tk += 512) {
            const int t = 16 * n0 + tk;
            if (t < SEQ) {
                const size_t m = (size_t)b * SEQ + t;
                const f32x4 c0 = *(const f32x4*)(rc + m * 8), c1 = *(const f32x4*)(rc + m * 8 + 4);
                const f32x4 s0 = *(const f32x4*)(rc + (size_t)MTOK * 8 + m * 8), s1 = *(const f32x4*)(rc + (size_t)MTOK * 8 + m * 8 + 4);
                const u32x4 a0 = *(const LAS u32x4*)(lds + CK_ADDR(tk)), a1 = *(const LAS u32x4*)(lds + CK_ADDR(tk) + 16);
                float v[16]; unpack8(a0, v); unpack8(a1, v + 8);
                const float cs[8] = {c0[0], c0[1], c0[2], c0[3], c1[0], c1[1], c1[2], c1[3]}, sn[8] = {s0[0], s0[1], s0[2], s0[3], s1[0], s1[1], s1[2], s1[3]};
                float o[16];
#pragma unroll
                for (int i = 0; i < 8; ++i) { o[i] = v[i] * cs[i] - v[8 + i] * sn[i]; o[8 + i] = v[8 + i] * cs[i] + v[i] * sn[i]; }
                *(LAS bf16x8*)(lds + CK_ADDR(tk)) = pack8(o); *(LAS bf16x8*)(lds + CK_ADDR(tk) + 16) = pack8(o + 8);
            }
        }
    }
    const int r16 = lane & 15, g4 = lane >> 4;
    float bb[2];
    {
        const float* cb1 = (const float*)(P->ws + WS_CB1) + kv * 256;
#pragma unroll
        for (int nfi = 0; nfi < 2; ++nfi) { const int hid = 32 * wave + 16 * nfi + r16; float a = 0.f;
#pragma unroll
            for (int kc = 0; kc < 16; ++kc) a += cb1[kc * 512 + hid];
            bb[nfi] = a; }
    }
    __syncthreads();
    {
        const bf16_t* w1t = (const bf16_t*)(P->ws + (kv ? WS_CW1V : WS_CW1K));
        const bf16_t* wrow = w1t + (size_t)(32 * wave + r16) * 2048 + 8 * g4;
        f32x4 acc[2][2];
#pragma unroll
        for (int a = 0; a < 2; ++a) { acc[a][0] = (f32x4){0.f, 0.f, 0.f, 0.f}; acc[a][1] = (f32x4){0.f, 0.f, 0.f, 0.f}; }
        for (int k8 = 0; k8 < 8; ++k8) {
            bf16x8 bfr[8][2];
#pragma unroll
            for (int kk = 0; kk < 8; ++kk)
#pragma unroll
                for (int nfi = 0; nfi < 2; ++nfi) bfr[kk][nfi] = *(const bf16x8*)(wrow + (size_t)nfi * 16 * 2048 + 32 * (8 * k8 + kk));
#pragma unroll
            for (int kk = 0; kk < 8; ++kk) {
                const int ks = 8 * k8 + kk, tt = ks >> 1, dd = 32 * (ks & 1) + 8 * g4;
                bf16x8 af[2];
#pragma unroll
                for (int mf = 0; mf < 2; ++mf) { const int tk_ = 16 * (16 * mf + r16) + tt; af[mf] = lds_frag(lds, CK_ADDR(tk_) + dd * 2); }
#pragma unroll
                for (int mf = 0; mf < 2; ++mf)
#pragma unroll
                    for (int nfi = 0; nfi < 2; ++nfi) acc[mf][nfi] = mfma16(af[mf], bfr[kk][nfi], acc[mf][nfi]);
            }
        }
#pragma unroll
        for (int nfi = 0; nfi < 2; ++nfi) { const int hid = 32 * wave + 16 * nfi + r16;
#pragma unroll
            for (int mf = 0; mf < 2; ++mf)
#pragma unroll
                for (int rg = 0; rg < 4; ++rg) *(LAS bf16_t*)(lds + H_OFF + ((16 * mf + 4 * g4 + rg) * HLD + hid) * 2) = f2bf(gelu_tanh(acc[mf][nfi][rg] + bb[nfi])); }
    }
    __syncthreads();
    {
        const bf16_t* w2t = (const bf16_t*)(P->ws + (kv ? WS_CW2V : WS_CW2K));
        const int mf = wave >> 2, nf = wave & 3;
        f32x4 acc = (f32x4){0.f, 0.f, 0.f, 0.f};
#pragma unroll
        for (int ks = 0; ks < 8; ++ks)
            acc = mfma16(lds_frag(lds, H_OFF + ((16 * mf + r16) * HLD + 32 * ks + 8 * g4) * 2), *(const bf16x8*)(w2t + (size_t)(16 * nf + r16) * 256 + 32 * ks + 8 * g4), acc);
        bf16_t* dst = (bf16_t*)(P->ws + (kv ? WS_VCMP : WS_KCMP)) + (size_t)bg * 128 * 64;
#pragma unroll
        for (int rg = 0; rg < 4; ++rg) { const int n = n0 + 16 * mf + 4 * g4 + rg; dst[n * 64 + 16 * nf + r16] = (n < 127) ? f2bf(acc[rg]) : (bf16_t)0; }
    }
#undef CK_ADDR
}

__device__ __forceinline__ void rope_item(KP P, int item, int tid) {
    bf16_t* z = (bf16_t*)(P->ws + WS_Z);
    const float* rc = (const float*)(P->ws + WS_ROPE);
    for (int e = item * 4096 + tid; e < item * 4096 + 4096; e += 512) {
        const int m = e / 12, hsel = e % 12;
        const int col = hsel < 8 ? ZC_AQ + hsel * 64 : (hsel < 10 ? ZC_SK + (hsel - 8) * 64 : ZC_WK + (hsel - 10) * 64);
        bf16_t* src = z + (size_t)m * ZLD + col;
        const u32x4 w0 = *(const u32x4*)src, w1 = *(const u32x4*)(src + 8);
        float v[16]; unpack8(w0, v); unpack8(w1, v + 8);
        const f32x4 c0 = *(const f32x4*)(rc + (size_t)m * 8), c1 = *(const f32x4*)(rc + (size_t)m * 8 + 4);
        const f32x4 s0 = *(const f32x4*)(rc + (size_t)MTOK * 8 + (size_t)m * 8), s1 = *(const f32x4*)(rc + (size_t)MTOK * 8 + (size_t)m * 8 + 4);
        const float cs[8] = {c0[0], c0[1], c0[2], c0[3], c1[0], c1[1], c1[2], c1[3]}, sn[8] = {s0[0], s0[1], s0[2], s0[3], s1[0], s1[1], s1[2], s1[3]};
        float o[16];
#pragma unroll
        for (int i = 0; i < 8; ++i) { o[i] = v[i] * cs[i] - v[8 + i] * sn[i]; o[8 + i] = v[8 + i] * cs[i] + v[i] * sn[i]; }
        *(bf16x8*)src = pack8(o); *(bf16x8*)(src + 8) = pack8(o + 8);
    }
}

struct NsaCtx { int tq; unsigned selm; };
__device__ __forceinline__ void nsa_tile(ldsp lds, int ks_off, int vt_off, const int MMODE, const bf16x8 (&Qf)[2][2], f32x4 (&OB)[4][2], float (&mrun)[2], float (&lrun)[2], int tql, bool selbit, int r16, int g4) {
    constexpr int KLD = 72, VLD = 72;
    const int kbase = ks_off + (r16 * KLD + 8 * g4) * 2, vbase = vt_off + ((4 * g4 + (r16 >> 2)) * VLD + 4 * (r16 & 3)) * 2;
    f32x4 S[2][4];
#pragma unroll
    for (int kfi = 0; kfi < 4; ++kfi) {
        const bf16x8 k0 = lds_frag(lds, kbase + 16 * kfi * KLD * 2), k1 = lds_frag(lds, kbase + 16 * kfi * KLD * 2 + 64);
#pragma unroll
        for (int f = 0; f < 2; ++f) S[f][kfi] = mfma16(k1, Qf[f][1], mfma16(k0, Qf[f][0], (f32x4){0.f, 0.f, 0.f, 0.f}));
    }
    bf16x8 pb[2][2];
#pragma unroll
    for (int f = 0; f < 2; ++f) {
        if (MMODE == 1) {
#pragma unroll
            for (int kfi = 0; kfi < 4; ++kfi)
#pragma unroll
                for (int rg = 0; rg < 4; ++rg) S[f][kfi][rg] = (16 * kfi + 4 * g4 + rg <= tql) ? S[f][kfi][rg] : NEGF;
        } else if (MMODE == 2) {
#pragma unroll
            for (int kfi = 0; kfi < 4; ++kfi)
#pragma unroll
                for (int rg = 0; rg < 4; ++rg) S[f][kfi][rg] = (16 * kfi + 4 * g4 + rg > tql) ? S[f][kfi][rg] : NEGF;
        }
        float mx = fmaxf(fmaxf(S[f][0][0], S[f][0][1]), fmaxf(S[f][0][2], S[f][0][3]));
#pragma unroll
        for (int kfi = 1; kfi < 4; ++kfi) mx = fmaxf(mx, fmaxf(fmaxf(S[f][kfi][0], S[f][kfi][1]), fmaxf(S[f][kfi][2], S[f][kfi][3])));
        mx = selbit ? mx : NEGF;
        mx = xmax16_32(mx);
        const float mn = fmaxf(mrun[f], mx);
        const float alpha = __builtin_amdgcn_exp2f(mrun[f] - mn);
        const float msub = selbit ? fmaxf(mn, -1e28f) : 1e30f;
        float ls = 0.f;
#pragma unroll
        for (int kfi = 0; kfi < 4; ++kfi)
#pragma unroll
            for (int rg = 0; rg < 4; ++rg) { const float p = __builtin_amdgcn_exp2f(S[f][kfi][rg] - msub); S[f][kfi][rg] = p; ls += p; }
        lrun[f] = lrun[f] * alpha + ls; mrun[f] = mn;
        if (__builtin_amdgcn_ballot_w64(alpha != 1.0f) != 0ull) {
#pragma unroll
            for (int df = 0; df < 4; ++df) OB[df][f] *= alpha;
        }
#pragma unroll
        for (int k2 = 0; k2 < 2; ++k2) {
            const float pv[8] = {S[f][2 * k2][0], S[f][2 * k2][1], S[f][2 * k2][2], S[f][2 * k2][3], S[f][2 * k2 + 1][0], S[f][2 * k2 + 1][1], S[f][2 * k2 + 1][2], S[f][2 * k2 + 1][3]};
            pb[f][k2] = pack8(pv);
        }
    }
#pragma unroll
    for (int k2 = 0; k2 < 2; ++k2)
#pragma unroll
        for (int df = 0; df < 4; ++df) {
            const bf16x4 lo = lds_tr16(lds, vbase + 32 * k2 * VLD * 2 + 32 * df);
            const bf16x4 hi = lds_tr16(lds, vbase + (32 * k2 + 16) * VLD * 2 + 32 * df);
            const bf16x8 va = __builtin_shufflevector(lo, hi, 0, 1, 2, 3, 4, 5, 6, 7);
            OB[df][0] = mfma16(va, pb[0][k2], OB[df][0]);
            OB[df][1] = mfma16(va, pb[1][k2], OB[df][1]);
        }
}

__device__ __forceinline__ void nsa_load_tile(ldsp lds, const bf16_t* kbase, const bf16_t* vbase, size_t ld, int keyoff, int tid) {
    constexpr int KS_OFF = 0, VT_OFF = 18432, KLD = 72;
    const int key = tid >> 3, dc = tid & 7;
    const u32x4 kw = *(const u32x4*)(kbase + (size_t)key * ld + 8 * dc);
    const u32x4 vw = *(const u32x4*)(vbase + (size_t)key * ld + 8 * dc);
    *(LAS u32x4*)(lds + KS_OFF + ((keyoff + key) * KLD + 8 * dc) * 2) = kw;
    *(LAS u32x4*)(lds + VT_OFF + ((keyoff + key) * KLD + 8 * dc) * 2) = vw;
}

__device__ __forceinline__ void nsa_item(KP P, int l, int item, ldsp lds, int tid, int wave, int lane) {
    const int qt = 31 - (item >> 4), bg = item & 15, b = bg >> 1, g = bg & 1;
    const int T0 = 64 * qt;
    const bf16_t* z = (const bf16_t*)(P->ws + WS_Z);
    const float* gate = (const float*)(P->ws + WS_GATE);
    constexpr int KS_OFF = 0, VT_OFF = 18432, KLD = 72, VLD = 72, IMP_OFF = 36864, SEL_OFF = 53248, OR_OFF = 53504;
    constexpr float SC2 = 0.125f * 1.4426950408889634f;
    const int r16 = lane & 15, g4 = lane >> 4;
    const int tq = T0 + 8 * wave + (r16 & 7);
    const size_t mq = (size_t)b * SEQ + tq;
    int hd[2]; hd[0] = 4 * g + (r16 >> 3); hd[1] = 4 * g + 2 + (r16 >> 3);
    bf16x8 Qf[2][2];
#pragma unroll
    for (int f = 0; f < 2; ++f)
#pragma unroll
        for (int ks = 0; ks < 2; ++ks) { const u32x4 qw = *(const u32x4*)(z + mq * ZLD + ZC_AQ + hd[f] * 64 + 32 * ks + 8 * g4);
            float qv[8]; unpack8(qw, qv);
#pragma unroll
            for (int e = 0; e < 8; ++e) qv[e] *= SC2;
            Qf[f][ks] = pack8(qv); }
    float gt[2][3];
#pragma unroll
    for (int f = 0; f < 2; ++f)
#pragma unroll
        for (int br = 0; br < 3; ++br) gt[f][br] = sigmoidf_(gate[mq * 32 + 8 + hd[f] * 3 + br]);
    unsigned long long tt0_ = 0; if (TIMEK >= 8 && TIMEK <= 10) tt0_ = __builtin_amdgcn_s_memrealtime();
#define NSA_TSTAMP(k) do { if (TIMEK >= 8 && TIMEK <= 10) { const unsigned long long n_ = __builtin_amdgcn_s_memrealtime(); if (TIMEK == (k) && tid == 0) atomicAdd((unsigned long long*)(P->ws + WS_CTL) + 1000, n_ - tt0_); tt0_ = n_; } } while (0)
    f32x4 OF[4][2], OB[4][2];
    if (tid == 0) *(LAS ual_t*)(lds + OR_OFF) = 0u;
    {
        const bf16_t* kc = (const bf16_t*)(P->ws + WS_KCMP) + (size_t)bg * 128 * 64;
        const bf16_t* vc = (const bf16_t*)(P->ws + WS_VCMP) + (size_t)bg * 128 * 64;
        nsa_load_tile(lds, kc, vc, 64, 0, tid);
        nsa_load_tile(lds, kc + 64 * 64, vc + 64 * 64, 64, 64, tid);
        __syncthreads();
        float pa[8], pc[8];
#pragma unroll
        for (int kf = 0; kf < 8; ++kf) { pa[kf] = 0.f; pc[kf] = 0.f; }
#pragma unroll
        for (int f = 0; f < 2; ++f) {
            __builtin_amdgcn_sched_barrier(0);
            f32x4 S[8];
#pragma unroll
            for (int kf = 0; kf < 8; ++kf) { S[kf] = (f32x4){0.f, 0.f, 0.f, 0.f};
#pragma unroll
                for (int ks = 0; ks < 2; ++ks) S[kf] = mfma16(lds_frag(lds, KS_OFF + ((16 * kf + r16) * KLD + 32 * ks + 8 * g4) * 2), Qf[f][ks], S[kf]);
                if ((kf & 1) == 1) __builtin_amdgcn_sched_barrier(0); }
            float mx = NEGF;
#pragma unroll
            for (int kf = 0; kf < 8; ++kf)
#pragma unroll
                for (int rg = 0; rg < 4; ++rg) { const int n = 16 * kf + 4 * g4 + rg; const bool v = (16 * n + 31 <= tq); const float s = v ? S[kf][rg] : NEGF; S[kf][rg] = s; mx = fmaxf(mx, s); }
            mx = fmaxf(mx, SHX(mx, 16)); mx = fmaxf(mx, SHX(mx, 32));
            float ls = 0.f;
#pragma unroll
            for (int kf = 0; kf < 8; ++kf)
#pragma unroll
                for (int rg = 0; rg < 4; ++rg) { const int n = 16 * kf + 4 * g4 + rg; const bool v = (16 * n + 31 <= tq); const float p = v ? __builtin_amdgcn_exp2f(S[kf][rg] - mx) : 0.f; S[kf][rg] = p; ls += p; }
            ls += SHX(ls, 16); ls += SHX(ls, 32);
            const float inv = ls > 0.f ? 1.0f / ls : 0.f;
#pragma unroll
            for (int kf = 0; kf < 8; ++kf) { S[kf] *= inv; pa[kf] += 2.0f * (S[kf][0] + S[kf][1] + S[kf][2]) + S[kf][3]; pc[kf] += S[kf][3]; }
            __builtin_amdgcn_sched_barrier(0);
#pragma unroll
            for (int df = 0; df < 4; ++df) OB[df][f] = (f32x4){0.f, 0.f, 0.f, 0.f};
#pragma unroll
            for (int k2 = 0; k2 < 4; ++k2) {
                const float pv[8] = {S[2 * k2][0], S[2 * k2][1], S[2 * k2][2], S[2 * k2][3], S[2 * k2 + 1][0], S[2 * k2 + 1][1], S[2 * k2 + 1][2], S[2 * k2 + 1][3]};
                const bf16x8 pb = pack8(pv);
#pragma unroll
                for (int df = 0; df < 4; ++df) {
                    const int vb_ = VT_OFF + ((4 * g4 + (r16 >> 2)) * VLD + 4 * (r16 & 3)) * 2;
                    const bf16x4 lo = lds_tr16(lds, vb_ + 32 * k2 * VLD * 2 + 32 * df);
                    const bf16x4 hi = lds_tr16(lds, vb_ + (32 * k2 + 16) * VLD * 2 + 32 * df);
                    OB[df][f] = mfma16(__builtin_shufflevector(lo, hi, 0, 1, 2, 3, 4, 5, 6, 7), pb, OB[df][f]);
                }
            }
#pragma unroll
            for (int df = 0; df < 4; ++df) OF[df][f] = OB[df][f] * gt[f][0];
        }
        LAS fal_t* impA = (LAS fal_t*)(lds + IMP_OFF + wave * 2048);
        LAS fal_t* impB = impA + 256;
#pragma unroll
        for (int kf = 0; kf < 8; ++kf) {
            const float va_ = pa[kf] + SHX(pa[kf], 8), vc_ = pc[kf] + SHX(pc[kf], 8);
            if (r16 < 8) {
                const int j = 4 * kf + g4;
                impA[r16 * 32 + j] = va_;
                if (j < 31) impB[r16 * 32 + j + 1] = vc_;
                if (j == 0) impB[r16 * 32] = 0.f;
            }
        }
        {
            const int tk = lane & 7, jg = lane >> 3;
            const int tt = T0 + 8 * wave + tk, jcur = tt >> 6;
            float myv[4];
#pragma unroll
            for (int i = 0; i < 4; ++i) { const int j = 4 * jg + i; float v = impA[tk * 32 + j] + impB[tk * 32 + j];
                if (j == 0 || j == jcur) v = 1e4f; else if (j > jcur) v = -1e4f; myv[i] = v; }
            asm volatile("s_waitcnt lgkmcnt(0)" ::: "memory");
#pragma unroll
            for (int i = 0; i < 4; ++i) impA[tk * 32 + 4 * jg + i] = myv[i];
            asm volatile("s_waitcnt lgkmcnt(0)" ::: "memory");
            int cnt[4] = {0, 0, 0, 0};
            for (int j2 = 0; j2 < 32; ++j2) { const float v2 = impA[tk * 32 + j2];
#pragma unroll
                for (int i = 0; i < 4; ++i) { const int j = 4 * jg + i; cnt[i] += (v2 > myv[i] || (v2 == myv[i] && j2 < j)) ? 1 : 0; } }
            unsigned bits = 0u;
#pragma unroll
            for (int i = 0; i < 4; ++i) { const int j = 4 * jg + i; if (cnt[i] < 8 && j <= jcur) bits |= (1u << j); }
            bits |= SHX(bits, 8); bits |= SHX(bits, 16); bits |= SHX(bits, 32);
            if (lane < 8) { *(LAS ual_t*)(lds + SEL_OFF + (wave * 8 + lane) * 4) = bits; __hip_atomic_fetch_or((LAS ual_t*)(lds + OR_OFF), bits, __ATOMIC_RELAXED, __HIP_MEMORY_SCOPE_WORKGROUP); }
        }
    }
    __syncthreads();
    NSA_TSTAMP(8);
    const unsigned selm = *(const LAS ual_t*)(lds + SEL_OFF + (wave * 8 + (r16 & 7)) * 4);
    {
        constexpr int TL_OFF = 53760, TILE_OFF = 54272, TKLD = 72;
        const unsigned selor = *(const LAS ual_t*)(lds + OR_OFF) & (qt >= 31 ? 0xffffffffu : ((2u << qt) - 1u));
        const int nsel = __builtin_popcount(selor), wj0 = (qt >= 4 ? qt - 4 : 0), nwin = qt - wj0 + 1, ntl = nsel + nwin;
        if (tid < 32) { if ((selor >> tid) & 1u) *(LAS ual_t*)(lds + TL_OFF + __builtin_popcount(selor & ((1u << tid) - 1u)) * 4) = 0x100u | (unsigned)tid; }
        else if (tid < 32 + nwin) *(LAS ual_t*)(lds + TL_OFF + (nsel + tid - 32) * 4) = 0x200u | (unsigned)(wj0 + tid - 32);
        __syncthreads();
        const int key = tid >> 3, dc = tid & 7;
        const bf16_t* zrow = z + ((size_t)b * SEQ + key) * ZLD + g * 64 + 8 * dc;
        u32x4 kw0, vw0, kw1, vw1;
#define NSA_TILE_LOAD(ti, KW, VW) do { const unsigned d_ = *(const LAS ual_t*)(lds + TL_OFF + (ti) * 4); const bf16_t* p_ = zrow + (size_t)(64 * (int)(d_ & 0xffu)) * ZLD + ((d_ >> 8) == 1u ? ZC_SK : ZC_WK); \
        KW = *(const u32x4*)p_; VW = *(const u32x4*)(p_ + 128); } while (0)
#define NSA_TILE_WRITE(bufi, KW, VW) do { const int ko_ = TILE_OFF + (bufi) * 18432; *(LAS u32x4*)(lds + ko_ + (key * TKLD + 8 * dc) * 2) = KW; \
        *(LAS u32x4*)(lds + ko_ + 9216 + (key * TKLD + 8 * dc) * 2) = VW; } while (0)
        NSA_TILE_LOAD(0, kw0, vw0);
        NSA_TILE_WRITE(0, kw0, vw0);
        if (ntl > 1) NSA_TILE_LOAD(1, kw1, vw1);
        if (ntl > 2) NSA_TILE_LOAD(2, kw0, vw0);
        __syncthreads();
        float mrun[2] = {NEGF, NEGF}, lrun[2] = {0.f, 0.f};
#pragma unroll
        for (int f = 0; f < 2; ++f)
#pragma unroll
            for (int df = 0; df < 4; ++df) OB[df][f] = (f32x4){0.f, 0.f, 0.f, 0.f};
        unsigned pmode = 1u;
#define NSA_ITER(i, KW, VW) do { \
            if ((i) + 1 < ntl) NSA_TILE_WRITE(((i) + 1) & 1, KW, VW); \
            if ((i) + 3 < ntl) NSA_TILE_LOAD((i) + 3, KW, VW); \
            const unsigned d = *(const LAS ual_t*)(lds + TL_OFF + (i) * 4); \
            const unsigned mode = d >> 8; const int j = (int)(d & 0xffu); \
            if (mode != pmode) { \
                _Pragma("unroll") for (int f = 0; f < 2; ++f) { const float sc = gt[f][1] / xsum16_32(lrun[f]); \
                    _Pragma("unroll") for (int df = 0; df < 4; ++df) { OF[df][f] += OB[df][f] * sc; OB[df][f] = (f32x4){0.f, 0.f, 0.f, 0.f}; } \
                    mrun[f] = NEGF; lrun[f] = 0.f; } \
                pmode = mode; \
            } \
            const int ko = TILE_OFF + ((i) & 1) * 18432; \
            const int mmode = (j == qt) ? 1 : ((mode == 2u && j == qt - 4) ? 2 : 0); \
            const bool selbit = mode == 1u ? (((selm >> j) & 1u) != 0u) : true; \
            if (__builtin_amdgcn_ballot_w64(selbit) != 0ull) nsa_tile(lds, ko, ko + 9216, mmode, Qf, OB, mrun, lrun, tq - T0, selbit, r16, g4); \
            __syncthreads(); } while (0)
        for (int i = 0; i < ntl; i += 2) {
            NSA_ITER(i, kw1, vw1);
            if (i + 1 < ntl) NSA_ITER(i + 1, kw0, vw0);
        }
#pragma unroll
        for (int f = 0; f < 2; ++f) { const float sc = gt[f][2] / xsum16_32(lrun[f]);
#pragma unroll
            for (int df = 0; df < 4; ++df) OF[df][f] += OB[df][f] * sc; }
#undef NSA_ITER
#undef NSA_TILE_LOAD
#undef NSA_TILE_WRITE
    }
    NSA_TSTAMP(9);
    {
        bf16_t* yo = (bf16_t*)(P->ws + WS_Y);
#pragma unroll
        for (int f = 0; f < 2; ++f) {
            float ss = 0.f;
#pragma unroll
            for (int df = 0; df < 4; ++df)
#pragma unroll
                for (int rg = 0; rg < 4; ++rg) ss += OF[df][f][rg] * OF[df][f][rg];
            ss += SHX(ss, 16); ss += SHX(ss, 32);
            const float rs = rsqrtf(ss * (1.0f / 64.0f) + EPS);
#pragma unroll
            for (int df = 0; df < 4; ++df) {
                const f32x4 gn = *(const f32x4*)(P->in[I_GN_NSA] + l * 512 + hd[f] * 64 + 16 * df + 4 * g4);
                const f32x4 o = OF[df][f] * rs * gn;
                u32x2 w; w.x = cvt_pk_bf16(o[0], o[1]); w.y = cvt_pk_bf16(o[2], o[3]);
                *(u32x2*)(yo + mq * DM + 512 + hd[f] * 64 + 16 * df + 4 * g4) = w;
            }
        }
    }
}

__device__ __forceinline__ int lane_id_hw() { return (int)__builtin_amdgcn_mbcnt_hi(~0u, __builtin_amdgcn_mbcnt_lo(~0u, 0u)); }
#define TID0_EXPR ((wave0_ << 6) | lane_id_hw())
#define XB_TMO      128
#define XB_XCNT(j)  (256  + 64 * (j))
#define XB_XSUB(j)  (1280 + 64 * (j))
#define XB_XGEN(j)  (2304 + 64 * (j))
#define XB_TOP      3328
#define XB_TOPGEN   3392
#define XCD_BAR_WORDS 3456
#define XB_SPIN_CAP (1u << 22)
__device__ __forceinline__ unsigned xb_ld(unsigned* p)              { return __hip_atomic_load(p, __ATOMIC_RELAXED, __HIP_MEMORY_SCOPE_AGENT); }
__device__ __forceinline__ unsigned xb_add(unsigned* p, unsigned v) { return __hip_atomic_fetch_add(p, v, __ATOMIC_RELAXED, __HIP_MEMORY_SCOPE_AGENT); }
__device__ __forceinline__ unsigned xb_xcc_id() { return (unsigned)__builtin_amdgcn_s_getreg((3 << 11) | 20) & 0xFu; }
#define XB_SPIN(cond, bar) do { unsigned _sp = 0; while (cond) { __builtin_amdgcn_s_sleep(1); \
    if ((++_sp & 255u) == 0u) { if (xb_ld(&(bar)[XB_TMO])) break; if (_sp > XB_SPIN_CAP) { atomicAdd(&(bar)[XB_TMO], 1u); break; } } } } while (0)
struct XcdBarrier { unsigned* bar; unsigned x; volatile LAS ual_t* st; };
__device__ __forceinline__ XcdBarrier xcd_barrier_post(unsigned* bar, volatile LAS ual_t* st, const int wave0_) {
    XcdBarrier b; b.bar = bar; b.x = xb_xcc_id(); b.st = st;
    if (TID0_EXPR == 0) (void)xb_add(&bar[XB_XCNT(b.x)], 1u);
    return b;
}
__device__ __forceinline__ void xcd_barrier_complete(unsigned* bar, unsigned x, unsigned& nloc, unsigned& nx) {
    const unsigned G = gridDim.x * gridDim.y * gridDim.z;
    unsigned sum, cnt, mine, sp = 0u;
    for (;;) {
        sum = 0u; cnt = 0u; mine = 0u;
#pragma unroll
        for (unsigned j = 0; j < 16; ++j) { const unsigned c = xb_ld(&bar[XB_XCNT(j)]); sum += c; cnt += (c > 0u) ? 1u : 0u; mine = (j == x) ? c : mine; }
        if (sum == G) break;
        __builtin_amdgcn_s_sleep(1);
        if ((++sp & 255u) == 0u) { if (xb_ld(&bar[XB_TMO])) break; if (sp > XB_SPIN_CAP) { atomicAdd(&bar[XB_TMO], 1u); break; } }
    }
    nloc = mine > 0u ? mine : 1u; nx = cnt > 0u ? cnt : 1u;
}
__device__ __forceinline__ void xcd_barrier(const XcdBarrier& b, const int wave0_) {
    asm volatile("s_waitcnt vmcnt(0)" ::: "memory");
    __syncthreads();
    if (TID0_EXPR == 0) {
        unsigned* bar = b.bar;
        __builtin_amdgcn_s_waitcnt(0);
        unsigned nloc = b.st[0], nx = b.st[1];
        if (nloc == 0u) { xcd_barrier_complete(bar, b.x, nloc, nx); b.st[0] = nloc; b.st[1] = nx; }
        const unsigned old = xb_add(&bar[XB_XSUB(b.x)], 1u);
        const unsigned gen = old / nloc;
        if (old + 1u == (gen + 1u) * nloc) {
            __builtin_amdgcn_fence(__ATOMIC_RELEASE, "agent");
            asm volatile("s_waitcnt vmcnt(0)" ::: "memory");
            const unsigned og = xb_add(&bar[XB_TOP], 1u);
            const unsigned tg = og / nx;
            if (og + 1u == (tg + 1u) * nx) xb_add(&bar[XB_TOPGEN], 1u);
            else XB_SPIN(xb_ld(&bar[XB_TOPGEN]) == tg, bar);
            __builtin_amdgcn_fence(__ATOMIC_ACQUIRE, "agent");
            xb_add(&bar[XB_XGEN(b.x)], 1u);
            asm volatile("s_waitcnt vmcnt(0)" ::: "memory");
        } else {
            XB_SPIN(xb_ld(&bar[XB_XGEN(b.x)]) == gen, bar);
            __builtin_amdgcn_fence(__ATOMIC_ACQUIRE, "agent");
            asm volatile("s_waitcnt vmcnt(0)" ::: "memory");
        }
    }
    __syncthreads();
}

__device__ __forceinline__ int p2_static(int bx, int k) {
    if (bx < 128) { return k == 0 ? bx : (k == 1 ? 128 + bx : (k == 2 ? 640 + bx : -1)); }
    const int j = bx - 128;
    if (k < 3) return 128 + 128 + 3 * j + k;
    if (k < 6) return 640 + 128 + 3 * j + (k - 3);
    if (k == 6 && j < 48) return 1152 + j;
    return -1;
}
__device__ __forceinline__ int p3_static(int bx, int k) {
    switch (k) {
        case 0: return bx;
        case 1: return ((31 - (bx >> 4)) << 4) | (bx & 15);
        case 2: return 512 + bx;
        case 3: return 512 + 256 + bx;
        case 4: return 1024 + bx;
        default: return -1;
    }
}
#ifndef EN_MASK
#define EN_MASK 0xFFFF
#endif
#define EN(b) (((EN_MASK) >> (b)) & 1)
#ifndef DUP
#define DUP 0
#endif
#define NREP(k) ((DUP) == (k) ? 2 : 1)
__global__ void __launch_bounds__(512, 2) hybrid_fwd(Params P_unused) {
    KP P = (KP)__builtin_amdgcn_kernarg_segment_ptr();
    extern __shared__ __attribute__((aligned(16))) unsigned char lds_raw[];
    ldsp lds = (ldsp)lds_raw;
    const int wave0_ = __builtin_amdgcn_readfirstlane((int)threadIdx.x >> 6);
#define tid0 TID0_EXPR
    volatile LAS ual_t* misc = (volatile LAS ual_t*)(lds + MISC_OFF);
    if (tid0 < 16) misc[tid0] = 0u;
    __syncthreads();
    (void)xcd_barrier_post((unsigned*)(P->ws + WS_CTL) + 4096, misc + 8, wave0_);
#define GRID_SYNC() do { asm volatile("" : "+s"(P)); XcdBarrier xb_; xb_.bar = (unsigned*)(P->ws + WS_CTL) + 4096; xb_.x = xb_xcc_id(); xb_.st = (volatile LAS ual_t*)(lds + MISC_OFF) + 8; xcd_barrier(xb_, wave0_); } while (0)
#define PHASE_BEGIN() asm volatile("" : "+s"(P)); int tid = tid0; asm volatile("" : "+v"(tid)); const int lane = tid & 63, wave = __builtin_amdgcn_readfirstlane(tid >> 6); \
    const int G = gridDim.x, gw = blockIdx.x * 8 + wave, NGW = G * 8; unsigned char* ws = P->ws; (void)lane; (void)gw; (void)NGW; (void)ws; (void)G

    {
        PHASE_BEGIN();
        if (EN(0)) { const bool hb = P->hb16 != 0; norm_pass(P->in[I_X], nullptr, nullptr, P->in[I_LN_MIX_PRE], nullptr, hb ? (bf16_t*)(ws + WS_H16) : nullptr, hb ? nullptr : P->out, (bf16_t*)(ws + WS_U), gw, NGW, lane); }
        if (EN(1)) {
            const int* pos = (const int*)P->in[I_POS];
            float* rc = (float*)(ws + WS_ROPE);
            for (int e = blockIdx.x * 512 + tid; e < MTOK * 8; e += G * 512) {
                const int m = e >> 3, j = e & 7;
                const float inv = powf(500000.0f, -(float)j * 0.125f);
                const float ang = (float)pos[m] * inv;
                rc[e] = cosf(ang); rc[(size_t)MTOK * 8 + e] = sinf(ang);
            }
        }
        if (EN(2)) convert_layer(P, 0, lds, gw, NGW, wave, lane);
    }
    GRID_SYNC();

    for (int l = 0; l < DEPTH; ++l) {
        for (int rep = 0; rep < NREP(1); ++rep) {
            PHASE_BEGIN();
            pg8::Gemm g{(const bf16_t*)(ws + WS_U), (const bf16_t*)(ws + WS_WIN), MTOK, ZLD, DM}; pg8::StaticOrder S; S.init(MTOK, ZLD, G, (int)blockIdx.x);
            pg8::EpiBf16<0> E{(bf16_t*)(ws + WS_Z), ZLD, (float*)(ws + WS_GATE), 10};
            pg8::gemm_phase<pg8::EpiBf16<0>, pg8::StaticOrder, true, true>(lds, g, S, E, tid);
            GRID_SYNC();
        }
        for (int rep = 0; rep < ((DUP) / 10 == 2 || (DUP) == 2 ? 2 : 1); ++rep) {
            constexpr int N_CMP = 128, N_ML = 512, N_S5 = 512, N_ROPE = 48, NTOT = N_CMP + N_ML + N_S5 + N_ROPE;
            for (int kstep = 0;; ++kstep) {
                __syncthreads();
                int item;
                if (gridDim.x == 256) item = p2_static((int)blockIdx.x, kstep);
                else { if (tid0 == 0) misc[0] = atomicAdd((unsigned*)(P->ws + WS_CTL) + 64 * (2 * l) + 1024 * rep, 1u); __syncthreads(); item = (int)misc[0]; if (item >= NTOT) item = -1; }
                PHASE_BEGIN();
                if (item < 0) break;
                if (item < N_CMP) { { unsigned long long t0_ = 0; if (TIMEK == 1) t0_ = __builtin_amdgcn_s_memrealtime(); if (EN(4) && (rep == 0 || DUP == 2 || DUP == 21)) compress_item(P, l, item, lds, tid, wave, lane); if (TIMEK == 1) { __syncthreads(); if (tid0 == 0) atomicAdd((unsigned long long*)(P->ws + WS_CTL) + 1000, __builtin_amdgcn_s_memrealtime() - t0_); } } continue; } item -= N_CMP;
                if (item < N_ML) { { unsigned long long t0_ = 0; if (TIMEK == 2) t0_ = __builtin_amdgcn_s_memrealtime(); if (EN(5) && (rep == 0 || DUP == 2 || DUP == 22)) mlstm_stage1(P, l, item, lds, tid, wave, lane); if (TIMEK == 2) { __syncthreads(); if (tid0 == 0) atomicAdd((unsigned long long*)(P->ws + WS_CTL) + 1000, __builtin_amdgcn_s_memrealtime() - t0_); } } continue; } item -= N_ML;
                if (item < N_S5) { { unsigned long long t0_ = 0; if (TIMEK == 3) t0_ = __builtin_amdgcn_s_memrealtime(); if (EN(6) && (rep == 0 || DUP == 2 || DUP == 23)) s5_stage1(P, l, item, lds, wave, lane); if (TIMEK == 3) { __syncthreads(); if (tid0 == 0) atomicAdd((unsigned long long*)(P->ws + WS_CTL) + 1000, __builtin_amdgcn_s_memrealtime() - t0_); } } continue; } item -= N_S5;
                { unsigned long long t0_ = 0; if (TIMEK == 4) t0_ = __builtin_amdgcn_s_memrealtime(); if (EN(7) && rep == 0) rope_item(P, item, tid); if (TIMEK == 4) { __syncthreads(); if (tid0 == 0) atomicAdd((unsigned long long*)(P->ws + WS_CTL) + 1000, __builtin_amdgcn_s_memrealtime() - t0_); } }
            }
            GRID_SYNC();
        }
        for (int rep = 0; rep < ((DUP) / 10 == 3 || (DUP) == 3 ? 2 : 1); ++rep) {
            constexpr int N_NSA = 512, N_ML = 512, N_S5 = 256, NTOT = N_NSA + N_ML + N_S5;
            for (int kstep = 0;; ++kstep) {
                __syncthreads();
                int item;
                if (gridDim.x == 256) item = p3_static((int)blockIdx.x, kstep);
                else { if (tid0 == 0) misc[0] = atomicAdd((unsigned*)(P->ws + WS_CTL) + 64 * (2 * l + 1) + 1024 * rep, 1u); __syncthreads(); item = (int)misc[0]; if (item >= NTOT) item = -1; }
                PHASE_BEGIN();
                if (item < 0) break;
                if (item < N_NSA) { { unsigned long long t0_ = 0; if (TIMEK == 5) t0_ = __builtin_amdgcn_s_memrealtime(); if (EN(8) && (rep == 0 || DUP == 3 || DUP == 31)) nsa_item(P, l, item, lds, tid, wave, lane); if (TIMEK == 5) { __syncthreads(); if (tid0 == 0) atomicAdd((unsigned long long*)(P->ws + WS_CTL) + 1000, __builtin_amdgcn_s_memrealtime() - t0_); } } continue; } item -= N_NSA;
                if (item < N_ML) { { unsigned long long t0_ = 0; if (TIMEK == 6) t0_ = __builtin_amdgcn_s_memrealtime(); if (EN(9) && (rep == 0 || DUP == 3 || DUP == 32)) mlstm_stage2(P, l, item, lds, tid, wave, lane); if (TIMEK == 6) { __syncthreads(); if (tid0 == 0) atomicAdd((unsigned long long*)(P->ws + WS_CTL) + 1000, __builtin_amdgcn_s_memrealtime() - t0_); } } continue; } item -= N_ML;
                { unsigned long long t0_ = 0; if (TIMEK == 7) t0_ = __builtin_amdgcn_s_memrealtime(); if (EN(10) && (rep == 0 || DUP == 3 || DUP == 33)) s5_stage2(P, l, item, lds, wave, lane); if (TIMEK == 7) { __syncthreads(); if (tid0 == 0) atomicAdd((unsigned long long*)(P->ws + WS_CTL) + 1000, __builtin_amdgcn_s_memrealtime() - t0_); } }
            }
            GRID_SYNC();
        }
        for (int rep = 0; rep < NREP(4); ++rep) {
            PHASE_BEGIN();
            pg8::Gemm g{(const bf16_t*)(ws + WS_Y), (const bf16_t*)(ws + WS_WOUT), MTOK, DM, DM}; pg8::StaticOrder S; S.init(MTOK, DM, G, (int)blockIdx.x);
            pg8::EpiBf16<0> E{(bf16_t*)(ws + WS_Z), DM, nullptr, -1};
            pg8::gemm_phase<pg8::EpiBf16<0>, pg8::StaticOrder, true, true>(lds, g, S, E, tid);
            GRID_SYNC();
        }
        if (EN(12)) {
            PHASE_BEGIN();
            const bool hb = P->hb16 != 0;
            norm_pass(nullptr, (const bf16_t*)(ws + WS_Z), P->in[I_LN_MIX_POST] + l * DM, P->in[I_LN_MLP_PRE] + l * DM, P->out, hb ? (bf16_t*)(ws + WS_H16) : nullptr, hb ? nullptr : P->out, (bf16_t*)(ws + WS_U), gw, NGW, lane);
        }
        GRID_SYNC();
        for (int rep = 0; rep < NREP(6); ++rep) {
            PHASE_BEGIN();
            pg8::Gemm g{(const bf16_t*)(ws + WS_U), (const bf16_t*)(ws + WS_W1), MTOK, DFF, DM}; pg8::StaticOrder S; S.init(MTOK, DFF, G, (int)blockIdx.x);
            pg8::EpiBf16<2> E{(bf16_t*)(ws + WS_Z), DFF, nullptr, -1};
            pg8::gemm_phase<pg8::EpiBf16<2>, pg8::StaticOrder, true, true>(lds, g, S, E, tid);
            GRID_SYNC();
        }
        for (int rep = 0; rep < NREP(7); ++rep) {
            PHASE_BEGIN();
            pg8::Gemm g{(const bf16_t*)(ws + WS_Z), (const bf16_t*)(ws + WS_W2), MTOK, DM, DFF}; pg8::StaticOrder S; S.init(MTOK, DM, G, (int)blockIdx.x);
            pg8::EpiBf16<0> E{(bf16_t*)(ws + WS_Y), DM, nullptr, -1};
            pg8::gemm_phase<pg8::EpiBf16<0>, pg8::StaticOrder, true, true>(lds, g, S, E, tid);
            GRID_SYNC();
        }
        {
            PHASE_BEGIN();
            if (EN(15)) { const bool hb = P->hb16 != 0, last = (l + 1 == DEPTH);
                norm_pass(nullptr, (const bf16_t*)(ws + WS_Y), P->in[I_LN_MLP_POST] + l * DM, last ? nullptr : P->in[I_LN_MIX_PRE] + (l + 1) * DM, P->out, hb ? (bf16_t*)(ws + WS_H16) : nullptr, (hb && !last) ? nullptr : P->out, (bf16_t*)(ws + WS_U), gw, NGW, lane); }
            if (l + 1 < DEPTH) { for (int rep = 0; rep < NREP(8); ++rep) convert_layer(P, l + 1, lds, gw, NGW, wave, lane); }
        }
        if (l + 1 < DEPTH) GRID_SYNC();
    }
    if (TIMEK != 0) {
        GRID_SYNC();
        if (blockIdx.x == 0 && tid0 == 0) { const unsigned long long tot = __hip_atomic_load((unsigned long long*)(P->ws + WS_CTL) + 1000, __ATOMIC_RELAXED, __HIP_MEMORY_SCOPE_AGENT) / 256ull;
            const unsigned long long t0_ = __builtin_amdgcn_s_memrealtime(); while (__builtin_amdgcn_s_memrealtime() - t0_ < tot) __builtin_amdgcn_s_sleep(8); }
    }
}

extern "C" void kernel_launch(void* const* d_in, const int* in_sizes, int n_in, void* d_out, int out_size, void* d_ws, size_t ws_size, hipStream_t stream) {
    static int grid = 0;
    if (grid == 0) {
        if (n_in != 31 || out_size != MTOK * DM || ws_size < WS_END) { fprintf(stderr, "kernel_launch: unexpected shapes (n_in %d out %d ws %zu)\n", n_in, out_size, ws_size); grid = -1; return; }
        int dev = 0, cus = 0, per_cu = 0;
        (void)hipGetDevice(&dev);
        (void)hipDeviceGetAttribute(&cus, hipDeviceAttributeMultiprocessorCount, dev);
        (void)hipFuncSetAttribute((const void*)hybrid_fwd, hipFuncAttributeMaxDynamicSharedMemorySize, LDS_BYTES);
        (void)hipOccupancyMaxActiveBlocksPerMultiprocessor(&per_cu, (const void*)hybrid_fwd, 512, LDS_BYTES);
        if (per_cu < 1) { fprintf(stderr, "kernel_launch: occupancy query says %d blocks/CU\n", per_cu); per_cu = 1; }
        grid = cus * 1;
        (void)hipGetLastError();
    }
    if (grid < 0) return;
    (void)hipMemsetAsync((char*)d_ws + WS_CTL, 0, 65536, stream);
    Params p{};
    for (int i = 0; i < 31; ++i) p.in[i] = (const float*)d_in[i];
    p.out = (float*)d_out; p.ws = (unsigned char*)d_ws; p.hb16 = (ws_size >= WS_END_H16) ? 1 : 0;
    void* args[] = {&p};
    hipError_t e = hipLaunchCooperativeKernel((const void*)hybrid_fwd, dim3(grid), dim3(512), args, LDS_BYTES, stream);
    if (e != hipSuccess) fprintf(stderr, "cooperative launch failed: %s (grid %d)\n", hipGetErrorString(e), grid);
}
```

```cpp
#include <hip/hip_runtime.h>
#include <hip/hip_cooperative_groups.h>
#include <cstdio>
#include <cstdint>
namespace cg = cooperative_groups;

#define LAS __attribute__((address_space(3)))
typedef unsigned short __attribute__((may_alias)) bf16_t;
typedef short bf16x8 __attribute__((ext_vector_type(8), may_alias));
typedef short bf16x4 __attribute__((ext_vector_type(4), may_alias));
typedef float f32x4 __attribute__((ext_vector_type(4), may_alias));
typedef float f32x2 __attribute__((ext_vector_type(2), may_alias));
typedef unsigned u32x4 __attribute__((ext_vector_type(4), may_alias));
typedef unsigned u32x2 __attribute__((ext_vector_type(2), may_alias));
typedef float __attribute__((may_alias)) fal_t;
typedef unsigned __attribute__((may_alias)) ual_t;
typedef LAS unsigned char* ldsp;

constexpr int NB = 8, SEQ = 2048, MTOK = NB * SEQ, DM = 1024, DEPTH = 4, DIN = 2592, ZLD = 2816, DFF = 4096;
constexpr int ZC_SU = 0, ZC_MQ = 256, ZC_MK = 512, ZC_MV = 768, ZC_MO = 1024, ZC_AQ = 1280, ZC_CK = 1792, ZC_CV = 1920,
              ZC_SK = 2048, ZC_SV = 2176, ZC_WK = 2304, ZC_WV = 2432, ZC_G = 2560;
constexpr float EPS = 1e-6f;
constexpr float NEGF = -1e30f;

constexpr size_t MiB = 1u << 20;
constexpr size_t WS_CTL = 0;
constexpr size_t WS_WIN = 1 * MiB;
constexpr size_t WS_WOUT = 7 * MiB;
constexpr size_t WS_W1 = 9 * MiB;
constexpr size_t WS_W2 = 17 * MiB;
constexpr size_t WS_WGLU = 25 * MiB;
constexpr size_t WS_CW1K = 25 * MiB + 256 * 1024;
constexpr size_t WS_CW1V = 26 * MiB + 256 * 1024;
constexpr size_t WS_CW2K = 27 * MiB + 256 * 1024;
constexpr size_t WS_CW2V = 27 * MiB + 320 * 1024;
constexpr size_t WS_CB1 = 27 * MiB + 384 * 1024;
constexpr size_t WS_ROPE = 28 * MiB;
constexpr size_t WS_GATE = 29 * MiB;
constexpr size_t WS_S5E = 31 * MiB;
constexpr size_t WS_MLC = 33 * MiB;
constexpr size_t WS_KCMP = 42 * MiB;
constexpr size_t WS_VCMP = 42 * MiB + 512 * 1024;
constexpr size_t WS_S5T = 42 * MiB + 256 * 1024;
constexpr size_t WS_MLG = 41 * MiB + 256 * 1024;
constexpr size_t WS_U = 43 * MiB;
constexpr size_t WS_Y = 75 * MiB;
constexpr size_t WS_Z = 107 * MiB;
constexpr size_t WS_QKC = WS_Z + 88 * MiB;
constexpr size_t WS_END = 235 * MiB;
constexpr size_t WS_H16 = 235 * MiB;
constexpr size_t WS_END_H16 = 267 * MiB;
constexpr int MLC_STRIDE = 4224;

#ifndef PROBE
#define PROBE 0
#endif
#ifndef TIMEK
#define TIMEK 0
#endif
#define REPN(k) ((PROBE) == (k) ? 3 : 1)
__device__ __forceinline__ float bf2f(unsigned short v) { return __uint_as_float(((unsigned)v) << 16); }
__device__ __forceinline__ unsigned cvt_pk_bf16(float lo, float hi) { unsigned r; asm volatile("v_cvt_pk_bf16_f32 %0, %1, %2" : "=v"(r) : "v"(lo), "v"(hi)); return r; }
__device__ __forceinline__ unsigned short f2bf(float f) { return (unsigned short)(cvt_pk_bf16(f, 0.f) & 0xffffu); }
typedef short v4i16_t __attribute__((ext_vector_type(4)));
__device__ __forceinline__ bf16x4 lds_tr16(ldsp lds, int byteoff) { return __builtin_bit_cast(bf16x4, __builtin_amdgcn_ds_read_tr16_b64_v4i16((LAS v4i16_t*)(lds + byteoff))); }
__device__ __forceinline__ float xmax16_32(float v) {
    auto a = __builtin_amdgcn_permlane16_swap(__float_as_uint(v), __float_as_uint(v), false, false);
    v = fmaxf(__uint_as_float(a[0]), __uint_as_float(a[1]));
    auto b = __builtin_amdgcn_permlane32_swap(__float_as_uint(v), __float_as_uint(v), false, false);
    return fmaxf(__uint_as_float(b[0]), __uint_as_float(b[1]));
}
__device__ __forceinline__ float xsum16_32(float v) {
    auto a = __builtin_amdgcn_permlane16_swap(__float_as_uint(v), __float_as_uint(v), false, false);
    v = __uint_as_float(a[0]) + __uint_as_float(a[1]);
    auto b = __builtin_amdgcn_permlane32_swap(__float_as_uint(v), __float_as_uint(v), false, false);
    return __uint_as_float(b[0]) + __uint_as_float(b[1]);
}
template <class T> __device__ __forceinline__ T bperm_(T v, int srclane) { return __builtin_bit_cast(T, __builtin_amdgcn_ds_bpermute(srclane << 2, __builtin_bit_cast(int, v))); }
#define SHX(v, o) bperm_((v), lane ^ (o))
#define SHUP(v, o) bperm_((v), (lane >= (o)) ? lane - (o) : lane)
#define SHIDX(v, src) bperm_((v), (src))
__device__ __forceinline__ float wave_sum(float v, int lane) {
#pragma unroll
    for (int o = 1; o < 64; o <<= 1) v += SHX(v, o);
    return v;
}
__device__ __forceinline__ float sigmoidf_(float x) { return 1.0f / (1.0f + __expf(-x)); }
__device__ __forceinline__ float gelu_tanh(float x) {
    const float a = 0.7978845608028654f * (x + 0.044715f * x * x * x);
    const float e = __expf(2.0f * a);
    const float t = 1.0f - 2.0f / (e + 1.0f);
    return 0.5f * x * (1.0f + t);
}
__device__ __forceinline__ f32x4 mfma16(bf16x8 a, bf16x8 b, f32x4 c) { return __builtin_amdgcn_mfma_f32_16x16x32_bf16(a, b, c, 0, 0, 0); }
__device__ __forceinline__ bf16x8 lds_frag(ldsp lds, int byteoff) { return *(const LAS bf16x8*)(lds + byteoff); }
__device__ __forceinline__ bf16x8 pack8(const float* v) {
    u32x4 w; w.x = cvt_pk_bf16(v[0], v[1]); w.y = cvt_pk_bf16(v[2], v[3]); w.z = cvt_pk_bf16(v[4], v[5]); w.w = cvt_pk_bf16(v[6], v[7]);
    return __builtin_bit_cast(bf16x8, w);
}
__device__ __forceinline__ void unpack8(u32x4 w, float* v) {
    v[0] = __uint_as_float(w.x << 16); v[1] = __uint_as_float(w.x & 0xffff0000u);
    v[2] = __uint_as_float(w.y << 16); v[3] = __uint_as_float(w.y & 0xffff0000u);
    v[4] = __uint_as_float(w.z << 16); v[5] = __uint_as_float(w.z & 0xffff0000u);
    v[6] = __uint_as_float(w.w << 16); v[7] = __uint_as_float(w.w & 0xffff0000u);
}

namespace pg8 {
#define PG8_LAS __attribute__((address_space(3)))
constexpr int BM = 256, BK = 64, HALF = 128, HTB = HALF * BK * 2, STAGE_BYTES = 8 * HTB, NXCD = 8, WGM = 8;
__host__ __device__ __forceinline__ int lds_byte(int r, int c) { const int st = (r >> 4) * 2 + (c >> 5), rr = r & 15, cc = c & 31, ob = rr * 64 + cc * 2; return st * 1024 + (ob ^ (((ob >> 9) & 1) << 5)); }
__host__ __device__ __forceinline__ void stage_rc(int b, int& R, int& C) { const int st = b / 1024, sb = b % 1024, swz = sb ^ (((sb >> 9) & 1) << 5); R = (st >> 1) * 16 + swz / 64; C = (st & 1) * 32 + (swz % 64) / 2; }
__host__ __device__ __forceinline__ int perm32(int rho) { const int n = rho >> 4, i = rho & 15; return 8 * (i >> 2) + 4 * n + (i & 3); }
struct Unit { int pm, pn; };
struct Gemm { const bf16_t* A; const bf16_t* Bt; int M, N, K; };
struct StaticOrder {
    int nM, nN, nwg, G, c;
    __host__ __device__ void init(int M, int N, int G_, int c_) { nM = M / BM; nN = N / BM; nwg = nM * nN; G = G_; c = c_; }
    __host__ __device__ bool next(int i, Unit& u) const {
        const long L = (long)i * G + c; if (L >= nwg) return false;
        int wgid = (int)L; { const int q = nwg / NXCD, r = nwg % NXCD, xcd = wgid % NXCD, off = wgid / NXCD; wgid = (xcd < r ? xcd * (q + 1) : r * (q + 1) + (xcd - r) * q) + off; }
        const int nig = WGM * nN, gid = wgid / nig, fm = gid * WGM, gsz = (nM - fm) < WGM ? (nM - fm) : WGM;
        u.pm = fm + ((wgid % nig) % gsz); u.pn = (wgid % nig) / gsz; return true;
    }
    __device__ __forceinline__ void a_ready(const Unit&) const {}
    __device__ __forceinline__ void done(const Unit&) const {}
};
template <int ACT  > struct EpiBf16 {
    static constexpr bool PERM = true, AFTER_DRAIN = false;
    bf16_t* O; int ldc; float* gate; int gate_pn;
    __device__ __forceinline__ void operator()(const f32x4 (&acc)[2][2][4][2], const Unit& u, int wr, int wc, int fr, int fq) const {
        const int row0 = u.pm * BM + wr * 64 + fr;
        if (u.pn == gate_pn) {
            if (wc == 0) {
#pragma unroll
                for (int ai = 0; ai < 2; ++ai)
#pragma unroll
                    for (int m = 0; m < 4; ++m) { float* gp = gate + (size_t)(row0 + ai * HALF + m * 16) * 32 + 8 * fq;
                        *(f32x4*)(gp) = acc[ai][0][m][0]; *(f32x4*)(gp + 4) = acc[ai][0][m][1]; }
            }
            return;
        }
        const int col0 = u.pn * BM + wc * 32 + 8 * fq;
#pragma unroll
        for (int ai = 0; ai < 2; ++ai)
#pragma unroll
            for (int m = 0; m < 4; ++m) { bf16_t* rowp = O + (size_t)(row0 + ai * HALF + m * 16) * ldc + col0;
#pragma unroll
                for (int bj = 0; bj < 2; ++bj) { f32x4 v0 = acc[ai][bj][m][0], v1 = acc[ai][bj][m][1];
                    if (ACT == 2) {
#pragma unroll
                        for (int e = 0; e < 4; ++e) { float a = fmaxf(v0[e], 0.f); v0[e] = a * a; float b = fmaxf(v1[e], 0.f); v1[e] = b * b; }
                    }
                    u32x4 w; w.x = cvt_pk_bf16(v0[0], v0[1]); w.y = cvt_pk_bf16(v0[2], v0[3]); w.z = cvt_pk_bf16(v1[0], v1[1]); w.w = cvt_pk_bf16(v1[2], v1[3]);
                    *(u32x4*)(rowp + bj * HALF) = w; } }
    }
};

template <class Epi, class Sched, bool ALIGN_EPI = false, bool SP2 = false>
__device__ __forceinline__ void gemm_phase(PG8_LAS unsigned char* lds, const Gemm g, const Sched& S, const Epi& E, const int tid) {
    const int wid = __builtin_amdgcn_readfirstlane(tid >> 6), lane = tid & 63, wr = wid >> 2, wc = wid & 3, fr = lane & 15, fq = lane >> 4;
    const int K = g.K, nt = K / BK;
    unsigned voffA[2], voffB[2];
#pragma unroll
    for (int i = 0; i < 2; ++i) { int R, C; stage_rc(tid * 16 + i * 8192, R, C); const int Rb = Epi::PERM ? ((R & ~31) + perm32(R & 31)) : R;
        voffA[i] = (unsigned)(R * K + C) * 2u; voffB[i] = (unsigned)(Rb * K + C) * 2u; }
    const size_t kstep = (size_t)(BK * 2);
    const size_t hstep = (size_t)HALF * K * 2;
    const size_t tstep = 2 * hstep;
    const unsigned ldsw = (unsigned)wid * 1024u;
    const int aoff = lds_byte(wr * 64 + fr, fq * 8), boff = lds_byte(wc * 32 + fr, fq * 8);
#define PG8_SA(b, h) (((b) * 2 + (h)) * HTB)
#define PG8_SB(b, h) ((4 + (b) * 2 + (h)) * HTB)
#define PG8_STAGE(bufoff, gbase, voff) do { _Pragma("unroll") for (int _i = 0; _i < 2; ++_i) \
        __builtin_amdgcn_global_load_lds((const unsigned*)((const char*)(gbase) + (voff)[_i]), (PG8_LAS ual_t*)(lds + (bufoff) + ldsw + _i * 8192), 16, 0, 0); } while (0)
#define PG8_LDA(dst, b, h) do { _Pragma("unroll") for (int m = 0; m < 4; ++m) _Pragma("unroll") for (int k = 0; k < 2; ++k) dst[m][k] = *(const PG8_LAS bf16x8*)(lds + PG8_SA(b, h) + aoff + m * 2048 + k * 1024); } while (0)
#define PG8_LDB(dst, b, h) do { _Pragma("unroll") for (int n = 0; n < 2; ++n) _Pragma("unroll") for (int k = 0; k < 2; ++k) dst[n][k] = *(const PG8_LAS bf16x8*)(lds + PG8_SB(b, h) + boff + n * 2048 + k * 1024); } while (0)
#define PG8_MMA(ai, bj, At, Bt) do { __builtin_amdgcn_s_setprio(1); _Pragma("unroll") for (int m = 0; m < 4; ++m) _Pragma("unroll") for (int n = 0; n < 2; ++n) _Pragma("unroll") for (int k = 0; k < 2; ++k) \
        acc[ai][bj][m][n] = __builtin_amdgcn_mfma_f32_16x16x32_bf16(Bt[n][k], At[m][k], acc[ai][bj][m][n], 0, 0, 0); __builtin_amdgcn_s_setprio(0); } while (0)
#define PG8_WAIT_V(n) asm volatile("s_waitcnt vmcnt(" #n ")" ::: "memory")
#define PG8_WAIT_L(n) asm volatile("s_waitcnt lgkmcnt(" #n ")" ::: "memory")
#define PG8_BAR __builtin_amdgcn_s_barrier()
#define PG8_SCHED __builtin_amdgcn_sched_barrier(0)
    Unit cur, nxt; int ui = 0;
    if (!S.next(0, cur)) return;
    f32x4 acc[2][2][4][2];
#pragma unroll
    for (int a = 0; a < 2; ++a)
#pragma unroll
        for (int b = 0; b < 2; ++b)
#pragma unroll
            for (int m = 0; m < 4; ++m)
#pragma unroll
                for (int n = 0; n < 2; ++n) acc[a][b][m][n] = (f32x4){0.f, 0.f, 0.f, 0.f};
    bf16x8 At[4][2], B0[2][2], B1[2][2];
    const char* cA = (const char*)g.A + (size_t)cur.pm * tstep; const char* cB = (const char*)g.Bt + (size_t)cur.pn * tstep;
    S.a_ready(cur);
    if constexpr (SP2) {
        PG8_STAGE(PG8_SB(0, 0), cB, voffB); PG8_STAGE(PG8_SB(0, 1), cB + hstep, voffB); PG8_STAGE(PG8_SA(0, 0), cA, voffA); PG8_STAGE(PG8_SA(0, 1), cA + hstep, voffA);
        if (wr == 1) PG8_BAR;
        PG8_WAIT_V(2); PG8_BAR;
        PG8_STAGE(PG8_SB(1, 0), cB + kstep, voffB); PG8_STAGE(PG8_SA(1, 0), cA + kstep, voffA); PG8_STAGE(PG8_SB(1, 1), cB + hstep + kstep, voffB);
        PG8_WAIT_V(6); PG8_BAR;
    } else {
        PG8_STAGE(PG8_SB(0, 0), cB, voffB); PG8_STAGE(PG8_SA(0, 0), cA, voffA); PG8_STAGE(PG8_SB(0, 1), cB + hstep, voffB); PG8_STAGE(PG8_SA(0, 1), cA + hstep, voffA);
        if (wr == 1) PG8_BAR;
        PG8_WAIT_V(4); PG8_BAR;
        PG8_STAGE(PG8_SB(1, 0), cB + kstep, voffB); PG8_STAGE(PG8_SA(1, 0), cA + kstep, voffA); PG8_STAGE(PG8_SB(1, 1), cB + hstep + kstep, voffB);
        PG8_WAIT_V(6); PG8_BAR;
    }
    for (;;) {
        const bool has_next = S.next(ui + 1, nxt);
        const char* nA = has_next ? (const char*)g.A + (size_t)nxt.pm * tstep : cA; const char* nB = has_next ? (const char*)g.Bt + (size_t)nxt.pn * tstep : cB;
        for (int t = 0; t < nt; t += 2) {
            const bool last = (t == nt - 2);
            const char* a1 = cA + (size_t)(t + 1) * kstep;
            const char* a2 = last ? nA : cA + (size_t)(t + 2) * kstep; const char* b2 = last ? nB : cB + (size_t)(t + 2) * kstep;
            const char* a3 = a2 + kstep; const char* b3 = b2 + kstep;
            if (last && has_next) S.a_ready(nxt);
            if constexpr (SP2) {
            PG8_LDB(B0, 0, 0); PG8_LDB(B1, 0, 1); PG8_SCHED; PG8_LDA(At, 0, 0); PG8_STAGE(PG8_SA(1, 1), a1 + hstep, voffA);
            PG8_WAIT_V(8); PG8_WAIT_L(0); PG8_BAR; PG8_MMA(0, 0, At, B0); PG8_MMA(0, 1, At, B1); PG8_BAR; PG8_SCHED;
            PG8_LDA(At, 0, 1); PG8_STAGE(PG8_SB(0, 0), b2, voffB); PG8_STAGE(PG8_SB(0, 1), b2 + hstep, voffB); PG8_STAGE(PG8_SA(0, 0), a2, voffA);
            PG8_WAIT_V(8); PG8_WAIT_L(0); PG8_BAR; PG8_MMA(1, 0, At, B0); PG8_MMA(1, 1, At, B1); PG8_BAR; PG8_SCHED;
            PG8_LDB(B0, 1, 0); PG8_LDB(B1, 1, 1); PG8_SCHED; PG8_LDA(At, 1, 0); PG8_STAGE(PG8_SA(0, 1), a2 + hstep, voffA);
            PG8_WAIT_V(8); PG8_WAIT_L(0); PG8_BAR; PG8_MMA(0, 0, At, B0); PG8_MMA(0, 1, At, B1); PG8_BAR; PG8_SCHED;
            PG8_LDA(At, 1, 1); PG8_STAGE(PG8_SB(1, 0), b3, voffB); PG8_STAGE(PG8_SB(1, 1), b3 + hstep, voffB); PG8_STAGE(PG8_SA(1, 0), a3, voffA);
            PG8_WAIT_V(8); PG8_WAIT_L(0); PG8_BAR; PG8_MMA(1, 0, At, B0); PG8_MMA(1, 1, At, B1); PG8_BAR; PG8_SCHED;
            } else {
            PG8_LDB(B0, 0, 0); PG8_SCHED; PG8_LDA(At, 0, 0); PG8_STAGE(PG8_SA(1, 1), a1 + hstep, voffA);
            PG8_WAIT_L(8); PG8_BAR; PG8_WAIT_L(0); PG8_MMA(0, 0, At, B0); PG8_BAR; PG8_SCHED;
            PG8_LDB(B1, 0, 1); PG8_STAGE(PG8_SB(0, 0), b2, voffB);
            PG8_BAR; PG8_WAIT_L(0); PG8_MMA(0, 1, At, B1); PG8_BAR;
            PG8_LDA(At, 0, 1); PG8_STAGE(PG8_SA(0, 0), a2, voffA);
            PG8_BAR; PG8_WAIT_L(0); PG8_MMA(1, 0, At, B0); PG8_BAR; PG8_SCHED;
            PG8_STAGE(PG8_SB(0, 1), b2 + hstep, voffB);
            PG8_WAIT_V(6); PG8_BAR; PG8_MMA(1, 1, At, B1); PG8_BAR;
            PG8_LDB(B0, 1, 0); PG8_SCHED; PG8_LDA(At, 1, 0); PG8_STAGE(PG8_SA(0, 1), a2 + hstep, voffA);
            PG8_WAIT_L(8); PG8_BAR; PG8_WAIT_L(0); PG8_MMA(0, 0, At, B0); PG8_BAR; PG8_SCHED;
            PG8_LDB(B1, 1, 1); PG8_STAGE(PG8_SB(1, 0), b3, voffB);
            PG8_BAR; PG8_WAIT_L(0); PG8_MMA(0, 1, At, B1); PG8_BAR;
            PG8_LDA(At, 1, 1); PG8_STAGE(PG8_SA(1, 0), a3, voffA);
            PG8_BAR; PG8_WAIT_L(0); PG8_MMA(1, 0, At, B0); PG8_BAR; PG8_SCHED;
            PG8_STAGE(PG8_SB(1, 1), b3 + hstep, voffB);
            PG8_WAIT_V(6); PG8_BAR; PG8_MMA(1, 1, At, B1); PG8_BAR;
            }
        }
        if constexpr (ALIGN_EPI) { if (wr == 0) PG8_BAR; }
        if constexpr (!Epi::AFTER_DRAIN) { E(acc, cur, wr, wc, fr, fq); S.done(cur); }
        if (!has_next) break;
#pragma unroll
        for (int a = 0; a < 2; ++a)
#pragma unroll
            for (int b = 0; b < 2; ++b)
#pragma unroll
                for (int m = 0; m < 4; ++m)
#pragma unroll
                    for (int n = 0; n < 2; ++n) acc[a][b][m][n] = (f32x4){0.f, 0.f, 0.f, 0.f};
        cur = nxt; cA = nA; cB = nB; ++ui;
        if constexpr (ALIGN_EPI) { if (wr == 1) PG8_BAR; }
    }
    PG8_WAIT_V(0);
    if constexpr (!ALIGN_EPI) { if (wr == 0) PG8_BAR; }
    PG8_BAR;
#undef PG8_SA
#undef PG8_SB
#undef PG8_STAGE
#undef PG8_LDA
#undef PG8_LDB
#undef PG8_MMA
#undef PG8_WAIT_V
#undef PG8_WAIT_L
#undef PG8_BAR
#undef PG8_SCHED
}
}

struct Params {
    const float* in[31];
    float* out;
    unsigned char* ws;
    int hb16;
    int pad;
};
typedef const __attribute__((address_space(4))) Params* KP;
enum { I_X = 0, I_POS, I_LN_MIX_PRE, I_LN_MIX_POST, I_LN_MLP_PRE, I_LN_MLP_POST, I_W_IN, I_W_OUT, I_LAM_RE, I_LAM_IM, I_B_RE, I_B_IM, I_C_RE, I_C_IM,
       I_SSM_D, I_LOG_DT, I_W_GLU, I_CONV, I_B_I, I_B_F, I_PE_K, I_W1_K, I_W2_K, I_PE_V, I_W1_V, I_W2_V, I_GN_SSM, I_GN_MLSTM, I_GN_NSA, I_MLP_W1, I_MLP_W2 };

constexpr int LDS_BYTES = 147456;
constexpr int MISC_OFF = 131072 + 8192;

__device__ __forceinline__ int win_src_col(int n) {
    if (n < 1280) return n;
    if (n < 2560) return n + 8;
    if (n < 2568) return n - 2560 + 1280;
    if (n < 2592) return n;
    return -1;
}
__device__ __forceinline__ void conv_item(const float* W, int K, int N, bf16_t* WT, int mode, int nblk, LAS fal_t* scr, int item, int lane) {
    const int kb = item / nblk, nb = item % nblk, k0 = 64 * kb, n0 = 64 * nb;
    const int nn = n0 + lane;
    const int sc = mode ? win_src_col(nn) : nn;
    const float* src = W + (size_t)k0 * N + (sc >= 0 ? sc : 0);
    float vv[64];
#pragma unroll
    for (int kk = 0; kk < 64; ++kk) vv[kk] = src[(size_t)kk * N];
#pragma unroll
    for (int kk = 0; kk < 64; ++kk) scr[kk * 65 + lane] = (sc >= 0) ? vv[kk] : 0.f;
    asm volatile("s_waitcnt lgkmcnt(0)" ::: "memory");
    const int c = lane & 7;
#pragma unroll
    for (int j = 0; j < 8; ++j) { const int n = (lane >> 3) + 8 * j; const LAS fal_t* sp = scr + (8 * c) * 65 + n;
        u32x4 o; o.x = cvt_pk_bf16(sp[0 * 65], sp[1 * 65]); o.y = cvt_pk_bf16(sp[2 * 65], sp[3 * 65]); o.z = cvt_pk_bf16(sp[4 * 65], sp[5 * 65]); o.w = cvt_pk_bf16(sp[6 * 65], sp[7 * 65]);
        *(u32x4*)(WT + (size_t)(n0 + n) * K + k0 + 8 * c) = o; }
    asm volatile("s_waitcnt lgkmcnt(0)" ::: "memory");
}

__device__ __forceinline__ void convert_layer(KP P, int l, ldsp lds, int gw, int NGW, int wave, int lane) {
    LAS fal_t* scr = (LAS fal_t*)(lds + wave * 16640);
    unsigned char* ws = P->ws;
    constexpr int I0 = 16 * 44, I1 = 16 * 16, I2 = 16 * 64, I3 = 64 * 16, I4 = 4 * 4, I5 = 32 * 4, I6 = 32 * 4, I7 = 4 * 1, I8 = 4 * 1, I9 = 128, I10 = 16;
    constexpr int NIT = I0 + I1 + I2 + I3 + I4 + I5 + I6 + I7 + I8 + I9 + I10;
    for (int it = gw; it < NIT; it += NGW) {
        int r = it;
        if (r < I0) { conv_item(P->in[I_W_IN] + (size_t)l * DM * DIN, DM, DIN, (bf16_t*)(ws + WS_WIN), 1, 44, scr, r, lane); continue; } r -= I0;
        if (r < I1) { conv_item(P->in[I_W_OUT] + (size_t)l * DM * DM, DM, DM, (bf16_t*)(ws + WS_WOUT), 0, 16, scr, r, lane); continue; } r -= I1;
        if (r < I2) { conv_item(P->in[I_MLP_W1] + (size_t)l * DM * DFF, DM, DFF, (bf16_t*)(ws + WS_W1), 0, 64, scr, r, lane); continue; } r -= I2;
        if (r < I3) { conv_item(P->in[I_MLP_W2] + (size_t)l * DFF * DM, DFF, DM, (bf16_t*)(ws + WS_W2), 0, 16, scr, r, lane); continue; } r -= I3;
        if (r < I4) { conv_item(P->in[I_W_GLU] + (size_t)l * 256 * 256, 256, 256, (bf16_t*)(ws + WS_WGLU), 0, 4, scr, r, lane); continue; } r -= I4;
        if (r < I5) { conv_item(P->in[I_W1_K] + (size_t)l * 2048 * 256, 2048, 256, (bf16_t*)(ws + WS_CW1K), 0, 4, scr, r, lane); continue; } r -= I5;
        if (r < I6) { conv_item(P->in[I_W1_V] + (size_t)l * 2048 * 256, 2048, 256, (bf16_t*)(ws + WS_CW1V), 0, 4, scr, r, lane); continue; } r -= I6;
        if (r < I7) { conv_item(P->in[I_W2_K] + (size_t)l * 256 * 64, 256, 64, (bf16_t*)(ws + WS_CW2K), 0, 1, scr, r, lane); continue; } r -= I7;
        if (r < I8) { conv_item(P->in[I_W2_V] + (size_t)l * 256 * 64, 256, 64, (bf16_t*)(ws + WS_CW2V), 0, 1, scr, r, lane); continue; } r -= I8;
        if (r >= I9) {
            const int g = r - I9, p = lane;
            const float dt = expf(P->in[I_LOG_DT][l * 16 + g]);
            const float lr = P->in[I_LAM_RE][(l * 16 + g) * 64 + p], li = P->in[I_LAM_IM][(l * 16 + g) * 64 + p];
            const float mag = expf(lr * dt), ang = li * dt;
            const float ar = mag * cosf(ang), ai = mag * sinf(ang);
            const float den = lr * lr + li * li;
            const float gr = ((ar - 1.0f) * lr + ai * li) / den, gi = (ai * lr - (ar - 1.0f) * li) / den;
            float pr = ar, pi = ai;
#pragma unroll
            for (int q = 0; q < 4; ++q) { const float nr = pr * pr - pi * pi, ni = 2.f * pr * pi; pr = nr; pi = ni; }
            const float p16r = pr, p16i = pi;
#pragma unroll
            for (int q = 0; q < 2; ++q) { const float nr = pr * pr - pi * pi, ni = 2.f * pr * pi; pr = nr; pi = ni; }
            float* tf = (float*)(ws + WS_S5T) + (size_t)(g * 64 + p) * 8;
            *(f32x4*)tf = (f32x4){ar, ai, p16r, p16i}; *(f32x4*)(tf + 4) = (f32x4){pr, pi, 0.f, 0.f};
            const float* br = P->in[I_B_RE] + ((size_t)(l * 16 + g) * 64 + p) * 16;
            const float* bi = P->in[I_B_IM] + ((size_t)(l * 16 + g) * 64 + p) * 16;
            float vr[16], vi[16];
#pragma unroll
            for (int q = 0; q < 4; ++q) { const f32x4 a = *(const f32x4*)(br + 4 * q), b = *(const f32x4*)(bi + 4 * q);
#pragma unroll
                for (int e = 0; e < 4; ++e) { vr[4 * q + e] = gr * a[e] - gi * b[e]; vi[4 * q + e] = gr * b[e] + gi * a[e]; } }
            bf16_t* tb = (bf16_t*)(ws + WS_S5T + 32768) + (size_t)(g * 64 + p) * 32;
            *(bf16x8*)tb = pack8(vr); *(bf16x8*)(tb + 8) = pack8(vr + 8); *(bf16x8*)(tb + 16) = pack8(vi); *(bf16x8*)(tb + 24) = pack8(vi + 8);
            continue;
        }
        {
            const int kv = r >> 6, hid = ((r >> 4) & 3) * 64 + lane, kc = r & 15;
            const float* pe = P->in[kv ? I_PE_V : I_PE_K] + (size_t)l * 2048 + kc * 128;
            const float* w1 = P->in[kv ? I_W1_V : I_W1_K] + (size_t)l * 2048 * 256 + (size_t)kc * 128 * 256;
            float a0 = 0.f, a1 = 0.f, a2 = 0.f, a3 = 0.f;
#pragma unroll 1
            for (int k0 = 0; k0 < 128; k0 += 32) {
                float wv[32];
#pragma unroll
                for (int k = 0; k < 32; ++k) wv[k] = w1[(size_t)(k0 + k) * 256 + hid];
#pragma unroll
                for (int k = 0; k < 32; k += 4) { a0 += pe[k0 + k] * wv[k]; a1 += pe[k0 + k + 1] * wv[k + 1]; a2 += pe[k0 + k + 2] * wv[k + 2]; a3 += pe[k0 + k + 3] * wv[k + 3]; }
            }
            ((float*)(ws + WS_CB1))[kc * 512 + kv * 256 + hid] = (a0 + a1) + (a2 + a3);
        }
    }
}

__device__ __forceinline__ void norm_pass(const float* xin, const bf16_t* f, const float* gpost, const float* gpre, float* h32, bf16_t* hb, float* out32, bf16_t* u, int gw, int NGW, int lane) {
    constexpr int R = 4;
    for (int mb = gw; mb < MTOK; mb += R * NGW) {
        f32x4 hv[R][4], fv[R][4];
        bool ok[R];
#pragma unroll
        for (int r = 0; r < R; ++r) {
            const int m = mb + r * NGW; ok[r] = m < MTOK;
            const size_t off = (size_t)(ok[r] ? m : mb) * DM + 4 * lane;
            if (f == nullptr) {
#pragma unroll
                for (int j = 0; j < 4; ++j) hv[r][j] = *(const f32x4*)(xin + off + 256 * j);
            } else {
#pragma unroll
                for (int j = 0; j < 4; ++j) {
                    if (hb) { const u32x2 hw = *(const u32x2*)(hb + off + 256 * j);
                        hv[r][j] = (f32x4){__uint_as_float(hw.x << 16), __uint_as_float(hw.x & 0xffff0000u), __uint_as_float(hw.y << 16), __uint_as_float(hw.y & 0xffff0000u)}; }
                    else hv[r][j] = *(const f32x4*)(h32 + off + 256 * j);
                    const u32x2 w = *(const u32x2*)(f + off + 256 * j);
                    fv[r][j] = (f32x4){__uint_as_float(w.x << 16), __uint_as_float(w.x & 0xffff0000u), __uint_as_float(w.y << 16), __uint_as_float(w.y & 0xffff0000u)};
                }
            }
        }
        if (f != nullptr) {
            float ss[R];
#pragma unroll
            for (int r = 0; r < R; ++r) { ss[r] = 0.f;
#pragma unroll
                for (int j = 0; j < 4; ++j) ss[r] += fv[r][j][0] * fv[r][j][0] + fv[r][j][1] * fv[r][j][1] + fv[r][j][2] * fv[r][j][2] + fv[r][j][3] * fv[r][j][3]; }
#pragma unroll
            for (int o = 1; o < 64; o <<= 1) {
#pragma unroll
                for (int r = 0; r < R; ++r) ss[r] += SHX(ss[r], o); }
#pragma unroll
            for (int r = 0; r < R; ++r) { const float rs = rsqrtf(ss[r] * (1.0f / DM) + EPS);
#pragma unroll
                for (int j = 0; j < 4; ++j) { const f32x4 g = *(const f32x4*)(gpost + 4 * lane + 256 * j); hv[r][j] += fv[r][j] * rs * g; } }
        }
#pragma unroll
        for (int r = 0; r < R; ++r) {
            const size_t off = (size_t)(mb + r * NGW) * DM + 4 * lane;
            if (ok[r] && out32) {
#pragma unroll
                for (int j = 0; j < 4; ++j) *(f32x4*)(out32 + off + 256 * j) = hv[r][j];
            }
            if (ok[r] && hb && gpre) {
#pragma unroll
                for (int j = 0; j < 4; ++j) { u32x2 w; w.x = cvt_pk_bf16(hv[r][j][0], hv[r][j][1]); w.y = cvt_pk_bf16(hv[r][j][2], hv[r][j][3]); *(u32x2*)(hb + off + 256 * j) = w; }
            }
        }
        if (gpre) {
            float ss[R];
#pragma unroll
            for (int r = 0; r < R; ++r) { ss[r] = 0.f;
#pragma unroll
                for (int j = 0; j < 4; ++j) ss[r] += hv[r][j][0] * hv[r][j][0] + hv[r][j][1] * hv[r][j][1] + hv[r][j][2] * hv[r][j][2] + hv[r][j][3] * hv[r][j][3]; }
#pragma unroll
            for (int o = 1; o < 64; o <<= 1) {
#pragma unroll
                for (int r = 0; r < R; ++r) ss[r] += SHX(ss[r], o); }
#pragma unroll
            for (int r = 0; r < R; ++r) { const float rs = rsqrtf(ss[r] * (1.0f / DM) + EPS);
                const size_t off = (size_t)(mb + r * NGW) * DM + 4 * lane;
                if (ok[r]) {
#pragma unroll
                    for (int j = 0; j < 4; ++j) { const f32x4 g = *(const f32x4*)(gpre + 4 * lane + 256 * j); const f32x4 o = hv[r][j] * rs * g;
                        u32x2 w; w.x = cvt_pk_bf16(o[0], o[1]); w.y = cvt_pk_bf16(o[2], o[3]); *(u32x2*)(u + off + 256 * j) = w; } } }
        }
    }
}

struct S5H { float ar[2], ai[2], p16r[2], p16i[2]; bf16x8 Bf[4]; };
__device__ __forceinline__ void s5h_setup(KP P, int l, int g, int r16, int g4, int half, S5H& s) {
    const float* tf = (const float*)(P->ws + WS_S5T);
    const bf16_t* tb = (const bf16_t*)(P->ws + WS_S5T + 32768);
#pragma unroll
    for (int ii = 0; ii < 2; ++ii) {
        const int p = 16 * (2 * half + ii) + r16;
        const f32x4 t0 = *(const f32x4*)(tf + (size_t)(g * 64 + p) * 8);
        s.ar[ii] = t0[0]; s.ai[ii] = t0[1]; s.p16r[ii] = t0[2]; s.p16i[ii] = t0[3];
        u32x4 wr = (u32x4){0u, 0u, 0u, 0u}, wi = (u32x4){0u, 0u, 0u, 0u};
        if (g4 < 2) { wr = *(const u32x4*)(tb + (size_t)(g * 64 + p) * 32 + 8 * g4); wi = *(const u32x4*)(tb + (size_t)(g * 64 + p) * 32 + 16 + 8 * g4); }
        s.Bf[ii] = __builtin_bit_cast(bf16x8, wr); s.Bf[2 + ii] = __builtin_bit_cast(bf16x8, wi);
    }
}
__device__ __forceinline__ void s5_load_u(const bf16_t* z, int m0, int g, bf16x8 (&Af)[4], int r16, int g4) {
#pragma unroll
    for (int mf = 0; mf < 4; ++mf) {
        const int tok = 16 * (r16 >> 2) + 4 * mf + (r16 & 3);
        u32x4 w = (u32x4){0u, 0u, 0u, 0u};
        if (g4 < 2) w = *(const u32x4*)(z + (size_t)(m0 + tok) * ZLD + ZC_SU + g * 16 + 8 * g4);
        Af[mf] = __builtin_bit_cast(bf16x8, w);
    }
}
__device__ __forceinline__ void s5h_bu(const bf16x8 (&Af)[4], const S5H& s, f32x4 (&C)[4][4]) {
#pragma unroll
    for (int mf = 0; mf < 4; ++mf)
#pragma unroll
        for (int j = 0; j < 4; ++j) C[mf][j] = mfma16(Af[mf], s.Bf[j], (f32x4){0.f, 0.f, 0.f, 0.f});
}
#define CMUL_R(ar_, ai_, br_, bi_) ((ar_) * (br_) - (ai_) * (bi_))
#define CMUL_I(ar_, ai_, br_, bi_) ((ar_) * (bi_) + (ai_) * (br_))

__device__ __forceinline__ void s5_stage1(KP P, int l, int bitem, ldsp lds, int wave, int lane) {
    const int wi = bitem * 8 + wave;
    const int c = wi & 31, g = (wi >> 5) & 15, b = wi >> 9;
    const int r16 = lane & 15, g4 = lane >> 4;
    const bf16_t* z = (const bf16_t*)(P->ws + WS_Z);
    bf16x8 Af[4]; s5_load_u(z, b * SEQ + c * 64, g, Af, r16, g4);
    float* E = (float*)(P->ws + WS_S5E) + (size_t)wi * 128;
#pragma nounroll
    for (int half = 0; half < 2; ++half) {
        S5H s; s5h_setup(P, l, g, r16, g4, half, s);
        f32x4 C[4][4];
        s5h_bu(Af, s, C);
#pragma unroll
        for (int ii = 0; ii < 2; ++ii) {
            const float ar = s.ar[ii], ai = s.ai[ii];
            float xr = 0.f, xi = 0.f;
#pragma unroll
            for (int k = 0; k < 16; ++k) { const float bur = C[k >> 2][ii][k & 3], bui = C[k >> 2][2 + ii][k & 3];
                const float nr = ar * xr - ai * xi + bur, ni = ar * xi + ai * xr + bui; xr = nr; xi = ni; }
            const float pr = s.p16r[ii], pi = s.p16i[ii];
            const float p2r = CMUL_R(pr, pi, pr, pi), p2i = CMUL_I(pr, pi, pr, pi), p3r = CMUL_R(p2r, p2i, pr, pi), p3i = CMUL_I(p2r, p2i, pr, pi);
            const float wr = g4 == 3 ? 1.f : (g4 == 2 ? pr : (g4 == 1 ? p2r : p3r)), wim = g4 == 3 ? 0.f : (g4 == 2 ? pi : (g4 == 1 ? p2i : p3i));
            const float er = xsum16_32(CMUL_R(wr, wim, xr, xi)), ei = xsum16_32(CMUL_I(wr, wim, xr, xi));
            const int p = 16 * (2 * half + ii) + r16;
            if (g4 == 0) { __hip_atomic_store(&E[p], er, __ATOMIC_RELAXED, __HIP_MEMORY_SCOPE_AGENT); __hip_atomic_store(&E[64 + p], ei, __ATOMIC_RELAXED, __HIP_MEMORY_SCOPE_AGENT); }
        }
    }
    asm volatile("s_waitcnt vmcnt(0)" ::: "memory");
    unsigned old = 0u;
    if (lane == 0) old = __hip_atomic_fetch_add((unsigned*)(P->ws + WS_CTL) + 12288 + (l * 128 + b * 16 + g) * 4, 1u, __ATOMIC_RELAXED, __HIP_MEMORY_SCOPE_AGENT);
    old = (unsigned)__builtin_amdgcn_readfirstlane((int)old);
    if (old == 31u) {
        __builtin_amdgcn_fence(__ATOMIC_ACQUIRE, "agent");
        asm volatile("s_waitcnt vmcnt(0)" ::: "memory");
        float* Er = (float*)(P->ws + WS_S5E) + (size_t)((b * 16 + g) * 32) * 128;
        const f32x4 t1 = *(const f32x4*)((const float*)(P->ws + WS_S5T) + (size_t)(g * 64 + lane) * 8 + 4);
        const float qr = t1[0], qi = t1[1];
        float xr = 0.f, xi = 0.f;
#pragma unroll 1
        for (int c0 = 0; c0 < 32; c0 += 16) {
            float er[16], ei[16];
#pragma unroll
            for (int q = 0; q < 16; ++q) { er[q] = Er[(c0 + q) * 128 + lane]; ei[q] = Er[(c0 + q) * 128 + 64 + lane]; }
#pragma unroll
            for (int q = 0; q < 16; ++q) { Er[(c0 + q) * 128 + lane] = xr; Er[(c0 + q) * 128 + 64 + lane] = xi;
                const float nr = CMUL_R(qr, qi, xr, xi) + er[q], ni = CMUL_I(qr, qi, xr, xi) + ei[q]; xr = nr; xi = ni; }
        }
    }
}

__device__ __forceinline__ void s5_stage2(KP P, int l, int bitem, ldsp lds, int wave, int lane) {
    const int c = bitem & 31, b = bitem >> 5;
    const bf16_t* z = (const bf16_t*)(P->ws + WS_Z);
    constexpr int YLD = 264;
    const int Y_OFF = 0, XS_OFF = 34816 + wave * 4352;
    const int r16 = lane & 15, g4 = lane >> 4;
    const int m0 = b * SEQ + c * 64;
#pragma nounroll
    for (int gi = 0; gi < 2; ++gi) {
        const int g = 2 * wave + gi;
        bf16x8 Af[4]; s5_load_u(z, m0, g, Af, r16, g4);
        const float dsk = P->in[I_SSM_D][l * 256 + g * 16 + r16];
        const float* E = (const float*)(P->ws + WS_S5E) + (size_t)((b * 16 + g) * 32) * 128;
        const float* cre = P->in[I_C_RE] + ((size_t)(l * 16 + g) * 16 + r16) * 64;
        const float* cim = P->in[I_C_IM] + ((size_t)(l * 16 + g) * 16 + r16) * 64;
        f32x4 acc[4];
#pragma unroll
        for (int q = 0; q < 4; ++q) acc[q] = (f32x4){0.f, 0.f, 0.f, 0.f};
#pragma nounroll
        for (int half = 0; half < 2; ++half) {
            S5H s; s5h_setup(P, l, g, r16, g4, half, s);
            bf16x8 Cf[2];
#pragma unroll
            for (int ks = 0; ks < 2; ++ks) {
                const f32x4 a = *(const f32x4*)(cre + 32 * half + 16 * ks + 4 * g4), bq = *(const f32x4*)(cim + 32 * half + 16 * ks + 4 * g4);
                float v[8] = {a[0], -bq[0], a[1], -bq[1], a[2], -bq[2], a[3], -bq[3]};
                Cf[ks] = pack8(v);
            }
            f32x4 C[4][4];
            s5h_bu(Af, s, C);
            float xr[2], xi[2];
#pragma unroll
            for (int ii = 0; ii < 2; ++ii) {
                const float ar = s.ar[ii], ai = s.ai[ii];
                float er = 0.f, ei = 0.f;
#pragma unroll
                for (int k = 0; k < 16; ++k) { const float bur = C[k >> 2][ii][k & 3], bui = C[k >> 2][2 + ii][k & 3];
                    const float nr = ar * er - ai * ei + bur, ni = ar * ei + ai * er + bui; er = nr; ei = ni; }
                const float p16r = s.p16r[ii], p16i = s.p16i[ii];
                const int p = 16 * (2 * half + ii) + r16;
                const float x0r = E[c * 128 + p], x0i = E[c * 128 + 64 + p];
                float cr = x0r, ci = x0i;
#pragma unroll
                for (int gq = 0; gq < 3; ++gq) {
                    const float eqr = SHIDX(er, r16 + 16 * gq), eqi = SHIDX(ei, r16 + 16 * gq);
                    const float nr = CMUL_R(p16r, p16i, cr, ci) + eqr, ni = CMUL_I(p16r, p16i, cr, ci) + eqi;
                    if (g4 > gq) { cr = nr; ci = ni; }
                }
                xr[ii] = cr; xi[ii] = ci;
            }
#pragma unroll
            for (int q = 0; q < 4; ++q) {
#pragma unroll
                for (int ii = 0; ii < 2; ++ii) {
                    const float ar = s.ar[ii], ai = s.ai[ii];
#pragma unroll
                    for (int rg = 0; rg < 4; ++rg) {
                        const float nr = ar * xr[ii] - ai * xi[ii] + C[q][ii][rg], ni = ar * xi[ii] + ai * xr[ii] + C[q][2 + ii][rg];
                        xr[ii] = nr; xi[ii] = ni;
                        *(LAS ual_t*)(lds + XS_OFF + ((4 * g4 + rg) * 136 + 2 * (16 * ii + r16)) * 2) = cvt_pk_bf16(nr, ni);
                    }
                }
#pragma unroll
                for (int ks = 0; ks < 2; ++ks) acc[q] = mfma16(lds_frag(lds, XS_OFF + (r16 * 136 + 32 * ks + 8 * g4) * 2), Cf[ks], acc[q]);
            }
        }
#pragma unroll
        for (int q = 0; q < 4; ++q)
#pragma unroll
            for (int rg = 0; rg < 4; ++rg) {
                const int tok = 16 * g4 + 4 * q + rg;
                float y = acc[q][rg] + dsk * bf2f(z[(size_t)(m0 + tok) * ZLD + ZC_SU + g * 16 + r16]);
                y = gelu_tanh(y);
                *(LAS bf16_t*)(lds + Y_OFF + (tok * YLD + g * 16 + r16) * 2) = f2bf(y);
            }
    }
    {
        const bf16_t* wg = (const bf16_t*)(P->ws + WS_WGLU);
        bf16x8 bfr[8][2];
#pragma unroll
        for (int ks = 0; ks < 8; ++ks)
#pragma unroll
            for (int nf = 0; nf < 2; ++nf) bfr[ks][nf] = *(const bf16x8*)(wg + (size_t)(32 * wave + 16 * nf + r16) * 256 + 32 * ks + 8 * g4);
        __syncthreads();
        for (int rp43 = 0; rp43 < REPN(43); ++rp43) {
        f32x4 acc[4][2];
#pragma unroll
        for (int mf = 0; mf < 4; ++mf) { acc[mf][0] = (f32x4){0.f, 0.f, 0.f, 0.f}; acc[mf][1] = (f32x4){0.f, 0.f, 0.f, 0.f}; }
#pragma unroll
        for (int ks = 0; ks < 8; ++ks) {
#pragma unroll
            for (int mf = 0; mf < 4; ++mf) { const bf16x8 af = lds_frag(lds, Y_OFF + ((16 * mf + r16) * YLD + 32 * ks + 8 * g4) * 2);
                acc[mf][0] = mfma16(af, bfr[ks][0], acc[mf][0]); acc[mf][1] = mfma16(af, bfr[ks][1], acc[mf][1]); }
        }
        bf16_t* yo = (bf16_t*)(P->ws + WS_Y);
#pragma unroll
        for (int nf = 0; nf < 2; ++nf) {
            const int n = 32 * wave + 16 * nf + r16;
            const float gn = P->in[I_GN_SSM][l * 256 + n];
#pragma unroll
            for (int mf = 0; mf < 4; ++mf)
#pragma unroll
                for (int rg = 0; rg < 4; ++rg) {
                    const int tok = 16 * mf + 4 * g4 + rg;
                    const float yv = bf2f(*(const LAS bf16_t*)(lds + Y_OFF + (tok * YLD + n) * 2));
                    const float o = yv * sigmoidf_(acc[mf][nf][rg]);
                    float ss = o * o;
                    ss += SHX(ss, 1); ss += SHX(ss, 2); ss += SHX(ss, 4); ss += SHX(ss, 8);
                    const float rs = rsqrtf(ss * (1.0f / 16.0f) + EPS);
                    yo[(size_t)(m0 + tok) * DM + n] = f2bf(o * rs * gn);
                }
        }
        }
    }
}

__device__ __forceinline__ float log_sigmoid(float x) { return x > 0.f ? -log1pf(expf(-x)) : x - log1pf(expf(x)); }

__device__ __forceinline__ void conv_silu16(const bf16_t* z, const float* convw  , int b, int t, int zcol, int ch0, float* out) {
#pragma unroll
    for (int i = 0; i < 16; ++i) out[i] = 0.f;
#pragma unroll
    for (int j = 0; j < 4; ++j) {
        const int ts = t - 3 + j;
        if (ts >= 0) {
            const bf16_t* src = z + (size_t)(b * SEQ + ts) * ZLD + zcol;
            const u32x4 w0 = *(const u32x4*)src, w1 = *(const u32x4*)(src + 8);
            float v[16]; unpack8(w0, v); unpack8(w1, v + 8);
            const float* cw = convw + j * 512 + ch0;
#pragma unroll
            for (int q = 0; q < 4; ++q) { const f32x4 c4 = *(const f32x4*)(cw + 4 * q);
#pragma unroll
                for (int e = 0; e < 4; ++e) out[4 * q + e] += v[4 * q + e] * c4[e]; }
        }
    }
#pragma unroll
    for (int i = 0; i < 16; ++i) out[i] = out[i] * sigmoidf_(out[i]);
}

__device__ __forceinline__ float wave_scan_add(float v, int lane) {
#pragma unroll
    for (int o = 1; o < 64; o <<= 1) { const float t = SHUP(v, o); if (lane >= o) v += t; }
    return v;
}
__device__ __forceinline__ float wave_scan_max(float v, int lane) {
#pragma unroll
    for (int o = 1; o < 64; o <<= 1) { const float t = SHUP(v, o); if (lane >= o) v = fmaxf(v, t); }
    return v;
}
__device__ __forceinline__ void mlstm_gates_w0(KP P, int l, int b, int hh, int c, LAS fal_t* G, int lane) {
    const float* gate = (const float*)(P->ws + WS_GATE);
    const int s0 = 2 * lane;
    const size_t m0 = (size_t)b * SEQ + c * 128 + s0;
    const float bi = P->in[I_B_I][l * 4 + hh], bfv = P->in[I_B_F][l * 4 + hh];
    const float ig0 = gate[m0 * 32 + hh] + bi, ig1 = gate[(m0 + 1) * 32 + hh] + bi;
    const float lf0 = log_sigmoid(gate[m0 * 32 + 4 + hh] + bfv), lf1 = log_sigmoid(gate[(m0 + 1) * 32 + 4 + hh] + bfv);
    const float sm = lf0 + lf1, incl = wave_scan_add(sm, lane), excl = incl - sm;
    const float b0 = excl + lf0, b1 = incl;
    const float d0 = ig0 - b0, d1 = ig1 - b1;
    const float inclm = wave_scan_max(fmaxf(d0, d1), lane);
    float exclm = SHUP(inclm, 1); if (lane == 0) exclm = NEGF;
    const float maxd = SHIDX(inclm, 63);
    G[s0] = ig0; G[s0 + 1] = ig1; G[128 + s0] = b0; G[128 + s0 + 1] = b1;
    G[256 + s0] = fmaxf(exclm, d0); G[256 + s0 + 1] = inclm;
    G[384 + s0] = __expf(d0 - maxd); G[384 + s0 + 1] = __expf(d1 - maxd);
    if (lane == 63) { G[512] = b1; G[513] = b1 + maxd; }
}

__device__ __forceinline__ void mlstm_stage1(KP P, int l, int item, ldsp lds, int tid, int wave, int lane) {
    const int c = item & 15, hh = (item >> 4) & 3, b = item >> 6;
    const bf16_t* z = (const bf16_t*)(P->ws + WS_Z);
    constexpr int KW_OFF = 0, VT_OFF = 17408, G_OFF = 39168, LD = 136;
    LAS fal_t* G = (LAS fal_t*)(lds + G_OFF);
    {
        const int s = tid >> 2, q4 = tid & 3, t = c * 128 + s;
        float kv[16];
        conv_silu16(z, P->in[I_CONV] + (size_t)l * 2048, b, t, ZC_MK + hh * 64 + 16 * q4, 256 + hh * 64 + 16 * q4, kv);
        const bf16_t* vs = z + (size_t)(b * SEQ + t) * ZLD + ZC_MV + hh * 64 + 16 * q4;
        const u32x4 w0 = *(const u32x4*)vs, w1 = *(const u32x4*)(vs + 8);
        {
            float qv[16];
            conv_silu16(z, P->in[I_CONV] + (size_t)l * 2048, b, t, ZC_MQ + hh * 64 + 16 * q4, hh * 64 + 16 * q4, qv);
            bf16_t* qk = (bf16_t*)(P->ws + WS_QKC) + ((size_t)b * SEQ + t) * 512 + hh * 64 + 16 * q4;
            *(bf16x8*)qk = pack8(qv); *(bf16x8*)(qk + 8) = pack8(qv + 8);
            float ks_[16];
#pragma unroll
            for (int i = 0; i < 16; ++i) ks_[i] = kv[i] * 0.125f;
            *(bf16x8*)(qk + 256) = pack8(ks_); *(bf16x8*)(qk + 256 + 8) = pack8(ks_ + 8);
        }
        for (int e = tid; e < 15 * 128; e += 512) *(LAS bf16_t*)(lds + VT_OFF + ((65 + e / 128) * LD + (e & 127)) * 2) = 0;
        if (tid < 128) *(LAS bf16_t*)(lds + VT_OFF + (64 * LD + tid) * 2) = 0x3f80;
        if (wave == 0) mlstm_gates_w0(P, l, b, hh, c, G, lane);
        __syncthreads();
        const float wk = G[384 + s] * 0.125f;
#pragma unroll
        for (int i = 0; i < 16; ++i) *(LAS bf16_t*)(lds + KW_OFF + ((16 * q4 + i) * LD + s) * 2) = f2bf(kv[i] * wk);
        const unsigned ww[8] = {w0.x, w0.y, w0.z, w0.w, w1.x, w1.y, w1.z, w1.w};
#pragma unroll
        for (int i = 0; i < 8; ++i) {
            *(LAS bf16_t*)(lds + VT_OFF + ((16 * q4 + 2 * i) * LD + s) * 2) = (bf16_t)(ww[i] & 0xffffu);
            *(LAS bf16_t*)(lds + VT_OFF + ((16 * q4 + 2 * i + 1) * LD + s) * 2) = (bf16_t)(ww[i] >> 16);
        }
    }
    __syncthreads();
    float* out = (float*)(P->ws + WS_MLC) + (size_t)item * MLC_STRIDE;
    {
        const int r16 = lane & 15, g4 = lane >> 4, mf = wave >> 1, nf0 = (wave & 1) * 2;
        f32x4 acc[2] = {(f32x4){0.f, 0.f, 0.f, 0.f}, (f32x4){0.f, 0.f, 0.f, 0.f}};
        f32x4 accn = (f32x4){0.f, 0.f, 0.f, 0.f};
#pragma unroll
        for (int ks = 0; ks < 4; ++ks) {
            const bf16x8 af = lds_frag(lds, KW_OFF + ((16 * mf + r16) * LD + 32 * ks + 8 * g4) * 2);
#pragma unroll
            for (int nfi = 0; nfi < 2; ++nfi) acc[nfi] = mfma16(af, lds_frag(lds, VT_OFF + ((16 * (nf0 + nfi) + r16) * LD + 32 * ks + 8 * g4) * 2), acc[nfi]);
            if ((wave & 1) == 0) accn = mfma16(af, lds_frag(lds, VT_OFF + ((64 + r16) * LD + 32 * ks + 8 * g4) * 2), accn);
        }
        if ((wave & 1) == 0 && r16 == 0) {
#pragma unroll
            for (int rg = 0; rg < 4; ++rg) out[4096 + 16 * mf + 4 * g4 + rg] = accn[rg];
        }
#pragma unroll
        for (int nfi = 0; nfi < 2; ++nfi)
#pragma unroll
            for (int rg = 0; rg < 4; ++rg) out[(16 * mf + 4 * g4 + rg) * 64 + 16 * (nf0 + nfi) + r16] = acc[nfi][rg];
    }
    if (tid == 0) { out[4160] = G[512]; out[4161] = G[513]; }
    if (tid < 128) {
        float* mg = (float*)(P->ws + WS_MLG) + (size_t)item * 384;
        mg[tid] = G[tid]; mg[128 + tid] = G[128 + tid]; mg[256 + tid] = G[256 + tid];
    }
}

__device__ __forceinline__ void mlstm_stage2(KP P, int l, int item, ldsp lds, int tid, int wave, int lane) {
    const int c = item & 15, hh = (item >> 4) & 3, b = item >> 6;
    const bf16_t* z = (const bf16_t*)(P->ws + WS_Z);
    constexpr int Q_OFF = 0, K_OFF = 18432, VT_OFF = 36864, CT_OFF = 58624, P_OFF = 70144, G_OFF = 104960, QLD = 72, VLD = 136;
    LAS fal_t* G = (LAS fal_t*)(lds + G_OFF);
    const float* mlc_base = (const float*)(P->ws + WS_MLC) + (size_t)(item - c) * MLC_STRIDE;
    unsigned short opre[4][4];
    {
        const int r16 = lane & 15, g4 = lane >> 4;
#pragma unroll
        for (int rg = 0; rg < 4; ++rg) { const size_t m = (size_t)b * SEQ + c * 128 + 16 * wave + 4 * g4 + rg;
#pragma unroll
            for (int nf = 0; nf < 4; ++nf) opre[rg][nf] = z[m * ZLD + ZC_MO + hh * 64 + 16 * nf + r16]; }
    }
    {
        const int s = tid >> 2, q4 = tid & 3, t = c * 128 + s;
        const bf16_t* qk = (const bf16_t*)(P->ws + WS_QKC) + ((size_t)b * SEQ + t) * 512 + hh * 64 + 16 * q4;
        const u32x4 q0 = *(const u32x4*)qk, q1 = *(const u32x4*)(qk + 8), k0 = *(const u32x4*)(qk + 256), k1 = *(const u32x4*)(qk + 256 + 8);
        *(LAS u32x4*)(lds + Q_OFF + (s * QLD + 16 * q4) * 2) = q0; *(LAS u32x4*)(lds + Q_OFF + (s * QLD + 16 * q4 + 8) * 2) = q1;
        *(LAS u32x4*)(lds + K_OFF + (s * QLD + 16 * q4) * 2) = k0; *(LAS u32x4*)(lds + K_OFF + (s * QLD + 16 * q4 + 8) * 2) = k1;
        const bf16_t* vs = z + (size_t)(b * SEQ + t) * ZLD + ZC_MV + hh * 64 + 16 * q4;
        const u32x4 w0 = *(const u32x4*)vs, w1 = *(const u32x4*)(vs + 8);
        const unsigned ww[8] = {w0.x, w0.y, w0.z, w0.w, w1.x, w1.y, w1.z, w1.w};
#pragma unroll
        for (int i = 0; i < 8; ++i) {
            *(LAS bf16_t*)(lds + VT_OFF + ((16 * q4 + 2 * i) * VLD + s) * 2) = (bf16_t)(ww[i] & 0xffffu);
            *(LAS bf16_t*)(lds + VT_OFF + ((16 * q4 + 2 * i + 1) * VLD + s) * 2) = (bf16_t)(ww[i] >> 16);
        }
        for (int e = tid; e < 15 * 64; e += 512) *(LAS bf16_t*)(lds + CT_OFF + ((65 + e / 64) * QLD + (e & 63)) * 2) = 0;
        for (int e = tid; e < 15 * 128; e += 512) *(LAS bf16_t*)(lds + VT_OFF + ((65 + e / 128) * VLD + (e & 127)) * 2) = 0;
        if (tid < 128) *(LAS bf16_t*)(lds + VT_OFF + (64 * VLD + tid) * 2) = 0x3f80;
    }
    if (tid < 128) {
        const float* mg = (const float*)(P->ws + WS_MLG) + (size_t)item * 384;
        G[tid] = mg[tid]; G[128 + tid] = mg[128 + tid]; G[256 + tid] = mg[256 + tid];
    }
    if (wave == 0) {
        const bool valid = lane < c;
        const float bLc = valid ? mlc_base[(size_t)lane * MLC_STRIDE + 4160] : 0.f;
        const float mlc = valid ? mlc_base[(size_t)lane * MLC_STRIDE + 4161] : NEGF;
        float suf = 0.f;
#pragma unroll
        for (int j = 1; j < 16; ++j) { const float v = SHIDX(bLc, j); if (j > lane) suf += v; }
        const float total = SHIDX(suf + bLc, 0);
        float e = valid ? mlc + suf : NEGF;
        float mx = e;
#pragma unroll
        for (int o = 1; o < 64; o <<= 1) mx = fmaxf(mx, SHX(mx, o));
        const float Mq = fmaxf(total, mx);
        if (lane < 16) G[520 + lane] = valid ? __expf(e - Mq) : 0.f;
        if (lane == 0) G[536] = Mq;
    }
    __syncthreads();
    const float Mp = G[536];
    {
        float Cv[8]; float nv = 0.f;
#pragma unroll
        for (int i = 0; i < 8; ++i) Cv[i] = 0.f;
#pragma unroll 4
        for (int cc = 0; cc < c; ++cc) {
            const float* src = mlc_base + (size_t)cc * MLC_STRIDE;
            const float w = G[520 + cc];
            const f32x4 a = *(const f32x4*)(src + tid * 8), bq = *(const f32x4*)(src + tid * 8 + 4);
#pragma unroll
            for (int e = 0; e < 4; ++e) { Cv[e] += w * a[e]; Cv[4 + e] += w * bq[e]; }
            if (tid < 64) nv += w * src[4096 + tid];
        }
        const int dk = tid >> 3, dv0 = (tid & 7) * 8;
#pragma unroll
        for (int i = 0; i < 8; ++i) *(LAS bf16_t*)(lds + CT_OFF + ((dv0 + i) * QLD + dk) * 2) = f2bf(Cv[i]);
        if (tid < 64) *(LAS bf16_t*)(lds + CT_OFF + (64 * QLD + tid) * 2) = f2bf(nv);
    }
    __syncthreads();
    if (lane < 16) { const int t_ = 16 * wave + lane; G[384 + t_] = G[128 + t_] + fmaxf(Mp, G[256 + t_]); }
    asm volatile("s_waitcnt lgkmcnt(0)" ::: "memory");
    {
        const int r16 = lane & 15, g4 = lane >> 4;
        const int PW = P_OFF + wave * 4352;
        bf16x8 qf[2];
#pragma unroll
        for (int ks = 0; ks < 2; ++ks) qf[ks] = lds_frag(lds, Q_OFF + ((16 * wave + r16) * QLD + 32 * ks + 8 * g4) * 2);
        f32x4 accO[5];
#pragma unroll
        for (int nf = 0; nf < 5; ++nf) { accO[nf] = (f32x4){0.f, 0.f, 0.f, 0.f};
#pragma unroll
            for (int ks = 0; ks < 2; ++ks) accO[nf] = mfma16(qf[ks], lds_frag(lds, CT_OFF + ((16 * nf + r16) * QLD + 32 * ks + 8 * g4) * 2), accO[nf]); }
        float bt[4], mt[4];
#pragma unroll
        for (int rg = 0; rg < 4; ++rg) { const int t = 16 * wave + 4 * g4 + rg; bt[rg] = G[128 + t]; mt[rg] = G[384 + t];
            const float wi = __expf(bt[rg] + Mp - mt[rg]);
#pragma unroll
            for (int nf = 0; nf < 5; ++nf) accO[nf][rg] *= wi; }
        const int nfmax = (wave | 1);
        for (int nf = 0; nf <= nfmax; ++nf) {
            f32x4 sacc = (f32x4){0.f, 0.f, 0.f, 0.f};
            if (nf <= wave) {
#pragma unroll
                for (int ks = 0; ks < 2; ++ks) sacc = mfma16(qf[ks], lds_frag(lds, K_OFF + ((16 * nf + r16) * QLD + 32 * ks + 8 * g4) * 2), sacc);
            }
            const int s = 16 * nf + r16;
            const float ds = G[s] - G[128 + s];
#pragma unroll
            for (int rg = 0; rg < 4; ++rg) {
                const int t = 16 * wave + 4 * g4 + rg;
                const float p = (s <= t) ? sacc[rg] * __expf(bt[rg] + ds - mt[rg]) : 0.f;
                *(LAS bf16_t*)(lds + PW + ((4 * g4 + rg) * VLD + s) * 2) = f2bf(p);
            }
        }
        for (int ks = 0; ks <= (wave >> 1); ++ks) {
            const bf16x8 pf = lds_frag(lds, PW + (r16 * VLD + 32 * ks + 8 * g4) * 2);
#pragma unroll
            for (int nf = 0; nf < 5; ++nf) accO[nf] = mfma16(pf, lds_frag(lds, VT_OFF + ((16 * nf + r16) * VLD + 32 * ks + 8 * g4) * 2), accO[nf]);
        }
        bf16_t* yo = (bf16_t*)(P->ws + WS_Y);
#pragma unroll
        for (int rg = 0; rg < 4; ++rg) {
            const int t = 16 * wave + 4 * g4 + rg;
            const size_t m = (size_t)b * SEQ + c * 128 + t;
            const float den = SHIDX(accO[4][rg], lane & 48);
            const float dn = fmaxf(fabsf(den), __expf(-mt[rg]));
            float o[4]; float ss = 0.f;
#pragma unroll
            for (int nf = 0; nf < 4; ++nf) {
                const float op = bf2f(opre[rg][nf]);
                o[nf] = sigmoidf_(op) * (accO[nf][rg] / dn);
                ss += o[nf] * o[nf];
            }
            ss += SHX(ss, 1); ss += SHX(ss, 2); ss += SHX(ss, 4); ss += SHX(ss, 8);
            const float rs = rsqrtf(ss * (1.0f / 64.0f) + EPS);
#pragma unroll
            for (int nf = 0; nf < 4; ++nf) yo[m * DM + 256 + hh * 64 + 16 * nf + r16] = f2bf(o[nf] * rs * P->in[I_GN_MLSTM][l * 256 + hh * 64 + 16 * nf + r16]);
        }
    }
}

__device__ __forceinline__ void compress_item(KP P, int l, int item, ldsp lds, int tid, int wave, int lane) {
    const int nt = item & 3, bg = (item >> 2) & 15, kv = item >> 6;
    const int b = bg >> 1, g = bg & 1, n0 = 32 * nt;
    const bf16_t* z = (const bf16_t*)(P->ws + WS_Z);
    constexpr int CK_OFF = 0, CLD = 72, H_OFF = 77824, HLD = 264;
#define CK_ADDR(tk_) (CK_OFF + (tk_) * (CLD * 2) + ((((tk_) >> 4) & 15) << 4) + (((tk_) >> 8) << 8))
    const float* rc = (const float*)(P->ws + WS_ROPE);
    {
        u32x4 w0[5], w1[5];
#pragma unroll
        for (int it = 0; it < 5; ++it) {
            const int e = tid + 512 * it, tk = e >> 2, q4 = e & 3, t = 16 * n0 + tk;
            w0[it] = (u32x4){0u, 0u, 0u, 0u}; w1[it] = (u32x4){0u, 0u, 0u, 0u};
            if (e < 528 * 4 && t < SEQ) {
                const bf16_t* src = z + ((size_t)b * SEQ + t) * ZLD + (kv ? ZC_CV : ZC_CK) + g * 64 + 16 * q4;
                w0[it] = *(const u32x4*)src; w1[it] = *(const u32x4*)(src + 8);
            }
        }
#pragma unroll
        for (int it = 0; it < 5; ++it) {
            const int e = tid + 512 * it, tk = e >> 2, q4 = e & 3;
            if (e < 528 * 4) { *(LAS u32x4*)(lds + CK_ADDR(tk) + 32 * q4) = w0[it]; *(LAS u32x4*)(lds + CK_ADDR(tk) + 32 * q4 + 16) = w1[it]; }
        }
    }
    if (kv == 0) {
        __syncthreads();
        for (int tk = tid; tk < 528; tk += 512) {
            const int t = 16 * n0 + tk;
            if (t < SEQ) {
                const size_t m = (size_t)b * SEQ + t;
                const f32x4 c0 = *(const f32x4*)(rc + m * 8), c1 = *(const f32x4*)(rc + m * 8 + 4);
                const f32x4 s0 = *(const f32x4*)(rc + (size_t)MTOK * 8 + m * 8), s1 = *(const f32x4*)(rc + (size_t)MTOK * 8 + m * 8 + 4);
                const u32x4 a0 = *(const LAS u32x4*)(lds + CK_ADDR(tk)), a1 = *(const LAS u32x4*)(lds + CK_ADDR(tk) + 16);
                float v[16]; unpack8(a0, v); unpack8(a1, v + 8);
                const float cs[8] = {c0[0], c0[1], c0[2], c0[3], c1[0], c1[1], c1[2], c1[3]}, sn[8] = {s0[0], s0[1], s0[2], s0[3], s1[0], s1[1], s1[2], s1[3]};
                float o[16];
#pragma unroll
                for (int i = 0; i < 8; ++i) { o[i] = v[i] * cs[i] - v[8 + i] * sn[i]; o[8 + i] = v[8 + i] * cs[i] + v[i] * sn[i]; }
                *(LAS bf16x8*)(lds + CK_ADDR(tk)) = pack8(o); *(LAS bf16x8*)(lds + CK_ADDR(tk) + 16) = pack8(o + 8);
            }
        }
    }
    const int r16 = lane & 15, g4 = lane >> 4;
    float bb[2];
    {
        const float* cb1 = (const float*)(P->ws + WS_CB1) + kv * 256;
#pragma unroll
        for (int nfi = 0; nfi < 2; ++nfi) { const int hid = 32 * wave + 16 * nfi + r16; float a = 0.f;
#pragma unroll
            for (int kc = 0; kc < 16; ++kc) a += cb1[kc * 512 + hid];
            bb[nfi] = a; }
    }
    __syncthreads();
    {
        const bf16_t* w1t = (const bf16_t*)(P->ws + (kv ? WS_CW1V : WS_CW1K));
        const bf16_t* wrow = w1t + (size_t)(32 * wave + r16) * 2048 + 8 * g4;
        f32x4 acc[2][2];
#pragma unroll
        for (int a = 0; a < 2; ++a) { acc[a][0] = (f32x4){0.f, 0.f, 0.f, 0.f}; acc[a][1] = (f32x4){0.f, 0.f, 0.f, 0.f}; }
        for (int k8 = 0; k8 < 8; ++k8) {
            bf16x8 bfr[8][2];
#pragma unroll
            for (int kk = 0; kk < 8; ++kk)
#pragma unroll
                for (int nfi = 0; nfi < 2; ++nfi) bfr[kk][nfi] = *(const bf16x8*)(wrow + (size_t)nfi * 16 * 2048 + 32 * (8 * k8 + kk));
#pragma unroll
            for (int kk = 0; kk < 8; ++kk) {
                const int ks = 8 * k8 + kk, tt = ks >> 1, dd = 32 * (ks & 1) + 8 * g4;
                bf16x8 af[2];
#pragma unroll
                for (int mf = 0; mf < 2; ++mf) { const int tk_ = 16 * (16 * mf + r16) + tt; af[mf] = lds_frag(lds, CK_ADDR(tk_) + dd * 2); }
#pragma unroll
                for (int mf = 0; mf < 2; ++mf)
#pragma unroll
                    for (int nfi = 0; nfi < 2; ++nfi) acc[mf][nfi] = mfma16(af[mf], bfr[kk][nfi], acc[mf][nfi]);
            }
        }
#pragma unroll
        for (int nfi = 0; nfi < 2; ++nfi) { const int hid = 32 * wave + 16 * nfi + r16;
#pragma unroll
            for (int mf = 0; mf < 2; ++mf)
#pragma unroll
                for (int rg = 0; rg < 4; ++rg) *(LAS bf16_t*)(lds + H_OFF + ((16 * mf + 4 * g4 + rg) * HLD + hid) * 2) = f2bf(gelu_tanh(acc[mf][nfi][rg] + bb[nfi])); }
    }
    __syncthreads();
    {
        const bf16_t* w2t = (const bf16_t*)(P->ws + (kv ? WS_CW2V : WS_CW2K));
        const int mf = wave >> 2, nf = wave & 3;
        f32x4 acc = (f32x4){0.f, 0.f, 0.f, 0.f};
#pragma unroll
        for (int ks = 0; ks < 8; ++ks)
            acc = mfma16(lds_frag(lds, H_OFF + ((16 * mf + r16) * HLD + 32 * ks + 8 * g4) * 2), *(const bf16x8*)(w2t + (size_t)(16 * nf + r16) * 256 + 32 * ks + 8 * g4), acc);
        bf16_t* dst = (bf16_t*)(P->ws + (kv ? WS_VCMP : WS_KCMP)) + (size_t)bg * 128 * 64;
#pragma unroll
        for (int rg = 0; rg < 4; ++rg) { const int n = n0 + 16 * mf + 4 * g4 + rg; dst[n * 64 + 16 * nf + r16] = (n < 127) ? f2bf(acc[rg]) : (bf16_t)0; }
    }
#undef CK_ADDR
}

__device__ __forceinline__ void rope_item(KP P, int item, int tid) {
    bf16_t* z = (bf16_t*)(P->ws + WS_Z);
    const float* rc = (const float*)(P->ws + WS_ROPE);
    for (int e = item * 4096 + tid; e < item * 4096 + 4096; e += 512) {
        const int m = e / 12, hsel = e % 12;
        const int col = hsel < 8 ? ZC_AQ + hsel * 64 : (hsel < 10 ? ZC_SK + (hsel - 8) * 64 : ZC_WK + (hsel - 10) * 64);
        bf16_t* src = z + (size_t)m * ZLD + col;
        const u32x4 w0 = *(const u32x4*)src, w1 = *(const u32x4*)(src + 8);
        float v[16]; unpack8(w0, v); unpack8(w1, v + 8);
        const f32x4 c0 = *(const f32x4*)(rc + (size_t)m * 8), c1 = *(const f32x4*)(rc + (size_t)m * 8 + 4);
        const f32x4 s0 = *(const f32x4*)(rc + (size_t)MTOK * 8 + (size_t)m * 8), s1 = *(const f32x4*)(rc + (size_t)MTOK * 8 + (size_t)m * 8 + 4);
        const float cs[8] = {c0[0], c0[1], c0[2], c0[3], c1[0], c1[1], c1[2], c1[3]}, sn[8] = {s0[0], s0[1], s0[2], s0[3], s1[0], s1[1], s1[2], s1[3]};
        float o[16];
#pragma unroll
        for (int i = 0; i < 8; ++i) { o[i] = v[i] * cs[i] - v[8 + i] * sn[i]; o[8 + i] = v[8 + i] * cs[i] + v[i] * sn[i]; }
        *(bf16x8*)src = pack8(o); *(bf16x8*)(src + 8) = pack8(o + 8);
    }
}

struct NsaCtx { int tq; unsigned selm; };
__device__ __forceinline__ void nsa_tile(ldsp lds, int ks_off, int vt_off, const int MMODE, const bf16x8 (&Qf)[2][2], f32x4 (&OB)[4][2], float (&mrun)[2], float (&lrun)[2], int tql, bool selbit, int r16, int g4) {
    constexpr int KLD = 72, VLD = 72;
    const int kbase = ks_off + (r16 * KLD + 8 * g4) * 2, vbase = vt_off + ((4 * g4 + (r16 >> 2)) * VLD + 4 * (r16 & 3)) * 2;
    f32x4 S[2][4];
#pragma unroll
    for (int kfi = 0; kfi < 4; ++kfi) {
        const bf16x8 k0 = lds_frag(lds, kbase + 16 * kfi * KLD * 2), k1 = lds_frag(lds, kbase + 16 * kfi * KLD * 2 + 64);
#pragma unroll
        for (int f = 0; f < 2; ++f) S[f][kfi] = mfma16(k1, Qf[f][1], mfma16(k0, Qf[f][0], (f32x4){0.f, 0.f, 0.f, 0.f}));
    }
    bf16x8 pb[2][2];
#pragma unroll
    for (int f = 0; f < 2; ++f) {
        if (MMODE == 1) {
#pragma unroll
            for (int kfi = 0; kfi < 4; ++kfi)
#pragma unroll
                for (int rg = 0; rg < 4; ++rg) S[f][kfi][rg] = (16 * kfi + 4 * g4 + rg <= tql) ? S[f][kfi][rg] : NEGF;
        } else if (MMODE == 2) {
#pragma unroll
            for (int kfi = 0; kfi < 4; ++kfi)
#pragma unroll
                for (int rg = 0; rg < 4; ++rg) S[f][kfi][rg] = (16 * kfi + 4 * g4 + rg > tql) ? S[f][kfi][rg] : NEGF;
        }
        float mx = fmaxf(fmaxf(S[f][0][0], S[f][0][1]), fmaxf(S[f][0][2], S[f][0][3]));
#pragma unroll
        for (int kfi = 1; kfi < 4; ++kfi) mx = fmaxf(mx, fmaxf(fmaxf(S[f][kfi][0], S[f][kfi][1]), fmaxf(S[f][kfi][2], S[f][kfi][3])));
        mx = selbit ? mx : NEGF;
        mx = xmax16_32(mx);
        const float mn = fmaxf(mrun[f], mx);
        const float alpha = __builtin_amdgcn_exp2f(mrun[f] - mn);
        const float msub = selbit ? fmaxf(mn, -1e28f) : 1e30f;
        float ls = 0.f;
#pragma unroll
        for (int kfi = 0; kfi < 4; ++kfi)
#pragma unroll
            for (int rg = 0; rg < 4; ++rg) { const float p = __builtin_amdgcn_exp2f(S[f][kfi][rg] - msub); S[f][kfi][rg] = p; ls += p; }
        lrun[f] = lrun[f] * alpha + ls; mrun[f] = mn;
        if (__builtin_amdgcn_ballot_w64(alpha != 1.0f) != 0ull) {
#pragma unroll
            for (int df = 0; df < 4; ++df) OB[df][f] *= alpha;
        }
#pragma unroll
        for (int k2 = 0; k2 < 2; ++k2) {
            const float pv[8] = {S[f][2 * k2][0], S[f][2 * k2][1], S[f][2 * k2][2], S[f][2 * k2][3], S[f][2 * k2 + 1][0], S[f][2 * k2 + 1][1], S[f][2 * k2 + 1][2], S[f][2 * k2 + 1][3]};
            pb[f][k2] = pack8(pv);
        }
    }
#pragma unroll
    for (int k2 = 0; k2 < 2; ++k2)
#pragma unroll
        for (int df = 0; df < 4; ++df) {
            const bf16x4 lo = lds_tr16(lds, vbase + 32 * k2 * VLD * 2 + 32 * df);
            const bf16x4 hi = lds_tr16(lds, vbase + (32 * k2 + 16) * VLD * 2 + 32 * df);
            const bf16x8 va = __builtin_shufflevector(lo, hi, 0, 1, 2, 3, 4, 5, 6, 7);
            OB[df][0] = mfma16(va, pb[0][k2], OB[df][0]);
            OB[df][1] = mfma16(va, pb[1][k2], OB[df][1]);
        }
}

__device__ __forceinline__ void nsa_load_tile(ldsp lds, const bf16_t* kbase, const bf16_t* vbase, size_t ld, int keyoff, int tid) {
    constexpr int KS_OFF = 0, VT_OFF = 18432, KLD = 72;
    const int key = tid >> 3, dc = tid & 7;
    const u32x4 kw = *(const u32x4*)(kbase + (size_t)key * ld + 8 * dc);
    const u32x4 vw = *(const u32x4*)(vbase + (size_t)key * ld + 8 * dc);
    *(LAS u32x4*)(lds + KS_OFF + ((keyoff + key) * KLD + 8 * dc) * 2) = kw;
    *(LAS u32x4*)(lds + VT_OFF + ((keyoff + key) * KLD + 8 * dc) * 2) = vw;
}

__device__ __forceinline__ void nsa_item(KP P, int l, int item, ldsp lds, int tid, int wave, int lane) {
    const int qt = 31 - (item >> 4), bg = item & 15, b = bg >> 1, g = bg & 1;
    const int T0 = 64 * qt;
    const bf16_t* z = (const bf16_t*)(P->ws + WS_Z);
    const float* gate = (const float*)(P->ws + WS_GATE);
    constexpr int KS_OFF = 0, VT_OFF = 18432, KLD = 72, VLD = 72, IMP_OFF = 36864, SEL_OFF = 53248, OR_OFF = 53504;
    constexpr float SC2 = 0.125f * 1.4426950408889634f;
    const int r16 = lane & 15, g4 = lane >> 4;
    const int tq = T0 + 8 * wave + (r16 & 7);
    const size_t mq = (size_t)b * SEQ + tq;
    int hd[2]; hd[0] = 4 * g + (r16 >> 3); hd[1] = 4 * g + 2 + (r16 >> 3);
    bf16x8 Qf[2][2];
#pragma unroll
    for (int f = 0; f < 2; ++f)
#pragma unroll
        for (int ks = 0; ks < 2; ++ks) { const u32x4 qw = *(const u32x4*)(z + mq * ZLD + ZC_AQ + hd[f] * 64 + 32 * ks + 8 * g4);
            float qv[8]; unpack8(qw, qv);
#pragma unroll
            for (int e = 0; e < 8; ++e) qv[e] *= SC2;
            Qf[f][ks] = pack8(qv); }
    float gt[2][3];
#pragma unroll
    for (int f = 0; f < 2; ++f)
#pragma unroll
        for (int br = 0; br < 3; ++br) gt[f][br] = sigmoidf_(gate[mq * 32 + 8 + hd[f] * 3 + br]);
    unsigned long long tt0_ = 0; if (TIMEK >= 8 && TIMEK <= 10) tt0_ = __builtin_amdgcn_s_memrealtime();
#define NSA_TSTAMP(k) do { if (TIMEK >= 8 && TIMEK <= 10) { const unsigned long long n_ = __builtin_amdgcn_s_memrealtime(); if (TIMEK == (k) && tid == 0) atomicAdd((unsigned long long*)(P->ws + WS_CTL) + 1000, n_ - tt0_); tt0_ = n_; } } while (0)
    f32x4 OF[4][2], OB[4][2];
    if (tid == 0) *(LAS ual_t*)(lds + OR_OFF) = 0u;
    {
        const bf16_t* kc = (const bf16_t*)(P->ws + WS_KCMP) + (size_t)bg * 128 * 64;
        const bf16_t* vc = (const bf16_t*)(P->ws + WS_VCMP) + (size_t)bg * 128 * 64;
        nsa_load_tile(lds, kc, vc, 64, 0, tid);
        nsa_load_tile(lds, kc + 64 * 64, vc + 64 * 64, 64, 64, tid);
        __syncthreads();
        float pa[8], pc[8];
#pragma unroll
        for (int kf = 0; kf < 8; ++kf) { pa[kf] = 0.f; pc[kf] = 0.f; }
#pragma unroll
        for (int f = 0; f < 2; ++f) {
            __builtin_amdgcn_sched_barrier(0);
            f32x4 S[8];
#pragma unroll
            for (int kf = 0; kf < 8; ++kf) { S[kf] = (f32x4){0.f, 0.f, 0.f, 0.f};
#pragma unroll
                for (int ks = 0; ks < 2; ++ks) S[kf] = mfma16(lds_frag(lds, KS_OFF + ((16 * kf + r16) * KLD + 32 * ks + 8 * g4) * 2), Qf[f][ks], S[kf]);
                if ((kf & 1) == 1) __builtin_amdgcn_sched_barrier(0); }
            float mx = NEGF;
#pragma unroll
            for (int kf = 0; kf < 8; ++kf)
#pragma unroll
                for (int rg = 0; rg < 4; ++rg) { const int n = 16 * kf + 4 * g4 + rg; const bool v = (16 * n + 31 <= tq); const float s = v ? S[kf][rg] : NEGF; S[kf][rg] = s; mx = fmaxf(mx, s); }
            mx = fmaxf(mx, SHX(mx, 16)); mx = fmaxf(mx, SHX(mx, 32));
            float ls = 0.f;
#pragma unroll
            for (int kf = 0; kf < 8; ++kf)
#pragma unroll
                for (int rg = 0; rg < 4; ++rg) { const int n = 16 * kf + 4 * g4 + rg; const bool v = (16 * n + 31 <= tq); const float p = v ? __builtin_amdgcn_exp2f(S[kf][rg] - mx) : 0.f; S[kf][rg] = p; ls += p; }
            ls += SHX(ls, 16); ls += SHX(ls, 32);
            const float inv = ls > 0.f ? 1.0f / ls : 0.f;
#pragma unroll
            for (int kf = 0; kf < 8; ++kf) { S[kf] *= inv; pa[kf] += 2.0f * (S[kf][0] + S[kf][1] + S[kf][2]) + S[kf][3]; pc[kf] += S[kf][3]; }
            __builtin_amdgcn_sched_barrier(0);
#pragma unroll
            for (int df = 0; df < 4; ++df) OB[df][f] = (f32x4){0.f, 0.f, 0.f, 0.f};
#pragma unroll
            for (int k2 = 0; k2 < 4; ++k2) {
                const float pv[8] = {S[2 * k2][0], S[2 * k2][1], S[2 * k2][2], S[2 * k2][3], S[2 * k2 + 1][0], S[2 * k2 + 1][1], S[2 * k2 + 1][2], S[2 * k2 + 1][3]};
                const bf16x8 pb = pack8(pv);
#pragma unroll
                for (int df = 0; df < 4; ++df) {
                    const int vb_ = VT_OFF + ((4 * g4 + (r16 >> 2)) * VLD + 4 * (r16 & 3)) * 2;
                    const bf16x4 lo = lds_tr16(lds, vb_ + 32 * k2 * VLD * 2 + 32 * df);
                    const bf16x4 hi = lds_tr16(lds, vb_ + (32 * k2 + 16) * VLD * 2 + 32 * df);
                    OB[df][f] = mfma16(__builtin_shufflevector(lo, hi, 0, 1, 2, 3, 4, 5, 6, 7), pb, OB[df][f]);
                }
            }
#pragma unroll
            for (int df = 0; df < 4; ++df) OF[df][f] = OB[df][f] * gt[f][0];
        }
        LAS fal_t* impA = (LAS fal_t*)(lds + IMP_OFF + wave * 2048);
        LAS fal_t* impB = impA + 256;
#pragma unroll
        for (int kf = 0; kf < 8; ++kf) {
            const float va_ = pa[kf] + SHX(pa[kf], 8), vc_ = pc[kf] + SHX(pc[kf], 8);
            if (r16 < 8) {
                const int j = 4 * kf + g4;
                impA[r16 * 32 + j] = va_;
                if (j < 31) impB[r16 * 32 + j + 1] = vc_;
                if (j == 0) impB[r16 * 32] = 0.f;
            }
        }
        {
            const int tk = lane & 7, jg = lane >> 3;
            const int tt = T0 + 8 * wave + tk, jcur = tt >> 6;
            float myv[4];
#pragma unroll
            for (int i = 0; i < 4; ++i) { const int j = 4 * jg + i; float v = impA[tk * 32 + j] + impB[tk * 32 + j];
                if (j == 0 || j == jcur) v = 1e4f; else if (j > jcur) v = -1e4f; myv[i] = v; }
            asm volatile("s_waitcnt lgkmcnt(0)" ::: "memory");
#pragma unroll
            for (int i = 0; i < 4; ++i) impA[tk * 32 + 4 * jg + i] = myv[i];
            asm volatile("s_waitcnt lgkmcnt(0)" ::: "memory");
            int cnt[4] = {0, 0, 0, 0};
            for (int j2 = 0; j2 < 32; ++j2) { const float v2 = impA[tk * 32 + j2];
#pragma unroll
                for (int i = 0; i < 4; ++i) { const int j = 4 * jg + i; cnt[i] += (v2 > myv[i] || (v2 == myv[i] && j2 < j)) ? 1 : 0; } }
            unsigned bits = 0u;
#pragma unroll
            for (int i = 0; i < 4; ++i) { const int j = 4 * jg + i; if (cnt[i] < 8 && j <= jcur) bits |= (1u << j); }
            bits |= SHX(bits, 8); bits |= SHX(bits, 16); bits |= SHX(bits, 32);
            if (lane < 8) { *(LAS ual_t*)(lds + SEL_OFF + (wave * 8 + lane) * 4) = bits; __hip_atomic_fetch_or((LAS ual_t*)(lds + OR_OFF), bits, __ATOMIC_RELAXED, __HIP_MEMORY_SCOPE_WORKGROUP); }
        }
    }
    __syncthreads();
    NSA_TSTAMP(8);
    const unsigned selm = *(const LAS ual_t*)(lds + SEL_OFF + (wave * 8 + (r16 & 7)) * 4);
    {
        constexpr int TL_OFF = 53760, TILE_OFF = 54272, TKLD = 72;
        const unsigned selor = *(const LAS ual_t*)(lds + OR_OFF) & (qt >= 31 ? 0xffffffffu : ((2u << qt) - 1u));
        const int nsel = __builtin_popcount(selor), wj0 = (qt >= 4 ? qt - 4 : 0), nwin = qt - wj0 + 1, ntl = nsel + nwin;
        if (tid < 32) { if ((selor >> tid) & 1u) *(LAS ual_t*)(lds + TL_OFF + __builtin_popcount(selor & ((1u << tid) - 1u)) * 4) = 0x100u | (unsigned)tid; }
        else if (tid < 32 + nwin) *(LAS ual_t*)(lds + TL_OFF + (nsel + tid - 32) * 4) = 0x200u | (unsigned)(wj0 + tid - 32);
        __syncthreads();
        const int key = tid >> 3, dc = tid & 7;
        const bf16_t* zrow = z + ((size_t)b * SEQ + key) * ZLD + g * 64 + 8 * dc;
        u32x4 kw0, vw0, kw1, vw1;
#define NSA_TILE_LOAD(ti, KW, VW) do { const unsigned d_ = *(const LAS ual_t*)(lds + TL_OFF + (ti) * 4); const bf16_t* p_ = zrow + (size_t)(64 * (int)(d_ & 0xffu)) * ZLD + ((d_ >> 8) == 1u ? ZC_SK : ZC_WK); \
        KW = *(const u32x4*)p_; VW = *(const u32x4*)(p_ + 128); } while (0)
#define NSA_TILE_WRITE(bufi, KW, VW) do { const int ko_ = TILE_OFF + (bufi) * 18432; *(LAS u32x4*)(lds + ko_ + (key * TKLD + 8 * dc) * 2) = KW; \
        *(LAS u32x4*)(lds + ko_ + 9216 + (key * TKLD + 8 * dc) * 2) = VW; } while (0)
        NSA_TILE_LOAD(0, kw0, vw0);
        NSA_TILE_WRITE(0, kw0, vw0);
        if (ntl > 1) NSA_TILE_LOAD(1, kw1, vw1);
        if (ntl > 2) NSA_TILE_LOAD(2, kw0, vw0);
        __syncthreads();
        float mrun[2] = {NEGF, NEGF}, lrun[2] = {0.f, 0.f};
#pragma unroll
        for (int f = 0; f < 2; ++f)
#pragma unroll
            for (int df = 0; df < 4; ++df) OB[df][f] = (f32x4){0.f, 0.f, 0.f, 0.f};
        unsigned pmode = 1u;
#define NSA_ITER(i, KW, VW) do { \
            if ((i) + 1 < ntl) NSA_TILE_WRITE(((i) + 1) & 1, KW, VW); \
            if ((i) + 3 < ntl) NSA_TILE_LOAD((i) + 3, KW, VW); \
            const unsigned d = *(const LAS ual_t*)(lds + TL_OFF + (i) * 4); \
            const unsigned mode = d >> 8; const int j = (int)(d & 0xffu); \
            if (mode != pmode) { \
                _Pragma("unroll") for (int f = 0; f < 2; ++f) { const float sc = gt[f][1] / xsum16_32(lrun[f]); \
                    _Pragma("unroll") for (int df = 0; df < 4; ++df) { OF[df][f] += OB[df][f] * sc; OB[df][f] = (f32x4){0.f, 0.f, 0.f, 0.f}; } \
                    mrun[f] = NEGF; lrun[f] = 0.f; } \
                pmode = mode; \
            } \
            const int ko = TILE_OFF + ((i) & 1) * 18432; \
            const int mmode = (j == qt) ? 1 : ((mode == 2u && j == qt - 4) ? 2 : 0); \
            const bool selbit = mode == 1u ? (((selm >> j) & 1u) != 0u) : true; \
            if (__builtin_amdgcn_ballot_w64(selbit) != 0ull) nsa_tile(lds, ko, ko + 9216, mmode, Qf, OB, mrun, lrun, tq - T0, selbit, r16, g4); \
            __syncthreads(); } while (0)
        for (int i = 0; i < ntl; i += 2) {
            NSA_ITER(i, kw1, vw1);
            if (i + 1 < ntl) NSA_ITER(i + 1, kw0, vw0);
        }
#pragma unroll
        for (int f = 0; f < 2; ++f) { const float sc = gt[f][2] / xsum16_32(lrun[f]);
#pragma unroll
            for (int df = 0; df < 4; ++df) OF[df][f] += OB[df][f] * sc; }
#undef NSA_ITER
#undef NSA_TILE_LOAD
#undef NSA_TILE_WRITE
    }
    NSA_TSTAMP(9);
    {
        bf16_t* yo = (bf16_t*)(P->ws + WS_Y);
#pragma unroll
        for (int f = 0; f < 2; ++f) {
            float ss = 0.f;
#pragma unroll
            for (int df = 0; df < 4; ++df)
#pragma unroll
                for (int rg = 0; rg < 4; ++rg) ss += OF[df][f][rg] * OF[df][f][rg];
            ss += SHX(ss, 16); ss += SHX(ss, 32);
            const float rs = rsqrtf(ss * (1.0f / 64.0f) + EPS);
#pragma unroll
            for (int df = 0; df < 4; ++df) {
                const f32x4 gn = *(const f32x4*)(P->in[I_GN_NSA] + l * 512 + hd[f] * 64 + 16 * df + 4 * g4);
                const f32x4 o = OF[df][f] * rs * gn;
                u32x2 w; w.x = cvt_pk_bf16(o[0], o[1]); w.y = cvt_pk_bf16(o[2], o[3]);
                *(u32x2*)(yo + mq * DM + 512 + hd[f] * 64 + 16 * df + 4 * g4) = w;
            }
        }
    }
}

__device__ __forceinline__ int lane_id_hw() { return (int)__builtin_amdgcn_mbcnt_hi(~0u, __builtin_amdgcn_mbcnt_lo(~0u, 0u)); }
#define TID0_EXPR ((wave0_ << 6) | lane_id_hw())
#define XB_TMO      128
#define XB_XCNT(j)  (256  + 64 * (j))
#define XB_XSUB(j)  (1280 + 64 * (j))
#define XB_XGEN(j)  (2304 + 64 * (j))
#define XB_TOP      3328
#define XB_TOPGEN   3392
#define XCD_BAR_WORDS 3456
#define XB_SPIN_CAP (1u << 22)
__device__ __forceinline__ unsigned xb_ld(unsigned* p)              { return __hip_atomic_load(p, __ATOMIC_RELAXED, __HIP_MEMORY_SCOPE_AGENT); }
__device__ __forceinline__ unsigned xb_add(unsigned* p, unsigned v) { return __hip_atomic_fetch_add(p, v, __ATOMIC_RELAXED, __HIP_MEMORY_SCOPE_AGENT); }
__device__ __forceinline__ unsigned xb_xcc_id() { return (unsigned)__builtin_amdgcn_s_getreg((3 << 11) | 20) & 0xFu; }
#define XB_SPIN(cond, bar) do { unsigned _sp = 0; while (cond) { __builtin_amdgcn_s_sleep(1); \
    if ((++_sp & 255u) == 0u) { if (xb_ld(&(bar)[XB_TMO])) break; if (_sp > XB_SPIN_CAP) { atomicAdd(&(bar)[XB_TMO], 1u); break; } } } } while (0)
struct XcdBarrier { unsigned* bar; unsigned x; volatile LAS ual_t* st; };
__device__ __forceinline__ XcdBarrier xcd_barrier_post(unsigned* bar, volatile LAS ual_t* st, const int wave0_) {
    XcdBarrier b; b.bar = bar; b.x = xb_xcc_id(); b.st = st;
    if (TID0_EXPR == 0) (void)xb_add(&bar[XB_XCNT(b.x)], 1u);
    return b;
}
__device__ __forceinline__ void xcd_barrier_complete(unsigned* bar, unsigned x, unsigned& nloc, unsigned& nx) {
    const unsigned G = gridDim.x * gridDim.y * gridDim.z;
    unsigned sum, cnt, mine, sp = 0u;
    for (;;) {
        sum = 0u; cnt = 0u; mine = 0u;
#pragma unroll
        for (unsigned j = 0; j < 16; ++j) { const unsigned c = xb_ld(&bar[XB_XCNT(j)]); sum += c; cnt += (c > 0u) ? 1u : 0u; mine = (j == x) ? c : mine; }
        if (sum == G) break;
        __builtin_amdgcn_s_sleep(1);
        if ((++sp & 255u) == 0u) { if (xb_ld(&bar[XB_TMO])) break; if (sp > XB_SPIN_CAP) { atomicAdd(&bar[XB_TMO], 1u); break; } }
    }
    nloc = mine > 0u ? mine : 1u; nx = cnt > 0u ? cnt : 1u;
}
__device__ __forceinline__ void xcd_barrier(const XcdBarrier& b, const int wave0_) {
    asm volatile("s_waitcnt vmcnt(0)" ::: "memory");
    __syncthreads();
    if (TID0_EXPR == 0) {
        unsigned* bar = b.bar;
        __builtin_amdgcn_s_waitcnt(0);
        unsigned nloc = b.st[0], nx = b.st[1];
        if (nloc == 0u) { xcd_barrier_complete(bar, b.x, nloc, nx); b.st[0] = nloc; b.st[1] = nx; }
        const unsigned old = xb_add(&bar[XB_XSUB(b.x)], 1u);
        const unsigned gen = old / nloc;
        if (old + 1u == (gen + 1u) * nloc) {
            __builtin_amdgcn_fence(__ATOMIC_RELEASE, "agent");
            asm volatile("s_waitcnt vmcnt(0)" ::: "memory");
            const unsigned og = xb_add(&bar[XB_TOP], 1u);
            const unsigned tg = og / nx;
            if (og + 1u == (tg + 1u) * nx) xb_add(&bar[XB_TOPGEN], 1u);
            else XB_SPIN(xb_ld(&bar[XB_TOPGEN]) == tg, bar);
            __builtin_amdgcn_fence(__ATOMIC_ACQUIRE, "agent");
            xb_add(&bar[XB_XGEN(b.x)], 1u);
            asm volatile("s_waitcnt vmcnt(0)" ::: "memory");
        } else {
            XB_SPIN(xb_ld(&bar[XB_XGEN(b.x)]) == gen, bar);
            __builtin_amdgcn_fence(__ATOMIC_ACQUIRE, "agent");
            asm volatile("s_waitcnt vmcnt(0)" ::: "memory");
        }
    }
    __syncthreads();
}

__device__ __forceinline__ int p2_static(int bx, int k) {
    if (bx < 128) { return k == 0 ? bx : (k == 1 ? 128 + bx : (k == 2 ? 640 + bx : -1)); }
    const int j = bx - 128;
    if (k < 3) return 128 + 128 + 3 * j + k;
    if (k < 6) return 640 + 128 + 3 * j + (k - 3);
    if (k == 6 && j < 48) return 1152 + j;
    return -1;
}
__device__ __forceinline__ int p3_static(int bx, int k) {
    switch (k) {
        case 0: return bx;
        case 1: return ((31 - (bx >> 4)) << 4) | (bx & 15);
        case 2: return 512 + bx;
        case 3: return 512 + 256 + bx;
        case 4: return 1024 + bx;
        default: return -1;
    }
}
#ifndef EN_MASK
#define EN_MASK 0xFFFF
#endif
#define EN(b) (((EN_MASK) >> (b)) & 1)
#ifndef DUP
#define DUP 0
#endif
#define NREP(k) ((DUP) == (k) ? 2 : 1)
__global__ void __launch_bounds__(512, 2) hybrid_fwd(Params P_unused) {
    KP P = (KP)__builtin_amdgcn_kernarg_segment_ptr();
    extern __shared__ __attribute__((aligned(16))) unsigned char lds_raw[];
    ldsp lds = (ldsp)lds_raw;
    const int wave0_ = __builtin_amdgcn_readfirstlane((int)threadIdx.x >> 6);
#define tid0 TID0_EXPR
    volatile LAS ual_t* misc = (volatile LAS ual_t*)(lds + MISC_OFF);
    if (tid0 < 16) misc[tid0] = 0u;
    __syncthreads();
    (void)xcd_barrier_post((unsigned*)(P->ws + WS_CTL) + 4096, misc + 8, wave0_);
#define GRID_SYNC() do { asm volatile("" : "+s"(P)); XcdBarrier xb_; xb_.bar = (unsigned*)(P->ws + WS_CTL) + 4096; xb_.x = xb_xcc_id(); xb_.st = (volatile LAS ual_t*)(lds + MISC_OFF) + 8; xcd_barrier(xb_, wave0_); } while (0)
#define PHASE_BEGIN() asm volatile("" : "+s"(P)); int tid = tid0; asm volatile("" : "+v"(tid)); const int lane = tid & 63, wave = __builtin_amdgcn_readfirstlane(tid >> 6); \
    const int G = gridDim.x, gw = blockIdx.x * 8 + wave, NGW = G * 8; unsigned char* ws = P->ws; (void)lane; (void)gw; (void)NGW; (void)ws; (void)G

    {
        PHASE_BEGIN();
        if (EN(0)) { const bool hb = P->hb16 != 0; norm_pass(P->in[I_X], nullptr, nullptr, P->in[I_LN_MIX_PRE], nullptr, hb ? (bf16_t*)(ws + WS_H16) : nullptr, hb ? nullptr : P->out, (bf16_t*)(ws + WS_U), gw, NGW, lane); }
        if (EN(1)) {
            const int* pos = (const int*)P->in[I_POS];
            float* rc = (float*)(ws + WS_ROPE);
            for (int e = blockIdx.x * 512 + tid; e < MTOK * 8; e += G * 512) {
                const int m = e >> 3, j = e & 7;
                const float inv = powf(500000.0f, -(float)j * 0.125f);
                const float ang = (float)pos[m] * inv;
                rc[e] = cosf(ang); rc[(size_t)MTOK * 8 + e] = sinf(ang);
            }
        }
        if (EN(2)) convert_layer(P, 0, lds, gw, NGW, wave, lane);
    }
    GRID_SYNC();

    for (int l = 0; l < DEPTH; ++l) {
        for (int rep = 0; rep < NREP(1); ++rep) {
            PHASE_BEGIN();
            pg8::Gemm g{(const bf16_t*)(ws + WS_U), (const bf16_t*)(ws + WS_WIN), MTOK, ZLD, DM}; pg8::StaticOrder S; S.init(MTOK, ZLD, G, (int)blockIdx.x);
            pg8::EpiBf16<0> E{(bf16_t*)(ws + WS_Z), ZLD, (float*)(ws + WS_GATE), 10};
            pg8::gemm_phase<pg8::EpiBf16<0>, pg8::StaticOrder, true, true>(lds, g, S, E, tid);
            GRID_SYNC();
        }
        for (int rep = 0; rep < ((DUP) / 10 == 2 || (DUP) == 2 ? 2 : 1); ++rep) {
            constexpr int N_CMP = 128, N_ML = 512, N_S5 = 512, N_ROPE = 48, NTOT = N_CMP + N_ML + N_S5 + N_ROPE;
            for (int kstep = 0;; ++kstep) {
                __syncthreads();
                int item;
                if (gridDim.x == 256) item = p2_static((int)blockIdx.x, kstep);
                else { if (tid0 == 0) misc[0] = atomicAdd((unsigned*)(P->ws + WS_CTL) + 64 * (2 * l) + 1024 * rep, 1u); __syncthreads(); item = (int)misc[0]; if (item >= NTOT) item = -1; }
                PHASE_BEGIN();
                if (item < 0) break;
                if (item < N_CMP) { { unsigned long long t0_ = 0; if (TIMEK == 1) t0_ = __builtin_amdgcn_s_memrealtime(); if (EN(4) && (rep == 0 || DUP == 2 || DUP == 21)) compress_item(P, l, item, lds, tid, wave, lane); if (TIMEK == 1) { __syncthreads(); if (tid0 == 0) atomicAdd((unsigned long long*)(P->ws + WS_CTL) + 1000, __builtin_amdgcn_s_memrealtime() - t0_); } } continue; } item -= N_CMP;
                if (item < N_ML) { { unsigned long long t0_ = 0; if (TIMEK == 2) t0_ = __builtin_amdgcn_s_memrealtime(); if (EN(5) && (rep == 0 || DUP == 2 || DUP == 22)) mlstm_stage1(P, l, item, lds, tid, wave, lane); if (TIMEK == 2) { __syncthreads(); if (tid0 == 0) atomicAdd((unsigned long long*)(P->ws + WS_CTL) + 1000, __builtin_amdgcn_s_memrealtime() - t0_); } } continue; } item -= N_ML;
                if (item < N_S5) { { unsigned long long t0_ = 0; if (TIMEK == 3) t0_ = __builtin_amdgcn_s_memrealtime(); if (EN(6) && (rep == 0 || DUP == 2 || DUP == 23)) s5_stage1(P, l, item, lds, wave, lane); if (TIMEK == 3) { __syncthreads(); if (tid0 == 0) atomicAdd((unsigned long long*)(P->ws + WS_CTL) + 1000, __builtin_amdgcn_s_memrealtime() - t0_); } } continue; } item -= N_S5;
                { unsigned long long t0_ = 0; if (TIMEK == 4) t0_ = __builtin_amdgcn_s_memrealtime(); if (EN(7) && rep == 0) rope_item(P, item, tid); if (TIMEK == 4) { __syncthreads(); if (tid0 == 0) atomicAdd((unsigned long long*)(P->ws + WS_CTL) + 1000, __builtin_amdgcn_s_memrealtime() - t0_); } }
            }
            GRID_SYNC();
        }
        for (int rep = 0; rep < ((DUP) / 10 == 3 || (DUP) == 3 ? 2 : 1); ++rep) {
            constexpr int N_NSA = 512, N_ML = 512, N_S5 = 256, NTOT = N_NSA + N_ML + N_S5;
            for (int kstep = 0;; ++kstep) {
                __syncthreads();
                int item;
                if (gridDim.x == 256) item = p3_static((int)blockIdx.x, kstep);
                else { if (tid0 == 0) misc[0] = atomicAdd((unsigned*)(P->ws + WS_CTL) + 64 * (2 * l + 1) + 1024 * rep, 1u); __syncthreads(); item = (int)misc[0]; if (item >= NTOT) item = -1; }
                PHASE_BEGIN();
                if (item < 0) break;
                if (item < N_NSA) { { unsigned long long t0_ = 0; if (TIMEK == 5) t0_ = __builtin_amdgcn_s_memrealtime(); if (EN(8) && (rep == 0 || DUP == 3 || DUP == 31)) nsa_item(P, l, item, lds, tid, wave, lane); if (TIMEK == 5) { __syncthreads(); if (tid0 == 0) atomicAdd((unsigned long long*)(P->ws + WS_CTL) + 1000, __builtin_amdgcn_s_memrealtime() - t0_); } } continue; } item -= N_NSA;
                if (item < N_ML) { { unsigned long long t0_ = 0; if (TIMEK == 6) t0_ = __builtin_amdgcn_s_memrealtime(); if (EN(9) && (rep == 0 || DUP == 3 || DUP == 32)) mlstm_stage2(P, l, item, lds, tid, wave, lane); if (TIMEK == 6) { __syncthreads(); if (tid0 == 0) atomicAdd((unsigned long long*)(P->ws + WS_CTL) + 1000, __builtin_amdgcn_s_memrealtime() - t0_); } } continue; } item -= N_ML;
                { unsigned long long t0_ = 0; if (TIMEK == 7) t0_ = __builtin_amdgcn_s_memrealtime(); if (EN(10) && (rep == 0 || DUP == 3 || DUP == 33)) s5_stage2(P, l, item, lds, wave, lane); if (TIMEK == 7) { __syncthreads(); if (tid0 == 0) atomicAdd((unsigned long long*)(P->ws + WS_CTL) + 1000, __builtin_amdgcn_s_memrealtime() - t0_); } }
            }
            GRID_SYNC();
        }
        for (int rep = 0; rep < NREP(4); ++rep) {
            PHASE_BEGIN();
            pg8::Gemm g{(const bf16_t*)(ws + WS_Y), (const bf16_t*)(ws + WS_WOUT), MTOK, DM, DM}; pg8::StaticOrder S; S.init(MTOK, DM, G, (int)blockIdx.x);
            pg8::EpiBf16<0> E{(bf16_t*)(ws + WS_Z), DM, nullptr, -1};
            pg8::gemm_phase<pg8::EpiBf16<0>, pg8::StaticOrder, true, true>(lds, g, S, E, tid);
            GRID_SYNC();
        }
        if (EN(12)) {
            PHASE_BEGIN();
            const bool hb = P->hb16 != 0;
            norm_pass(nullptr, (const bf16_t*)(ws + WS_Z), P->in[I_LN_MIX_POST] + l * DM, P->in[I_LN_MLP_PRE] + l * DM, P->out, hb ? (bf16_t*)(ws + WS_H16) : nullptr, hb ? nullptr : P->out, (bf16_t*)(ws + WS_U), gw, NGW, lane);
        }
        GRID_SYNC();
        for (int rep = 0; rep < NREP(6); ++rep) {
            PHASE_BEGIN();
            pg8::Gemm g{(const bf16_t*)(ws + WS_U), (const bf16_t*)(ws + WS_W1), MTOK, DFF, DM}; pg8::StaticOrder S; S.init(MTOK, DFF, G, (int)blockIdx.x);
            pg8::EpiBf16<2> E{(bf16_t*)(ws + WS_Z), DFF, nullptr, -1};
            pg8::gemm_phase<pg8::EpiBf16<2>, pg8::StaticOrder, true, true>(lds, g, S, E, tid);
            GRID_SYNC();
        }
        for (int rep = 0; rep < NREP(7); ++rep) {
            PHASE_BEGIN();
            pg8::Gemm g{(const bf16_t*)(ws + WS_Z), (const bf16_t*)(ws + WS_W2), MTOK, DM, DFF}; pg8::StaticOrder S; S.init(MTOK, DM, G, (int)blockIdx.x);
            pg8::EpiBf16<0> E{(bf16_t*)(ws + WS_Y), DM, nullptr, -1};
            pg8::gemm_phase<pg8::EpiBf16<0>, pg8::StaticOrder, true, true>(lds, g, S, E, tid);
            GRID_SYNC();
        }
        {
            PHASE_BEGIN();
            if (EN(15)) { const bool hb = P->hb16 != 0, last = (l + 1 == DEPTH);
                norm_pass(nullptr, (const bf16_t*)(ws + WS_Y), P->in[I_LN_MLP_POST] + l * DM, last ? nullptr : P->in[I_LN_MIX_PRE] + (l + 1) * DM, P->out, hb ? (bf16_t*)(ws + WS_H16) : nullptr, (hb && !last) ? nullptr : P->out, (bf16_t*)(ws + WS_U), gw, NGW, lane); }
            if (l + 1 < DEPTH) { for (int rep = 0; rep < NREP(8); ++rep) convert_layer(P, l + 1, lds, gw, NGW, wave, lane); }
        }
        if (l + 1 < DEPTH) GRID_SYNC();
    }
    if (TIMEK != 0) {
        GRID_SYNC();
        if (blockIdx.x == 0 && tid0 == 0) { const unsigned long long tot = __hip_atomic_load((unsigned long long*)(P->ws + WS_CTL) + 1000, __ATOMIC_RELAXED, __HIP_MEMORY_SCOPE_AGENT) / 256ull;
            const unsigned long long t0_ = __builtin_amdgcn_s_memrealtime(); while (__builtin_amdgcn_s_memrealtime() - t0_ < tot) __builtin_amdgcn_s_sleep(8); }
    }
}

extern "C" void kernel_launch(void* const* d_in, const int* in_sizes, int n_in, void* d_out, int out_size, void* d_ws, size_t ws_size, hipStream_t stream) {
    static int grid = 0;
    if (grid == 0) {
        if (n_in != 31 || out_size != MTOK * DM || ws_size < WS_END) { fprintf(stderr, "kernel_launch: unexpected shapes (n_in %d out %d ws %zu)\n", n_in, out_size, ws_size); grid = -1; return; }
        int dev = 0, cus = 0, per_cu = 0;
        (void)hipGetDevice(&dev);
        (void)hipDeviceGetAttribute(&cus, hipDeviceAttributeMultiprocessorCount, dev);
        (void)hipFuncSetAttribute((const void*)hybrid_fwd, hipFuncAttributeMaxDynamicSharedMemorySize, LDS_BYTES);
        (void)hipOccupancyMaxActiveBlocksPerMultiprocessor(&per_cu, (const void*)hybrid_fwd, 512, LDS_BYTES);
        if (per_cu < 1) { fprintf(stderr, "kernel_launch: occupancy query says %d blocks/CU\n", per_cu); per_cu = 1; }
        grid = cus * 1;
        (void)hipGetLastError();
    }
    if (grid < 0) return;
    (void)hipMemsetAsync((char*)d_ws + WS_CTL, 0, 65536, stream);
    Params p{};
    for (int i = 0; i < 31; ++i) p.in[i] = (const float*)d_in[i];
    p.out = (float*)d_out; p.ws = (unsigned char*)d_ws; p.hb16 = (ws_size >= WS_END_H16) ? 1 : 0;
    void* args[] = {&p};
    hipError_t e = hipLaunchCooperativeKernel((const void*)hybrid_fwd, dim3(grid), dim3(512), args, LDS_BYTES, stream);
    if (e != hipSuccess) fprintf(stderr, "cooperative launch failed: %s (grid %d)\n", hipGetErrorString(e), grid);
}
```
